# Optimizing an MI355X kernel written in HIP

```python
import math
import jax, jax.numpy as jnp
from jax import lax
import numpy as np

D_MODEL = 4096
BATCH = 4
SEQ = 4096
DEPTH = 1

CTX_LEN = 256
GRID_W = 64
N_MOD = 9
D_FF = 11008
SSM_WIDTH = D_MODEL // 4
SSM_GROUP = 16
SSM_GROUPS = SSM_WIDTH // SSM_GROUP
SSM_STATE = 64
POOL_WINDOWS = (2, 4, 8, 16)
POOL_WIDTH = D_MODEL // 2
POOL_GROUP = POOL_WIDTH // len(POOL_WINDOWS)
D_IN = SSM_WIDTH + POOL_WIDTH + 2 * D_MODEL
RMS_EPS = 1e-6
LAMBDA_RE_MAX = -1e-4
STEP_MIN = 1e-3
STEP_MAX = 1e-1
HALF = 0.5

kernel_name = 'hybrid_s5_pool_macaron_prefix_dit'


def _rmsnorm(v, g):
    vf = v.astype(jnp.float32)
    vf = vf * lax.rsqrt(jnp.mean(vf * vf, axis=-1, keepdims=True) + RMS_EPS)
    return (vf * g.astype(jnp.float32)).astype(v.dtype)


def _pre(v, g, shift, scale):
    return _rmsnorm(v, g) * (1 + scale) + shift


def _swiglu(u, w_in, w_out):
    gate, up = jnp.split(u @ w_in, 2, axis=-1)
    return (jax.nn.silu(gate) * up) @ w_out


def _discretise(lam_re, lam_im, log_step, b_re, b_im):
    lam = lax.complex(jnp.minimum(lam_re.astype(jnp.float32), LAMBDA_RE_MAX), lam_im.astype(jnp.float32))
    step = jnp.exp(log_step.astype(jnp.float32))[..., None]
    lam_bar = jnp.exp(lam * step)
    b = lax.complex(b_re.astype(jnp.float32), b_im.astype(jnp.float32))
    b_bar = ((lam_bar - 1) / lam)[..., None] * b
    return lam_bar, b_bar


def _diag_scan(bu, lam_bar, reverse):
    a = jnp.broadcast_to(lam_bar, (bu.shape[0], 1) + lam_bar.shape)

    def combine(e1, e2):
        a1, b1 = e1
        a2, b2 = e2
        return a1 * a2, a2 * b1 + b2

    _, h = lax.associative_scan(combine, (a, bu), reverse=reverse, axis=0)
    return h


def _ssm_states(u_s, lam_bar, b_bar, h0):
    bsz, n, _ = u_s.shape
    ug = u_s.astype(jnp.float32).reshape(bsz, n, SSM_GROUPS, SSM_GROUP).astype(jnp.complex64)
    bu_f = jnp.einsum('blgk,gpk->lbgp', ug, b_bar[0])
    bu_b = jnp.einsum('blgk,gpk->lbgp', ug, b_bar[1])
    if h0 is not None:
        h0_f, h0_b = h0
        bu_f = bu_f.at[0].add(lam_bar[0] * h0_f)
        bu_b = bu_b.at[-1].add(lam_bar[1] * h0_b)
    h_f = _diag_scan(bu_f, lam_bar[0], reverse=False)
    h_b = _diag_scan(bu_b, lam_bar[1], reverse=True)
    return h_f, h_b


def _ssm_branch(u_s, h_f, h_b, c_re, c_im, d, w_glu, w_branch):
    bsz, n, _ = u_s.shape
    cm = lax.complex(c_re.astype(jnp.float32), c_im.astype(jnp.float32))
    y = jnp.real(jnp.einsum('lbgp,gkp->blgk', h_f, cm[0]) + jnp.einsum('lbgp,gkp->blgk', h_b, cm[1]))
    y = y.reshape(bsz, n, SSM_WIDTH).astype(u_s.dtype) + d * u_s
    z = jax.nn.gelu(y)
    a, b = jnp.split(z @ w_glu, 2, axis=-1)
    return (a * jax.nn.sigmoid(b)) @ w_branch


def _box_sum(v, w, axis):
    n = v.shape[axis]
    pad = [(0, 0)] * v.ndim
    pad[axis] = (1, 0)
    s = jnp.pad(jnp.cumsum(v, axis=axis), pad)
    idx = jnp.arange(n)
    lo = jnp.clip(idx - w // 2, 0, n)
    hi = jnp.clip(idx + (w - w // 2), 0, n)
    total = jnp.take(s, hi, axis=axis) - jnp.take(s, lo, axis=axis)
    return total, (hi - lo).astype(jnp.float32)


def _window_mean(v, w, on_grid):
    bsz, n, ch = v.shape
    vf = v.astype(jnp.float32)
    if on_grid:
        rows = n // GRID_W
        g = vf.reshape(bsz, rows, GRID_W, ch)
        s, cnt_r = _box_sum(g, w, 1)
        s, cnt_c = _box_sum(s, w, 2)
        mean = (s / (cnt_r[:, None] * cnt_c[None, :])[None, :, :, None]).reshape(bsz, n, ch)
    else:
        s, cnt = _box_sum(vf, w, 1)
        mean = s / cnt[None, :, None]
    return mean.astype(v.dtype)


def _pool_branch(u_p, on_grid, pool_w, pool_scale, w_branch):
    bsz, n, _ = u_p.shape
    groups = jnp.split(u_p, len(POOL_WINDOWS), axis=-1)
    mixed = jnp.stack([_window_mean(v, w, on_grid) - v for v, w in zip(groups, POOL_WINDOWS)], axis=2)
    y = jnp.einsum('blgc,gcd->blgd', mixed, pool_w).reshape(bsz, n, POOL_WIDTH)
    return (y * pool_scale) @ w_branch


def _token_mixer(u, lp, lam_bar, b_bar, h0, on_grid):
    splits = [SSM_WIDTH, SSM_WIDTH + POOL_WIDTH, SSM_WIDTH + POOL_WIDTH + D_MODEL]
    u_s, u_p, g_a, g_b = jnp.split(u @ lp['w_in'], splits, axis=-1)
    h_f, h_b = _ssm_states(u_s, lam_bar, b_bar, h0)
    y_a = _ssm_branch(u_s, h_f, h_b, lp['ssm_c_re'], lp['ssm_c_im'], lp['ssm_d'], lp['w_glu'], lp['w_branch_a'])
    y_b = _pool_branch(u_p, on_grid, lp['pool_w'], lp['pool_scale'], lp['w_branch_b'])
    merged = jax.nn.sigmoid(g_a) * y_a + jax.nn.sigmoid(g_b) * y_b
    return merged @ lp['w_out'], (h_f[-1], h_b[0])


def setup_inputs(seed: int = 0) -> dict:
    key = jax.random.key(seed)
    ks = jax.random.split(key, 32)
    f32 = jnp.float32

    def nrm(k, shape, scale):
        return jax.random.normal(k, shape, f32) * scale

    L, G, P, K = DEPTH, SSM_GROUPS, SSM_STATE, SSM_GROUP
    x = nrm(ks[0], (BATCH, SEQ, D_MODEL), 1.0)
    c = nrm(ks[1], (BATCH, D_MODEL), 1.0)
    ctx = nrm(ks[2], (BATCH, CTX_LEN, D_MODEL), 1.0)
    c_ctx = nrm(ks[3], (D_MODEL,), 1.0)
    w_mod = nrm(ks[4], (L, D_MODEL, N_MOD * D_MODEL), 0.5 * D_MODEL ** -0.5)
    b_mod = nrm(ks[5], (L, N_MOD * D_MODEL), 0.02)
    norm_g = 1.0 + nrm(ks[6], (L, 3, D_MODEL), 0.02)
    final_g = 1.0 + nrm(ks[7], (D_MODEL,), 0.02)
    ffn1_w_in = nrm(ks[8], (L, D_MODEL, 2 * D_FF), D_MODEL ** -0.5)
    ffn1_w_out = nrm(ks[9], (L, D_FF, D_MODEL), D_FF ** -0.5)
    ffn2_w_in = nrm(ks[10], (L, D_MODEL, 2 * D_FF), D_MODEL ** -0.5)
    ffn2_w_out = nrm(ks[11], (L, D_FF, D_MODEL), D_FF ** -0.5)
    w_in = nrm(ks[12], (L, D_MODEL, D_IN), D_MODEL ** -0.5)
    n_idx = jnp.arange(P, dtype=f32)
    ssm_lambda_re = -0.5 + nrm(ks[13], (L, 2, G, P), 0.01)
    ssm_lambda_im = math.pi * n_idx + nrm(ks[14], (L, 2, G, P), 0.01)
    ssm_log_step = jax.random.uniform(ks[15], (L, 2, G), f32, math.log(STEP_MIN), math.log(STEP_MAX))
    ssm_b_re = nrm(ks[16], (L, 2, G, P, K), (2 * K) ** -0.5)
    ssm_b_im = nrm(ks[17], (L, 2, G, P, K), (2 * K) ** -0.5)
    ssm_c_re = nrm(ks[18], (L, 2, G, K, P), (2 * P) ** -0.5)
    ssm_c_im = nrm(ks[19], (L, 2, G, K, P), (2 * P) ** -0.5)
    ssm_d = nrm(ks[20], (L, SSM_WIDTH), 1.0)
    w_glu = nrm(ks[21], (L, SSM_WIDTH, 2 * SSM_WIDTH), SSM_WIDTH ** -0.5)
    w_branch_a = nrm(ks[22], (L, SSM_WIDTH, D_MODEL), SSM_WIDTH ** -0.5)
    pool_w = nrm(ks[23], (L, len(POOL_WINDOWS), POOL_GROUP, POOL_GROUP), POOL_GROUP ** -0.5)
    pool_scale = 1.0 + nrm(ks[24], (L, POOL_WIDTH), 0.02)
    w_branch_b = nrm(ks[25], (L, POOL_WIDTH, D_MODEL), POOL_WIDTH ** -0.5)
    w_out = nrm(ks[26], (L, D_MODEL, D_MODEL), D_MODEL ** -0.5)
    return {'x': x, 'c': c, 'ctx': ctx, 'c_ctx': c_ctx, 'w_mod': w_mod, 'b_mod': b_mod,
            'norm_g': norm_g, 'final_g': final_g,
            'ffn1_w_in': ffn1_w_in, 'ffn1_w_out': ffn1_w_out, 'ffn2_w_in': ffn2_w_in, 'ffn2_w_out': ffn2_w_out,
            'w_in': w_in, 'ssm_lambda_re': ssm_lambda_re, 'ssm_lambda_im': ssm_lambda_im,
            'ssm_log_step': ssm_log_step, 'ssm_b_re': ssm_b_re, 'ssm_b_im': ssm_b_im,
            'ssm_c_re': ssm_c_re, 'ssm_c_im': ssm_c_im, 'ssm_d': ssm_d, 'w_glu': w_glu,
            'w_branch_a': w_branch_a, 'pool_w': pool_w, 'pool_scale': pool_scale,
            'w_branch_b': w_branch_b, 'w_out': w_out}


def reference(x, c, ctx, c_ctx, w_mod, b_mod, norm_g, final_g, ffn1_w_in, ffn1_w_out, ffn2_w_in, ffn2_w_out,
              w_in, ssm_lambda_re, ssm_lambda_im, ssm_log_step, ssm_b_re, ssm_b_im, ssm_c_re, ssm_c_im, ssm_d,
              w_glu, w_branch_a, pool_w, pool_scale, w_branch_b, w_out):
    bsz = x.shape[0]
    for l in range(DEPTH):
        last = l == DEPTH - 1
        mx = (jax.nn.silu(c) @ w_mod[l] + b_mod[l]).reshape(bsz, N_MOD, 1, D_MODEL)
        mx = [mx[:, i] for i in range(N_MOD)]
        mc = (jax.nn.silu(c_ctx) @ w_mod[l] + b_mod[l]).reshape(N_MOD, D_MODEL)
        lp = {'w_in': w_in[l], 'ssm_c_re': ssm_c_re[l], 'ssm_c_im': ssm_c_im[l], 'ssm_d': ssm_d[l],
              'w_glu': w_glu[l], 'w_branch_a': w_branch_a[l], 'pool_w': pool_w[l],
              'pool_scale': pool_scale[l], 'w_branch_b': w_branch_b[l], 'w_out': w_out[l]}
        lam_bar, b_bar = _discretise(ssm_lambda_re[l], ssm_lambda_im[l], ssm_log_step[l], ssm_b_re[l], ssm_b_im[l])

        x = x + HALF * mx[2] * _swiglu(_pre(x, norm_g[l, 0], mx[0], mx[1]), ffn1_w_in[l], ffn1_w_out[l])
        ctx = ctx + HALF * mc[2] * _swiglu(_pre(ctx, norm_g[l, 0], mc[0], mc[1]), ffn1_w_in[l], ffn1_w_out[l])

        uc = _pre(ctx, norm_g[l, 1], mc[3], mc[4])
        if last:
            h_f, h_b = _ssm_states(uc @ w_in[l][:, :SSM_WIDTH], lam_bar, b_bar, None)
            h_ctx = (h_f[-1], h_b[0])
        else:
            m_c, h_ctx = _token_mixer(uc, lp, lam_bar, b_bar, None, False)
            ctx = ctx + mc[5] * m_c
            ctx = ctx + HALF * mc[8] * _swiglu(_pre(ctx, norm_g[l, 2], mc[6], mc[7]), ffn2_w_in[l], ffn2_w_out[l])

        m_x, _ = _token_mixer(_pre(x, norm_g[l, 1], mx[3], mx[4]), lp, lam_bar, b_bar, h_ctx, True)
        x = x + mx[5] * m_x

        x = x + HALF * mx[8] * _swiglu(_pre(x, norm_g[l, 2], mx[6], mx[7]), ffn2_w_in[l], ffn2_w_out[l])
    return _rmsnorm(x, final_g)
```

```cpp
#include <hip/hip_runtime.h>
#include <cstdio>
#include <cstdint>

namespace pg8 {
#define PG8_LAS __attribute__((address_space(3)))
typedef unsigned short bf16_t;
typedef short bf16x8 __attribute__((ext_vector_type(8)));
typedef float f32x4 __attribute__((ext_vector_type(4)));
typedef unsigned u32x4 __attribute__((ext_vector_type(4)));
constexpr int BM = 256, BK = 64, HALF = 128, HTB = HALF * BK * 2  , STAGE_BYTES = 8 * HTB, NXCD = 8, WGM = 8;

__host__ __device__ __forceinline__ int lds_byte(int r, int c) { const int st = (r >> 4) * 2 + (c >> 5), rr = r & 15, cc = c & 31, ob = rr * 64 + cc * 2; return st * 1024 + (ob ^ (((ob >> 9) & 1) << 5)); }
__host__ __device__ __forceinline__ void stage_rc(int b, int& R, int& C) { const int st = b / 1024, sb = b % 1024, swz = sb ^ (((sb >> 9) & 1) << 5); R = (st >> 1) * 16 + swz / 64; C = (st & 1) * 32 + (swz % 64) / 2; }
__host__ __device__ __forceinline__ int perm32(int rho) { const int n = rho >> 4, i = rho & 15; return 8 * (i >> 2) + 4 * n + (i & 3); }

struct Unit { int pm, pn, g, kt0, nkt; };
struct Gemm { const char* A; const char* Bt; int lda, ldb, K; long gsa, gsb; };

struct StaticOrder {
    int nM, nN, nwg, G, c, wgm;
    __host__ __device__ void init(int M, int N, int G_, int c_, int wgm_ = WGM) { nM = M / BM; nN = N / BM; nwg = nM * nN; G = G_; c = c_; wgm = wgm_; }
    static constexpr bool DYNAMIC = false;
    __host__ __device__ int total() const { return nwg; }
    __host__ __device__ bool next(int i, Unit& u) const { return at((long)i * G + c, u); }
    __host__ __device__ bool at(long L, Unit& u) const {
        if (L >= nwg) return false;
        int wgid = (int)L; { const int q = nwg / NXCD, r = nwg % NXCD, xcd = wgid % NXCD, off = wgid / NXCD; wgid = (xcd < r ? xcd * (q + 1) : r * (q + 1) + (xcd - r) * q) + off; }
        const int nig = wgm * nN, gid = wgid / nig, fm = gid * wgm, gsz = (nM - fm) < wgm ? (nM - fm) : wgm;
        u.pm = fm + ((wgid % nig) % gsz); u.pn = (wgid % nig) / gsz; u.g = 0; u.kt0 = 0; u.nkt = 0; return true;
    }
    __device__ __forceinline__ void a_ready(const Unit&) const {}
    __device__ __forceinline__ void done(const Unit&) const {}
};
struct GroupOrder {
    static constexpr bool DYNAMIC = false;
    int nM, nN, ng, G, c;
    __device__ bool next(int i, Unit& u) const {
        const long L = (long)i * G + c; const int per = nM * nN; if (L >= (long)ng * per) return false;
        u.g = (int)(L / per); const int r = (int)(L % per); u.pm = r % nM; u.pn = r / nM; u.kt0 = 0; u.nkt = 0; return true;
    }
    __device__ __forceinline__ void a_ready(const Unit&) const {}
    __device__ __forceinline__ void done(const Unit&) const {}
};

struct SplitKOrder {
    StaticOrder S; int pm0, npn, ntiles, kt_a, kt_b;
    static constexpr bool DYNAMIC = false;
    __device__ int total() const { return S.nwg + 4 * ntiles; }
    __device__ bool next(int i, Unit& u) const { return at((long)i * S.G + S.c, u); }
    __device__ bool at(long L, Unit& u) const {
        if (L < S.nwg) return S.at(L, u);
        const int j = (int)(L - S.nwg); if (j >= 4 * ntiles) return false;
        const int split = j & 3, tile = j >> 2;
        u.pm = pm0 + tile / npn; u.pn = tile % npn; u.g = split + 1; u.kt0 = split < 2 ? split * kt_a : 2 * kt_a + (split - 2) * kt_b; u.nkt = split < 2 ? kt_a : kt_b; return true;
    }
    __device__ __forceinline__ void a_ready(const Unit&) const {}
    __device__ __forceinline__ void done(const Unit&) const {}
};

template <class Base> struct DynOrder {
    static constexpr bool DYNAMIC = true;
    Base B; unsigned* ctr; volatile PG8_LAS int* slot; int G, c;
    __device__ int total() const { return B.total(); }
    __device__ bool at(long L, Unit& u) const { return B.at(L, u); }
    __device__ int pull() const {
        const int x = c & 7, tot = B.total();
        for (int s_ = 0; s_ < 8; ++s_) { const int y = (x + s_) & 7, n0 = (G - y + 7) >> 3;
            const unsigned k = (unsigned)n0 + __hip_atomic_fetch_add(ctr + 16 * y, 1u, __ATOMIC_RELAXED, __HIP_MEMORY_SCOPE_AGENT);
            const long L = 8l * (long)k + y; if (L < tot) return (int)L; }
        return -1;
    }
    __device__ __forceinline__ void a_ready(const Unit&) const {}
    __device__ __forceinline__ void done(const Unit&) const {}
};

__device__ __forceinline__ unsigned cvt_pk_bf16(float lo, float hi) { unsigned r; asm volatile("v_cvt_pk_bf16_f32 %0, %1, %2" : "=v"(r) : "v"(lo), "v"(hi)); return r; }
__device__ __forceinline__ float sigmoidf_fast(float x) { return __builtin_amdgcn_rcpf(1.0f + __expf(-x)); }
__device__ __forceinline__ float bf_lo(unsigned w) { return __uint_as_float(w << 16); }
__device__ __forceinline__ float bf_hi(unsigned w) { return __uint_as_float(w & 0xffff0000u); }

template <class Epi, class Sched, bool ALIGN_EPI = false, bool SP2 = false, int VAR = 0>
__device__ __forceinline__ void gemm_phase(PG8_LAS unsigned char* lds, const Gemm g, const Sched& S, const Epi& E) {
    const int tid = threadIdx.x, wid = __builtin_amdgcn_readfirstlane(tid >> 6), lane = tid & 63, wr = wid >> 2, wc = wid & 3, fr = lane & 15, fq = lane >> 4;
    const int K = g.K, nt = K / BK;
    unsigned voffA[2], voffB[2];
#pragma unroll
    for (int i = 0; i < 2; ++i) { int R, C; stage_rc(tid * 16 + i * 8192, R, C); const int Rb = Epi::PERM ? ((R & ~31) + perm32(R & 31)) : R;
        voffA[i] = (unsigned)(R * g.lda + C) * 2u; voffB[i] = (unsigned)(Rb * g.ldb + C) * 2u; }
    const size_t kstep = (size_t)(BK * 2);
    const size_t hsA = (size_t)HALF * g.lda * 2, hsB = (size_t)HALF * g.ldb * 2;
    const size_t tsA = 2 * hsA, tsB = 2 * hsB;
    const unsigned ldsw = (unsigned)wid * 1024u;
    const int aoff = lds_byte(wr * 64 + fr, fq * 8), boff = lds_byte(wc * 32 + fr, fq * 8);
#define PG8_SA(b, h) (((b) * 2 + (h)) * HTB)
#define PG8_SB(b, h) ((4 + (b) * 2 + (h)) * HTB)
#define PG8_STAGE(bufoff, gbase, voff) do { if (!(VAR & 1)) _Pragma("unroll") for (int _i = 0; _i < 2; ++_i) \
        __builtin_amdgcn_global_load_lds((const unsigned*)((const char*)(gbase) + (voff)[_i]), (PG8_LAS unsigned*)(lds + (bufoff) + ldsw + _i * 8192), 16, 0, 0); } while (0)
#define PG8_LDA(dst, b, h) do { if (!(VAR & 2)) _Pragma("unroll") for (int m = 0; m < 4; ++m) _Pragma("unroll") for (int k = 0; k < 2; ++k) dst[m][k] = *(const PG8_LAS bf16x8*)(lds + PG8_SA(b, h) + aoff + m * 2048 + k * 1024); } while (0)
#define PG8_LDB(dst, b, h) do { if (!(VAR & 2)) _Pragma("unroll") for (int n = 0; n < 2; ++n) _Pragma("unroll") for (int k = 0; k < 2; ++k) dst[n][k] = *(const PG8_LAS bf16x8*)(lds + PG8_SB(b, h) + boff + n * 2048 + k * 1024); } while (0)
#define PG8_MMA(ai, bj, At, Bt) do { if (!(VAR & 128)) __builtin_amdgcn_s_setprio(1); if (!(VAR & 4)) _Pragma("unroll") for (int m = 0; m < 4; ++m) _Pragma("unroll") for (int n = 0; n < 2; ++n) _Pragma("unroll") for (int k = 0; k < 2; ++k) \
        acc[ai][bj][m][n] = __builtin_amdgcn_mfma_f32_16x16x32_bf16(Bt[n][k], At[m][k], acc[ai][bj][m][n], 0, 0, 0); if (!(VAR & 128)) __builtin_amdgcn_s_setprio(0); } while (0)
#define PG8_WAIT_V(n) asm volatile("s_waitcnt vmcnt(" #n ")" ::: "memory")
#define PG8_WAIT_L(n) asm volatile("s_waitcnt lgkmcnt(" #n ")" ::: "memory")
#define PG8_BAR __builtin_amdgcn_s_barrier()
#define PG8_SCHED __builtin_amdgcn_sched_barrier(0)
    Unit cur, nxt; int ui = 0;
    if constexpr (Sched::DYNAMIC) {
        if (!S.at(S.c, cur)) return;
        if (tid == 0) S.slot[1] = S.pull();
        __syncthreads();
    } else { if (!S.next(0, cur)) return; }
    if constexpr (VAR & 128) { if (wr == 1) __builtin_amdgcn_s_setprio(1); }
    f32x4 acc[2][2][4][2];
#pragma unroll
    for (int a = 0; a < 2; ++a)
#pragma unroll
        for (int b = 0; b < 2; ++b)
#pragma unroll
            for (int m = 0; m < 4; ++m)
#pragma unroll
                for (int n = 0; n < 2; ++n) acc[a][b][m][n] = (f32x4){0.f, 0.f, 0.f, 0.f};
    bf16x8 At[4][2], B0[2][2], B1[2][2];
    if (VAR & 2) {
#pragma unroll
        for (int m = 0; m < 4; ++m)
#pragma unroll
            for (int k = 0; k < 2; ++k) { At[m][k] = (bf16x8){0, 0, 0, 0, 0, 0, 0, 0}; asm volatile("" : "+v"(At[m][k])); }
#pragma unroll
        for (int n = 0; n < 2; ++n)
#pragma unroll
            for (int k = 0; k < 2; ++k) { B0[n][k] = (bf16x8){0, 0, 0, 0, 0, 0, 0, 0}; B1[n][k] = B0[n][k]; asm volatile("" : "+v"(B0[n][k])); asm volatile("" : "+v"(B1[n][k])); }
    }
    const bool grouped = g.gsa != 0 || g.gsb != 0;
    const char* cA = g.A + (grouped ? (size_t)cur.g * g.gsa : 0) + (size_t)((VAR & 8) ? 0 : cur.pm) * tsA + (size_t)cur.kt0 * kstep; const char* cB = g.Bt + (grouped ? (size_t)cur.g * g.gsb : 0) + (size_t)((VAR & 8) ? 0 : cur.pn) * tsB + (size_t)cur.kt0 * kstep;
    S.a_ready(cur);
    if constexpr (SP2) {
        PG8_STAGE(PG8_SB(0, 0), cB, voffB); PG8_STAGE(PG8_SB(0, 1), cB + hsB, voffB); PG8_STAGE(PG8_SA(0, 0), cA, voffA); PG8_STAGE(PG8_SA(0, 1), cA + hsA, voffA);
        if (wr == 1) PG8_BAR;
        PG8_WAIT_V(2); PG8_BAR;
        PG8_STAGE(PG8_SB(1, 0), cB + kstep, voffB); PG8_STAGE(PG8_SA(1, 0), cA + kstep, voffA); PG8_STAGE(PG8_SB(1, 1), cB + hsB + kstep, voffB);
        PG8_WAIT_V(6); PG8_BAR;
    } else {
        PG8_STAGE(PG8_SB(0, 0), cB, voffB); PG8_STAGE(PG8_SA(0, 0), cA, voffA); PG8_STAGE(PG8_SB(0, 1), cB + hsB, voffB); PG8_STAGE(PG8_SA(0, 1), cA + hsA, voffA);
        if (wr == 1) PG8_BAR;
        PG8_WAIT_V(4); PG8_BAR;
        PG8_STAGE(PG8_SB(1, 0), cB + kstep, voffB); PG8_STAGE(PG8_SA(1, 0), cA + kstep, voffA); PG8_STAGE(PG8_SB(1, 1), cB + hsB + kstep, voffB);
        PG8_WAIT_V(6); PG8_BAR;
    }
    unsigned sink = 0u; const int tidx = wid * 12 + lane; const bool t_isA = tidx < 64; constexpr int PD = 4;
    for (;;) {
        bool has_next = false; const char* nA = cA; const char* nB = cB;
#define PG8_NEXT_PTRS() do { nA = has_next ? g.A + (grouped ? (size_t)nxt.g * g.gsa : 0) + (size_t)((VAR & 8) ? 0 : nxt.pm) * tsA + (size_t)nxt.kt0 * kstep : cA; \
                             nB = has_next ? g.Bt + (grouped ? (size_t)nxt.g * g.gsb : 0) + (size_t)((VAR & 8) ? 0 : nxt.pn) * tsB + (size_t)nxt.kt0 * kstep : cB; } while (0)
        if constexpr (!Sched::DYNAMIC) { has_next = S.next(ui + 1, nxt); PG8_NEXT_PTRS(); }
        const int ntu = cur.nkt ? cur.nkt : nt;
        const unsigned toff = t_isA ? (unsigned)(((cur.pn & 3) * 64 + tidx) * g.lda) * 2u : (unsigned)(((cur.pm & 7) * 32 + (tidx - 64)) * g.ldb) * 2u;
#define PG8_TOUCH(tt) do { if constexpr (VAR & 64) { const int tp_ = (tt) + PD; const char* ta_ = tp_ < ntu ? cA + (size_t)tp_ * kstep : nA + (size_t)(tp_ - ntu) * kstep; \
            const char* tb_ = tp_ < ntu ? cB + (size_t)tp_ * kstep : nB + (size_t)(tp_ - ntu) * kstep; const char* tpp_ = (t_isA ? ta_ : tb_) + toff; \
            if (lane < 12) asm volatile("global_load_dword %0, %1, off" : "+v"(sink) : "v"(tpp_) : "memory"); } } while (0)
        for (int t = 0; t < ntu; t += 2) {
            const bool last = (t == ntu - 2);
            if constexpr (Sched::DYNAMIC) { if (last) {
                const int nL = __builtin_amdgcn_readfirstlane(S.slot[(ui + 1) & 1]); has_next = nL >= 0; if (has_next) has_next = S.at(nL, nxt); PG8_NEXT_PTRS(); } }
            const char* a1 = cA + (size_t)(t + 1) * kstep;
            const char* a2 = last ? nA : cA + (size_t)(t + 2) * kstep; const char* b2 = last ? nB : cB + (size_t)(t + 2) * kstep;
            const char* a3 = a2 + kstep; const char* b3 = b2 + kstep;
            if (last && has_next) S.a_ready(nxt);
            if constexpr (SP2) {
            if constexpr (VAR & 256) { PG8_STAGE(PG8_SA(1, 1), a1 + hsA, voffA); PG8_SCHED; PG8_LDB(B0, 0, 0); PG8_LDB(B1, 0, 1); PG8_SCHED; PG8_LDA(At, 0, 0); } else {
            PG8_LDB(B0, 0, 0); PG8_LDB(B1, 0, 1); PG8_SCHED; PG8_LDA(At, 0, 0); PG8_STAGE(PG8_SA(1, 1), a1 + hsA, voffA); } PG8_TOUCH(t);
            if constexpr ((VAR & 96) == 96) { PG8_WAIT_L(0); PG8_BAR; PG8_MMA(0, 0, At, B0); PG8_MMA(0, 1, At, B1); PG8_WAIT_V(10); PG8_BAR; PG8_SCHED; } else
            if constexpr (VAR & 32) { if (wr == 1) PG8_WAIT_V(8); PG8_WAIT_L(0); PG8_BAR; PG8_MMA(0, 0, At, B0); PG8_MMA(0, 1, At, B1); if (wr == 0) PG8_WAIT_V(8); PG8_BAR; PG8_SCHED; } else {
            PG8_WAIT_V(8); PG8_WAIT_L(0); PG8_BAR; PG8_MMA(0, 0, At, B0); PG8_MMA(0, 1, At, B1); PG8_BAR; PG8_SCHED; }
            if constexpr (VAR & 16) {
            PG8_LDA(At, 0, 1); PG8_STAGE(PG8_SB(0, 0), b2, voffB); PG8_STAGE(PG8_SB(0, 1), b2 + hsB, voffB);
            PG8_WAIT_V(6); PG8_WAIT_L(0); PG8_BAR; PG8_MMA(1, 0, At, B0); PG8_SCHED; PG8_STAGE(PG8_SA(0, 0), a2, voffA); PG8_SCHED; PG8_MMA(1, 1, At, B1); PG8_BAR; PG8_SCHED;
            } else {
            if constexpr (VAR & 256) { PG8_STAGE(PG8_SB(0, 0), b2, voffB); PG8_STAGE(PG8_SB(0, 1), b2 + hsB, voffB); PG8_STAGE(PG8_SA(0, 0), a2, voffA); PG8_SCHED; PG8_LDA(At, 0, 1); } else {
            PG8_LDA(At, 0, 1); PG8_STAGE(PG8_SB(0, 0), b2, voffB); PG8_STAGE(PG8_SB(0, 1), b2 + hsB, voffB); PG8_STAGE(PG8_SA(0, 0), a2, voffA); }
            if constexpr ((VAR & 96) == 96) { PG8_WAIT_L(0); PG8_BAR; PG8_MMA(1, 0, At, B0); PG8_MMA(1, 1, At, B1); PG8_WAIT_V(9); PG8_BAR; PG8_SCHED; } else
            if constexpr (VAR & 32) { if (wr == 1) PG8_WAIT_V(8); PG8_WAIT_L(0); PG8_BAR; PG8_MMA(1, 0, At, B0); PG8_MMA(1, 1, At, B1); if (wr == 0) PG8_WAIT_V(8); PG8_BAR; PG8_SCHED; } else {
            PG8_WAIT_V(8); PG8_WAIT_L(0); PG8_BAR; PG8_MMA(1, 0, At, B0); PG8_MMA(1, 1, At, B1); PG8_BAR; PG8_SCHED; }
            }
            if constexpr (VAR & 256) { PG8_STAGE(PG8_SA(0, 1), a2 + hsA, voffA); PG8_SCHED; PG8_LDB(B0, 1, 0); PG8_LDB(B1, 1, 1); PG8_SCHED; PG8_LDA(At, 1, 0); } else {
            PG8_LDB(B0, 1, 0); PG8_LDB(B1, 1, 1); PG8_SCHED; PG8_LDA(At, 1, 0); PG8_STAGE(PG8_SA(0, 1), a2 + hsA, voffA); } PG8_TOUCH(t + 1);
            if constexpr ((VAR & 96) == 96) { PG8_WAIT_L(0); PG8_BAR; PG8_MMA(0, 0, At, B0); PG8_MMA(0, 1, At, B1); PG8_WAIT_V(10); PG8_BAR; PG8_SCHED; } else
            if constexpr (VAR & 32) { if (wr == 1) PG8_WAIT_V(8); PG8_WAIT_L(0); PG8_BAR; PG8_MMA(0, 0, At, B0); PG8_MMA(0, 1, At, B1); if (wr == 0) PG8_WAIT_V(8); PG8_BAR; PG8_SCHED; } else {
            PG8_WAIT_V(8); PG8_WAIT_L(0); PG8_BAR; PG8_MMA(0, 0, At, B0); PG8_MMA(0, 1, At, B1); PG8_BAR; PG8_SCHED; }
            if constexpr (VAR & 16) {
            PG8_LDA(At, 1, 1); PG8_STAGE(PG8_SB(1, 0), b3, voffB); PG8_STAGE(PG8_SB(1, 1), b3 + hsB, voffB);
            PG8_WAIT_V(6); PG8_WAIT_L(0); PG8_BAR; PG8_MMA(1, 0, At, B0); PG8_SCHED; PG8_STAGE(PG8_SA(1, 0), a3, voffA); PG8_SCHED; PG8_MMA(1, 1, At, B1); PG8_BAR; PG8_SCHED;
            } else {
            if constexpr (VAR & 256) { PG8_STAGE(PG8_SB(1, 0), b3, voffB); PG8_STAGE(PG8_SB(1, 1), b3 + hsB, voffB); PG8_STAGE(PG8_SA(1, 0), a3, voffA); PG8_SCHED; PG8_LDA(At, 1, 1); } else {
            PG8_LDA(At, 1, 1); PG8_STAGE(PG8_SB(1, 0), b3, voffB); PG8_STAGE(PG8_SB(1, 1), b3 + hsB, voffB); PG8_STAGE(PG8_SA(1, 0), a3, voffA); }
            if constexpr ((VAR & 96) == 96) { PG8_WAIT_L(0); PG8_BAR; PG8_MMA(1, 0, At, B0); PG8_MMA(1, 1, At, B1); PG8_WAIT_V(9); PG8_BAR; PG8_SCHED; } else
            if constexpr (VAR & 32) { if (wr == 1) PG8_WAIT_V(8); PG8_WAIT_L(0); PG8_BAR; PG8_MMA(1, 0, At, B0); PG8_MMA(1, 1, At, B1); if (wr == 0) PG8_WAIT_V(8); PG8_BAR; PG8_SCHED; } else {
            PG8_WAIT_V(8); PG8_WAIT_L(0); PG8_BAR; PG8_MMA(1, 0, At, B0); PG8_MMA(1, 1, At, B1); PG8_BAR; PG8_SCHED; }
            }
            } else {
            PG8_LDB(B0, 0, 0); PG8_SCHED; PG8_LDA(At, 0, 0); PG8_STAGE(PG8_SA(1, 1), a1 + hsA, voffA);
            PG8_WAIT_L(8); PG8_BAR; PG8_WAIT_L(0); PG8_MMA(0, 0, At, B0); PG8_BAR; PG8_SCHED;
            PG8_LDB(B1, 0, 1); PG8_STAGE(PG8_SB(0, 0), b2, voffB);
            PG8_BAR; PG8_WAIT_L(0); PG8_MMA(0, 1, At, B1); PG8_BAR;
            PG8_LDA(At, 0, 1); PG8_STAGE(PG8_SA(0, 0), a2, voffA);
            PG8_BAR; PG8_WAIT_L(0); PG8_MMA(1, 0, At, B0); PG8_BAR; PG8_SCHED;
            PG8_STAGE(PG8_SB(0, 1), b2 + hsB, voffB);
            PG8_WAIT_V(6); PG8_BAR; PG8_MMA(1, 1, At, B1); PG8_BAR;
            PG8_LDB(B0, 1, 0); PG8_SCHED; PG8_LDA(At, 1, 0); PG8_STAGE(PG8_SA(0, 1), a2 + hsA, voffA);
            PG8_WAIT_L(8); PG8_BAR; PG8_WAIT_L(0); PG8_MMA(0, 0, At, B0); PG8_BAR; PG8_SCHED;
            PG8_LDB(B1, 1, 1); PG8_STAGE(PG8_SB(1, 0), b3, voffB);
            PG8_BAR; PG8_WAIT_L(0); PG8_MMA(0, 1, At, B1); PG8_BAR;
            PG8_LDA(At, 1, 1); PG8_STAGE(PG8_SA(1, 0), a3, voffA);
            PG8_BAR; PG8_WAIT_L(0); PG8_MMA(1, 0, At, B0); PG8_BAR; PG8_SCHED;
            PG8_STAGE(PG8_SB(1, 1), b3 + hsB, voffB);
            PG8_WAIT_V(6); PG8_BAR; PG8_MMA(1, 1, At, B1); PG8_BAR;
            }
        }
        if constexpr (ALIGN_EPI) { if (wr == 0) PG8_BAR; }
        int pulled = -1;
        if constexpr (Sched::DYNAMIC) { if (has_next && tid == 0) pulled = S.pull(); }
        E(acc, cur, wr, wc, fr, fq); S.done(cur);
        if constexpr (Sched::DYNAMIC) { if (has_next && tid == 0) S.slot[ui & 1] = pulled; }
        if (!has_next) break;
#pragma unroll
        for (int a = 0; a < 2; ++a)
#pragma unroll
            for (int b = 0; b < 2; ++b)
#pragma unroll
                for (int m = 0; m < 4; ++m)
#pragma unroll
                    for (int n = 0; n < 2; ++n) acc[a][b][m][n] = (f32x4){0.f, 0.f, 0.f, 0.f};
        cur = nxt; cA = nA; cB = nB; ++ui;
        if constexpr (ALIGN_EPI) { if (wr == 1) PG8_BAR; }
    }
    if constexpr (VAR & 128) __builtin_amdgcn_s_setprio(0);
    PG8_WAIT_V(0);
    asm volatile("" :: "v"(sink));
    if constexpr (!ALIGN_EPI) { if (wr == 0) PG8_BAR; }
    PG8_BAR;
#undef PG8_TOUCH
#undef PG8_NEXT_PTRS
#undef PG8_SA
#undef PG8_SB
#undef PG8_STAGE
#undef PG8_LDA
#undef PG8_LDB
#undef PG8_MMA
#undef PG8_WAIT_V
#undef PG8_WAIT_L
#undef PG8_BAR
#undef PG8_SCHED
}
}

#ifndef PG8_SP2
#define PG8_SP2 true
#endif
#ifndef PG8_ALIGN
#define PG8_ALIGN true
#endif
#ifndef PG8_VAR
#define PG8_VAR 0
#endif

constexpr int NWAVES = 8;
constexpr int D = 4096, BATCH = 4, SEQ = 4096, CTXL = 256, DFF = 11008, NMOD = 9;
constexpr int ML = BATCH * SEQ;
constexpr int MC = BATCH * CTXL;
constexpr int MA = ML + MC;
constexpr int SW = 1024, SG = 64, SK = 16, SP = 64;
constexpr int PW_ = 2048;
constexpr int DIN = SW + PW_ + 2 * D;
constexpr int CT = 32;
constexpr int NCH = SEQ / CT;
constexpr int A2R = BATCH * NCH;
constexpr int A2K = CT * SK + 4 * SP;
constexpr float RMS_EPS = 1e-6f;

constexpr size_t MiB = 1u << 20;
constexpr size_t WS_CTL = 0, CTL_ZERO_BYTES = 32768;
constexpr size_t WS_MOD = 1 * MiB;
constexpr size_t WS_BBAR = 2 * MiB;
constexpr size_t WS_LAMB = 3 * MiB;
constexpr size_t WS_USC = 4 * MiB;
constexpr size_t WS_S = 6 * MiB;
constexpr size_t WS_A2 = 38 * MiB;
constexpr size_t WS_BTY = 86 * MiB;
constexpr size_t WS_BTS = 134 * MiB;
constexpr size_t WS_W1A = 150 * MiB, WS_W1B = 322 * MiB, WS_W2A = 408 * MiB, WS_W2B = 580 * MiB;
constexpr size_t WS_WIN = 666 * MiB, WS_WGLU = 754 * MiB, WS_WA = 758 * MiB, WS_WPOOL = 766 * MiB, WS_WB = 768 * MiB, WS_WOUT = 784 * MiB;
constexpr size_t WS_U = 816 * MiB;
constexpr size_t WS_MIX = WS_U, WS_YB = WS_U + 64 * MiB;
constexpr size_t WS_H = 952 * MiB;
constexpr size_t WS_UP = WS_H, WS_GT = WS_H + 64 * MiB;
constexpr size_t WS_X = 1318 * MiB;
constexpr size_t WS_Z = 1590 * MiB, WS_GL = 1622 * MiB, WS_T = 1654 * MiB;
constexpr size_t WS_END = 1782 * MiB;
static_assert(WS_H + (size_t)MA * DFF * 2 <= WS_X && WS_GT + (size_t)ML * 2 * D * 2 <= WS_X && WS_U + (size_t)MA * D * 2 <= WS_H && WS_X + (size_t)MA * D * 4 <= WS_Z, "ws map");
constexpr int CW_TMO = 0, CW_QUEUE = 64, CW_DONE = 512  , CW_DYN = 1536  , CW_BAR = 4096;

constexpr int RING_OFF = 0;
constexpr int MISC_OFF = 144000;
constexpr int LDS_BYTES = 147456;

#define GAS __attribute__((address_space(1)))
#define LAS __attribute__((address_space(3)))
typedef unsigned short bf16;
typedef unsigned v4u __attribute__((ext_vector_type(4)));
typedef unsigned v2u __attribute__((ext_vector_type(2)));
typedef float f32x4 __attribute__((ext_vector_type(4)));
typedef GAS unsigned gu32;
#define RLX_AGENT __ATOMIC_RELAXED, __HIP_MEMORY_SCOPE_AGENT
#define LDS_WAIT() asm volatile("s_waitcnt lgkmcnt(0)" ::: "memory")
#define VM_WAIT() asm volatile("s_waitcnt vmcnt(0)" ::: "memory")
using pg8::cvt_pk_bf16; using pg8::sigmoidf_fast; using pg8::bf_lo; using pg8::bf_hi;

#define XB_TMO      128
#define XB_XCNT(j)  (256  + 64 * (j))
#define XB_XSUB(j)  (1280 + 64 * (j))
#define XB_XGEN(j)  (2304 + 64 * (j))
#define XB_TOP      3328
#define XB_TOPGEN   3392
#define XCD_BAR_WORDS 3456
#define XB_SPIN_CAP (1u << 18)
__device__ __forceinline__ unsigned xb_ld(unsigned* p)              { return __hip_atomic_load(p, __ATOMIC_RELAXED, __HIP_MEMORY_SCOPE_AGENT); }
__device__ __forceinline__ unsigned xb_add(unsigned* p, unsigned v) { return __hip_atomic_fetch_add(p, v, __ATOMIC_RELAXED, __HIP_MEMORY_SCOPE_AGENT); }
__device__ __forceinline__ unsigned xb_xcc_id() { return (unsigned)__builtin_amdgcn_s_getreg((3 << 11) | 20) & 0xFu; }
#define XB_SPIN(cond, bar) do { unsigned _sp = 0; while (cond) { __builtin_amdgcn_s_sleep(1); \
    if ((++_sp & 255u) == 0u) { if (xb_ld(&(bar)[XB_TMO])) break; if (_sp > XB_SPIN_CAP) { atomicAdd(&(bar)[XB_TMO], 1u); break; } } } } while (0)
struct XcdBarrier { unsigned* bar; unsigned x; volatile LAS unsigned* st; };
__device__ __forceinline__ XcdBarrier xcd_barrier_post(unsigned* bar, volatile LAS unsigned* st) {
    XcdBarrier b; b.bar = bar; b.x = xb_xcc_id(); b.st = st;
    if (threadIdx.x == 0) (void)xb_add(&bar[XB_XCNT(b.x)], 1u);
    return b;
}
__device__ __forceinline__ void xcd_barrier_complete(unsigned* bar, unsigned x, unsigned& nloc, unsigned& nx) {
    const unsigned G = gridDim.x * gridDim.y * gridDim.z;
    unsigned sum, cnt, mine, sp = 0u;
    for (;;) {
        sum = 0u; cnt = 0u; mine = 0u;
#pragma unroll
        for (unsigned j = 0; j < 16; ++j) { const unsigned c = xb_ld(&bar[XB_XCNT(j)]); sum += c; cnt += (c > 0u) ? 1u : 0u; mine = (j == x) ? c : mine; }
        if (sum == G) break;
        __builtin_amdgcn_s_sleep(1);
        if ((++sp & 255u) == 0u) { if (xb_ld(&bar[XB_TMO])) break; if (sp > XB_SPIN_CAP) { atomicAdd(&bar[XB_TMO], 1u); break; } }
    }
    nloc = mine > 0u ? mine : 1u; nx = cnt > 0u ? cnt : 1u;
}
__device__ __forceinline__ void xcd_barrier(const XcdBarrier& b) {
    asm volatile("s_waitcnt vmcnt(0)" ::: "memory");
    __syncthreads();
    if (threadIdx.x == 0) {
        unsigned* bar = b.bar;
        __builtin_amdgcn_s_waitcnt(0);
        unsigned nloc = b.st[0], nx = b.st[1];
        if (nloc == 0u) { xcd_barrier_complete(bar, b.x, nloc, nx); b.st[0] = nloc; b.st[1] = nx; }
        const unsigned old = xb_add(&bar[XB_XSUB(b.x)], 1u);
        const unsigned gen = old / nloc;
        if (old + 1u == (gen + 1u) * nloc) {
            __builtin_amdgcn_fence(__ATOMIC_RELEASE, "agent");
            asm volatile("s_waitcnt vmcnt(0)" ::: "memory");
            const unsigned og = xb_add(&bar[XB_TOP], 1u);
            const unsigned tg = og / nx;
            if (og + 1u == (tg + 1u) * nx) xb_add(&bar[XB_TOPGEN], 1u);
            else XB_SPIN(xb_ld(&bar[XB_TOPGEN]) == tg, bar);
            __builtin_amdgcn_fence(__ATOMIC_ACQUIRE, "agent");
            xb_add(&bar[XB_XGEN(b.x)], 1u);
            asm volatile("s_waitcnt vmcnt(0)" ::: "memory");
        } else {
            XB_SPIN(xb_ld(&bar[XB_XGEN(b.x)]) == gen, bar);
            __builtin_amdgcn_fence(__ATOMIC_ACQUIRE, "agent");
            asm volatile("s_waitcnt vmcnt(0)" ::: "memory");
        }
    }
    __syncthreads();
}

struct Frame {
    LAS unsigned char* lds;
    int tid, lane, wave, vcu, G;
    const float* in[27];
    float* out; unsigned char* ws;
};
enum { I_X = 0, I_C, I_CTX, I_CCTX, I_WMOD, I_BMOD, I_NORMG, I_FINALG, I_F1IN, I_F1OUT, I_F2IN, I_F2OUT, I_WIN, I_LRE, I_LIM, I_LSTEP, I_BRE, I_BIM, I_CRE, I_CIM, I_SD, I_WGLU, I_WBA, I_POOLW, I_POOLS, I_WBB, I_WOUT };

__device__ __forceinline__ float wave_sum(float v) {
#pragma unroll
    for (int o = 1; o < 64; o <<= 1) v += __shfl_xor(v, o);
    return v;
}

using pg8::Unit; using pg8::BM; using pg8::HALF;
template <int MODE> struct EpiGated {
    static constexpr bool PERM = true;
    bf16* O; int ldo;
    __device__ __forceinline__ void operator()(const f32x4 (&acc)[2][2][4][2], const Unit& u, int wr, int wc, int fr, int fq) const {
        const int row0 = u.pm * BM + wr * 64 + fr, col0 = u.pn * HALF + wc * 32 + 8 * fq;
#pragma unroll
        for (int ai = 0; ai < 2; ++ai)
#pragma unroll
            for (int m = 0; m < 4; ++m) {
                float o[8];
#pragma unroll
                for (int n = 0; n < 2; ++n)
#pragma unroll
                    for (int j = 0; j < 4; ++j) { const float a = acc[ai][0][m][n][j], b = acc[ai][1][m][n][j];
                        o[n * 4 + j] = MODE == 0 ? a * sigmoidf_fast(a) * b : a * sigmoidf_fast(b); }
                v4u w; w.x = cvt_pk_bf16(o[0], o[1]); w.y = cvt_pk_bf16(o[2], o[3]); w.z = cvt_pk_bf16(o[4], o[5]); w.w = cvt_pk_bf16(o[6], o[7]);
                *(v4u*)(O + (size_t)(row0 + ai * HALF + m * 16) * ldo + col0) = w;
            }
    }
};
struct EpiResid {
    static constexpr bool PERM = false;
    const float* in_lat; const float* in_ctx; float* X; const float* mod; int gidx; float coef; float* part;
    __device__ __forceinline__ void operator()(const f32x4 (&acc)[2][2][4][2], const Unit& u, int wr, int wc, int fr, int fq) const {
        const int row0 = u.pm * BM + wr * 64 + fr, col0 = u.pn * BM + wc * 32 + 4 * fq;
        if (u.g != 0) {
#pragma unroll
            for (int ai = 0; ai < 2; ++ai)
#pragma unroll
                for (int m = 0; m < 4; ++m) { float* rowp = part + ((size_t)(u.g - 1) * MC + (size_t)(row0 + ai * HALF + m * 16 - ML)) * D + col0;
#pragma unroll
                    for (int bj = 0; bj < 2; ++bj)
#pragma unroll
                        for (int n = 0; n < 2; ++n) *(f32x4*)(rowp + bj * HALF + n * 16) = acc[ai][bj][m][n]; }
            return;
        }
        const bool isctx = u.pm >= ML / BM; const int mi = isctx ? 4 : (u.pm >> 4);
        const float* gp = mod + (size_t)mi * (NMOD * D) + (size_t)gidx * D + col0;
        f32x4 gv[2][2];
#pragma unroll
        for (int bj = 0; bj < 2; ++bj)
#pragma unroll
            for (int n = 0; n < 2; ++n) gv[bj][n] = *(const f32x4*)(gp + bj * HALF + n * 16) * coef;
        const float* src = isctx ? in_ctx - (size_t)ML * D : in_lat;
#pragma unroll
        for (int ai = 0; ai < 2; ++ai) {
            f32x4 xi[4][2][2];
#pragma unroll
            for (int m = 0; m < 4; ++m) { const size_t off = (size_t)(row0 + ai * HALF + m * 16) * D + col0;
#pragma unroll
                for (int bj = 0; bj < 2; ++bj)
#pragma unroll
                    for (int n = 0; n < 2; ++n) xi[m][bj][n] = *(const f32x4*)(src + off + bj * HALF + n * 16); }
            asm volatile("" ::: "memory");
#pragma unroll
            for (int m = 0; m < 4; ++m) { const size_t off = (size_t)(row0 + ai * HALF + m * 16) * D + col0;
#pragma unroll
                for (int bj = 0; bj < 2; ++bj)
#pragma unroll
                    for (int n = 0; n < 2; ++n) *(f32x4*)(X + off + bj * HALF + n * 16) = xi[m][bj][n] + gv[bj][n] * acc[ai][bj][m][n]; }
            asm volatile("" ::: "memory");
        }
    }
};
struct EpiWin {
    static constexpr bool PERM = true;
    bf16* A2; float* USCP; bf16* UP; bf16* GT;
    __device__ __forceinline__ void operator()(const f32x4 (&acc)[2][2][4][2], const Unit& u, int wr, int wc, int fr, int fq) const {
        const int row0 = u.pm * BM + wr * 64 + fr;
        if (u.g != 0) {
#pragma unroll
            for (int ai = 0; ai < 2; ++ai)
#pragma unroll
                for (int m = 0; m < 4; ++m) { float* rowp = USCP + ((size_t)(u.g - 1) * MC + (size_t)(row0 + ai * HALF + m * 16 - ML)) * SW + u.pn * BM + wc * 32 + 8 * fq;
#pragma unroll
                    for (int bj = 0; bj < 2; ++bj) { *(f32x4*)(rowp + bj * HALF) = acc[ai][bj][m][0]; *(f32x4*)(rowp + bj * HALF + 4) = acc[ai][bj][m][1]; } }
            return;
        }
#pragma unroll
        for (int ai = 0; ai < 2; ++ai)
#pragma unroll
            for (int m = 0; m < 4; ++m) { const int row = row0 + ai * HALF + m * 16;
#pragma unroll
                for (int bj = 0; bj < 2; ++bj) {
                    const int cl = bj * HALF + wc * 32 + 8 * fq;
                    f32x4 v0 = acc[ai][bj][m][0], v1 = acc[ai][bj][m][1];
                    bf16* dst;
                    if (u.pn < 4) {
                        const int c = u.pn * BM + cl;
                        { const int b = row >> 12, t = row & 4095, g = c >> 4, k0 = c & 15;
                               dst = A2 + ((size_t)(g * A2R + b * NCH + (t >> 5)) * A2K + (t & 31) * SK + k0); }
                    } else if (u.pn < 12) {
                        const int ch = (u.pn - 4) * BM + cl, b = row >> 12, t = row & 4095;
                        dst = UP + ((size_t)((b * 256 + (ch >> 3)) * SEQ + t) * 8);
                    } else {
#pragma unroll
                        for (int j = 0; j < 4; ++j) { v0[j] = sigmoidf_fast(v0[j]); v1[j] = sigmoidf_fast(v1[j]); }
                        dst = GT + (size_t)row * (2 * D) + (u.pn - 12) * BM + cl;
                    }
                    v4u w; w.x = cvt_pk_bf16(v0[0], v0[1]); w.y = cvt_pk_bf16(v0[2], v0[3]); w.z = cvt_pk_bf16(v1[0], v1[1]); w.w = cvt_pk_bf16(v1[2], v1[3]);
                    *(v4u*)dst = w; } }
    }
};
struct EpiF32G {
    static constexpr bool PERM = false;
    float* C; int ldc; size_t gs;
    __device__ __forceinline__ void operator()(const f32x4 (&acc)[2][2][4][2], const Unit& u, int wr, int wc, int fr, int fq) const {
        const int row0 = u.pm * BM + wr * 64 + fr, col0 = u.pn * BM + wc * 32 + 4 * fq;
#pragma unroll
        for (int ai = 0; ai < 2; ++ai)
#pragma unroll
            for (int m = 0; m < 4; ++m) { float* rowp = C + (size_t)u.g * gs + (size_t)(row0 + ai * HALF + m * 16) * ldc + col0;
#pragma unroll
                for (int bj = 0; bj < 2; ++bj)
#pragma unroll
                    for (int n = 0; n < 2; ++n) *(f32x4*)(rowp + bj * HALF + n * 16) = acc[ai][bj][m][n]; }
    }
};
__device__ __forceinline__ float gelu_tanh(float x) { const float u2 = 1.5957691216f * (x + 0.044715f * x * x * x); return x * sigmoidf_fast(u2); }
struct EpiY {
    static constexpr bool PERM = true;
    bf16* Z;
    __device__ __forceinline__ void operator()(const f32x4 (&acc)[2][2][4][2], const Unit& u, int wr, int wc, int fr, int fq) const {
        const int row0 = u.pm * BM + wr * 64 + fr;
#pragma unroll
        for (int ai = 0; ai < 2; ++ai)
#pragma unroll
            for (int m = 0; m < 4; ++m) { const int R = row0 + ai * HALF + m * 16, b = R >> 7, cc = R & 127;
#pragma unroll
                for (int bj = 0; bj < 2; ++bj) { const int n_ = u.pn * BM + bj * HALF + wc * 32 + 8 * fq, tl = n_ >> 4, k0 = n_ & 15;
                    float o[8];
#pragma unroll
                    for (int n = 0; n < 2; ++n)
#pragma unroll
                        for (int j = 0; j < 4; ++j) o[n * 4 + j] = gelu_tanh(acc[ai][bj][m][n][j]);
                    v4u w; w.x = cvt_pk_bf16(o[0], o[1]); w.y = cvt_pk_bf16(o[2], o[3]); w.z = cvt_pk_bf16(o[4], o[5]); w.w = cvt_pk_bf16(o[6], o[7]);
                    *(v4u*)(Z + (size_t)(b * SEQ + cc * CT + tl) * SW + u.g * SK + k0) = w; } }
    }
};
struct EpiPool {
    static constexpr bool PERM = true;
    bf16* YB; const float* scale;
    __device__ __forceinline__ void operator()(const f32x4 (&acc)[2][2][4][2], const Unit& u, int wr, int wc, int fr, int fq) const {
        const int row0 = u.pm * BM + wr * 64 + fr, col0 = u.g * 512 + u.pn * BM + wc * 32 + 8 * fq;
        f32x4 sv[2][2];
#pragma unroll
        for (int bj = 0; bj < 2; ++bj)
#pragma unroll
            for (int n = 0; n < 2; ++n) sv[bj][n] = *(const f32x4*)(scale + col0 + bj * HALF + 4 * n);
#pragma unroll
        for (int ai = 0; ai < 2; ++ai)
#pragma unroll
            for (int m = 0; m < 4; ++m) { bf16* rowp = YB + (size_t)(row0 + ai * HALF + m * 16) * PW_ + col0;
#pragma unroll
                for (int bj = 0; bj < 2; ++bj) { const f32x4 v0 = acc[ai][bj][m][0] * sv[bj][0], v1 = acc[ai][bj][m][1] * sv[bj][1];
                    v4u w; w.x = cvt_pk_bf16(v0[0], v0[1]); w.y = cvt_pk_bf16(v0[2], v0[3]); w.z = cvt_pk_bf16(v1[0], v1[1]); w.w = cvt_pk_bf16(v1[2], v1[3]);
                    *(v4u*)(rowp + bj * HALF) = w; } }
    }
};
template <bool ADD> struct EpiBranch {
    static constexpr bool PERM = true;
    bf16* T; const bf16* GT; int goff;
    __device__ __forceinline__ void operator()(const f32x4 (&acc)[2][2][4][2], const Unit& u, int wr, int wc, int fr, int fq) const {
        const int row0 = u.pm * BM + wr * 64 + fr, col0 = u.pn * BM + wc * 32 + 8 * fq;
#pragma unroll
        for (int ai = 0; ai < 2; ++ai) {
            v4u gws[4][2], tws[4][2];
#pragma unroll
            for (int m = 0; m < 4; ++m) { const size_t row = (size_t)(row0 + ai * HALF + m * 16);
#pragma unroll
                for (int bj = 0; bj < 2; ++bj) { gws[m][bj] = *(const v4u*)(GT + row * (2 * D) + goff + col0 + bj * HALF);
                    if (ADD) tws[m][bj] = *(const v4u*)(T + row * D + col0 + bj * HALF); else tws[m][bj] = (v4u){0u, 0u, 0u, 0u}; } }
            asm volatile("" ::: "memory");
#pragma unroll
            for (int m = 0; m < 4; ++m) { const size_t row = (size_t)(row0 + ai * HALF + m * 16);
#pragma unroll
                for (int bj = 0; bj < 2; ++bj) {
                    const v4u gw = gws[m][bj]; const v4u tw = tws[m][bj];
                    bf16* tp = T + row * D + col0 + bj * HALF;
                    float o[8]; const f32x4 v0 = acc[ai][bj][m][0], v1 = acc[ai][bj][m][1];
                    o[0] = bf_lo(gw.x) * v0[0]; o[1] = bf_hi(gw.x) * v0[1]; o[2] = bf_lo(gw.y) * v0[2]; o[3] = bf_hi(gw.y) * v0[3];
                    o[4] = bf_lo(gw.z) * v1[0]; o[5] = bf_hi(gw.z) * v1[1]; o[6] = bf_lo(gw.w) * v1[2]; o[7] = bf_hi(gw.w) * v1[3];
                    if (ADD) { o[0] += bf_lo(tw.x); o[1] += bf_hi(tw.x); o[2] += bf_lo(tw.y); o[3] += bf_hi(tw.y); o[4] += bf_lo(tw.z); o[5] += bf_hi(tw.z); o[6] += bf_lo(tw.w); o[7] += bf_hi(tw.w); }
                    v4u w; w.x = cvt_pk_bf16(o[0], o[1]); w.y = cvt_pk_bf16(o[2], o[3]); w.z = cvt_pk_bf16(o[4], o[5]); w.w = cvt_pk_bf16(o[6], o[7]);
                    *(v4u*)tp = w; } }
            asm volatile("" ::: "memory");
        }
    }
};

__device__ __forceinline__ void p0_mod(Frame& F) {
    LAS float* sc = (LAS float*)(F.lds);
    LAS float* red = (LAS float*)(F.lds + 81920);
    const float* c = F.in[I_C]; const float* cctx = F.in[I_CCTX]; const float* wmod = F.in[I_WMOD]; const float* bmod = F.in[I_BMOD];
    float* mod = (float*)(F.ws + WS_MOD);
    for (int i = F.tid; i < 5 * D; i += NWAVES * 64) { const int v = i >> 12, k = i & (D - 1); const float x = v < 4 ? c[v * D + k] : cctx[k]; sc[i] = x * sigmoidf_fast(x); }
    __syncthreads();
    const int col4 = F.tid % 36, ksub = F.tid / 36;
    for (int chunk = blockIdx.x; chunk < 256; chunk += F.G) {
        float acc[5][4];
#pragma unroll
        for (int v = 0; v < 5; ++v)
#pragma unroll
            for (int e = 0; e < 4; ++e) acc[v][e] = 0.f;
        if (ksub < 14) {
            const float* wp = wmod + (size_t)chunk * 144 + col4 * 4;
#pragma unroll 8
            for (int k = ksub; k < D; k += 14) { const f32x4 w = __builtin_nontemporal_load((const f32x4*)(wp + (size_t)k * (NMOD * D)));
#pragma unroll
                for (int v = 0; v < 5; ++v) { const float s = sc[v * D + k];
#pragma unroll
                    for (int e = 0; e < 4; ++e) acc[v][e] += s * w[e]; } }
#pragma unroll
            for (int v = 0; v < 5; ++v)
#pragma unroll
                for (int e = 0; e < 4; ++e) red[(ksub * 36 + col4) * 20 + v * 4 + e] = acc[v][e];
        }
        __syncthreads();
        for (int o = F.tid; o < 720; o += NWAVES * 64) { const int v = o / 144, cl = o % 144; float s = bmod[chunk * 144 + cl];
#pragma unroll
            for (int q = 0; q < 14; ++q) s += red[(q * 36 + (cl >> 2)) * 20 + v * 4 + (cl & 3)];
            mod[(size_t)v * (NMOD * D) + chunk * 144 + cl] = s; }
        __syncthreads();
    }
}

__device__ __forceinline__ void p0_transpose_item(const float* W, int N, bf16* WT, int ldt, int dst_row0, LAS float* scr, int k0, int n0, int lane) {
    f32x4 v[16];
    const float* src = W + (size_t)(k0 + (lane >> 4)) * N + n0 + (lane & 15) * 4;
#pragma unroll
    for (int i = 0; i < 16; ++i) v[i] = __builtin_nontemporal_load((const f32x4*)(src + (size_t)(4 * i) * N));
#pragma unroll
    for (int i = 0; i < 16; ++i) { LAS float* d = scr + (4 * i + (lane >> 4)) * 65 + (lane & 15) * 4; d[0] = v[i].x; d[1] = v[i].y; d[2] = v[i].z; d[3] = v[i].w; }
    LDS_WAIT(); asm volatile("" ::: "memory");
    const int c = lane >> 3, nn = lane & 7;
#pragma unroll
    for (int j = 0; j < 8; ++j) { const int n = nn + 8 * j; const LAS float* s = scr + (8 * c) * 65 + n;
        v4u o; o.x = cvt_pk_bf16(s[0 * 65], s[1 * 65]); o.y = cvt_pk_bf16(s[2 * 65], s[3 * 65]); o.z = cvt_pk_bf16(s[4 * 65], s[5 * 65]); o.w = cvt_pk_bf16(s[6 * 65], s[7 * 65]);
        __builtin_nontemporal_store(o, (GAS v4u*)(WT + (size_t)(dst_row0 + n) * ldt + k0 + 8 * c)); }
    LDS_WAIT(); asm volatile("" ::: "memory");
}
constexpr int IT_FA = (D / 64) * (2 * DFF / 64), IT_FB = (DFF / 64) * (D / 64), IT_WIN = (D / 64) * (DIN / 64), IT_GLU = (SW / 64) * (2 * SW / 64), IT_WA = (SW / 64) * (D / 64),
              IT_POOL = 4 * (512 / 64) * (512 / 64), IT_WB = (PW_ / 64) * (D / 64), IT_WOUT = (D / 64) * (D / 64);
constexpr int Q_W1A = IT_FA, Q_W1B = Q_W1A + IT_FB, Q_WIN = Q_W1B + IT_WIN, Q_POOL = Q_WIN + IT_POOL, Q_WB = Q_POOL + IT_WB, Q_GLU = Q_WB + IT_GLU, Q_WA = Q_GLU + IT_WA,
              Q_WOUT = Q_WA + IT_WOUT, Q_W2A = Q_WOUT + IT_FA, Q_W2B = Q_W2A + IT_FB;
constexpr int IT_TOTAL = Q_W2B;
__device__ __forceinline__ int gated_row(int n0, int half) { const int j = n0 < half ? n0 : n0 - half; return (j >> 7) * 256 + (j & 127) + (n0 < half ? 0 : 128); }
__device__ __forceinline__ void p0_one_item(Frame& F, int r, LAS float* scr) {
    unsigned char* ws = F.ws; const int lane = F.lane;
#define TR_PLAIN(W, Kd, Nd, WT) do { const int nblk = (Nd) / 64, kb = r / nblk, nb = r % nblk; p0_transpose_item(W, Nd, (bf16*)(WT), Kd, 64 * nb, scr, 64 * kb, 64 * nb, lane); } while (0)
#define TR_GATED(W, Kd, Nd, WT) do { const int nblk = (Nd) / 64, kb = r / nblk, nb = r % nblk; p0_transpose_item(W, Nd, (bf16*)(WT), Kd, gated_row(64 * nb, (Nd) / 2), scr, 64 * kb, 64 * nb, lane); } while (0)
    if (r < IT_FA) { TR_GATED(F.in[I_F1IN], D, 2 * DFF, ws + WS_W1A); return; } r -= IT_FA;
    if (r < IT_FB) { TR_PLAIN(F.in[I_F1OUT], DFF, D, ws + WS_W1B); return; } r -= IT_FB;
    if (r < IT_WIN) { TR_PLAIN(F.in[I_WIN], D, DIN, ws + WS_WIN); return; } r -= IT_WIN;
    if (r < IT_POOL) { const int gi = r / 64; r %= 64; TR_PLAIN(F.in[I_POOLW] + (size_t)gi * 512 * 512, 512, 512, ws + WS_WPOOL + (size_t)gi * 512 * 512 * 2); return; } r -= IT_POOL;
    if (r < IT_WB) { TR_PLAIN(F.in[I_WBB], PW_, D, ws + WS_WB); return; } r -= IT_WB;
    if (r < IT_GLU) { TR_GATED(F.in[I_WGLU], SW, 2 * SW, ws + WS_WGLU); return; } r -= IT_GLU;
    if (r < IT_WA) { TR_PLAIN(F.in[I_WBA], SW, D, ws + WS_WA); return; } r -= IT_WA;
    if (r < IT_WOUT) { TR_PLAIN(F.in[I_WOUT], D, D, ws + WS_WOUT); return; } r -= IT_WOUT;
    if (r < IT_FA) { TR_GATED(F.in[I_F2IN], D, 2 * DFF, ws + WS_W2A); return; } r -= IT_FA;
    TR_PLAIN(F.in[I_F2OUT], DFF, D, ws + WS_W2B);
#undef TR_PLAIN
#undef TR_GATED
}
__device__ __forceinline__ bool fill_transposes(Frame& F, int mandatory, unsigned* done_ctr) {
    LAS float* scr = (LAS float*)(F.lds + F.wave * 16640);
    volatile LAS int* sh = (volatile LAS int*)(F.lds + MISC_OFF + 64);
    unsigned* q = (unsigned*)(F.ws + WS_CTL) + CW_QUEUE;
    constexpr int PER_WAVE = 2, CHB = PER_WAVE * NWAVES;
    for (;;) {
        if (F.tid == 0) { int base = -1; const int head = (int)__hip_atomic_load(q, __ATOMIC_RELAXED, __HIP_MEMORY_SCOPE_AGENT);
            const bool go = head < mandatory || (head < IT_TOTAL && done_ctr != nullptr && __hip_atomic_load(done_ctr, __ATOMIC_RELAXED, __HIP_MEMORY_SCOPE_AGENT) < (unsigned)F.G);
            if (go) { base = (int)__hip_atomic_fetch_add(q, (unsigned)CHB, __ATOMIC_RELAXED, __HIP_MEMORY_SCOPE_AGENT); if (base >= IT_TOTAL) base = -2; }
            else if (head >= IT_TOTAL) base = -2;
            sh[0] = base; }
        __syncthreads();
        const int base = sh[0];
        __syncthreads();
        if (base < 0) return base == -2;
        const int b0 = base + F.wave * PER_WAVE, end = b0 + PER_WAVE < IT_TOTAL ? b0 + PER_WAVE : IT_TOTAL;
        for (int it = b0; it < end; ++it) p0_one_item(F, it, scr);
    }
}
__device__ __forceinline__ void phase_done(Frame& F, unsigned* done_ctr) {
    __syncthreads();
    if (F.tid == 0) __hip_atomic_fetch_add(done_ctr, 1u, __ATOMIC_RELAXED, __HIP_MEMORY_SCOPE_AGENT);
}

typedef float f32x2 __attribute__((ext_vector_type(2)));
constexpr int KFS = 272;
__device__ __forceinline__ void p0_ssm_part(Frame& F, int g, int part) {
    LAS f32x2* PWR = (LAS f32x2*)(F.lds);
    LAS f32x2* BB = (LAS f32x2*)(F.lds + 33792);
    LAS f32x2* CC = (LAS f32x2*)(F.lds + 33792 + 16384);
    LAS float* KF = (LAS float*)(F.lds + 33792 + 32768);
    const int tid = F.tid;
    if (tid < 128) {
        const int dir = tid >> 6, p = tid & 63, idx = (dir * SG + g) * SP + p;
        const double lr = fmin((double)F.in[I_LRE][idx], -1e-4), li = (double)F.in[I_LIM][idx], st = exp((double)F.in[I_LSTEP][dir * SG + g]);
        const double mag = exp(lr * st), ang = li * st, lbr = mag * cos(ang), lbi = mag * sin(ang);
        const double nr = lbr - 1.0, ni = lbi, den = lr * lr + li * li, fr_ = (nr * lr + ni * li) / den, fi_ = (ni * lr - nr * li) / den;
        double pr = 1.0, pi = 0.0;
        for (int tau = 0; tau <= CT; ++tau) { PWR[(dir * SP + p) * 33 + tau] = (f32x2){(float)pr, (float)pi}; const double t = pr * lbr - pi * lbi; pi = pr * lbi + pi * lbr; pr = t; }
        f32x2* bbar = (f32x2*)(F.ws + WS_BBAR);
        for (int k = 0; k < SK; ++k) { const double br = (double)F.in[I_BRE][idx * SK + k], bi = (double)F.in[I_BIM][idx * SK + k];
            const f32x2 bb = (f32x2){(float)(fr_ * br - fi_ * bi), (float)(fr_ * bi + fi_ * br)}; BB[(dir * SP + p) * SK + k] = bb; if (part == 0) bbar[(size_t)idx * SK + k] = bb; }
        if (part == 0) { f32x2* lamb = (f32x2*)(F.ws + WS_LAMB); f32x2* lamT = (f32x2*)(F.ws + WS_LAMB + 65536);
            lamb[idx] = (f32x2){(float)lbr, (float)lbi}; lamT[idx] = PWR[(dir * SP + p) * 33 + CT]; }
    }
    for (int o = tid; o < 2048; o += NWAVES * 64) { const int dir = o >> 10, k = (o >> 6) & 15, p = o & 63, cidx = ((dir * SG + g) * SK + k) * SP + p; CC[(dir * SP + p) * SK + k] = (f32x2){F.in[I_CRE][cidx], F.in[I_CIM][cidx]}; }
    __syncthreads();
    for (int combo = tid; combo < 1024; combo += NWAVES * 64) { const int dir = combo >> 9, tau = (combo >> 4) & 31, k = combo & 15;
        float a[16];
#pragma unroll
        for (int e = 0; e < 16; ++e) a[e] = 0.f;
        for (int p = 0; p < SP; ++p) { const f32x2 c = CC[(dir * SP + p) * SK + k], w = PWR[(dir * SP + p) * 33 + tau]; const float gr = c.x * w.x - c.y * w.y, gi = c.x * w.y + c.y * w.x;
#pragma unroll
            for (int e = 0; e < 16; ++e) { const f32x2 b = BB[(dir * SP + p) * SK + e]; a[e] += gr * b.x - gi * b.y; } }
#pragma unroll
        for (int e = 0; e < 16; ++e) KF[(dir * CT + tau) * KFS + k * SK + e] = a[e]; }
    __syncthreads();
    bf16* bty = (bf16*)(F.ws + WS_BTY) + (size_t)g * (CT * SK) * A2K;
    const float* dvec = F.in[I_SD] + g * SK;
    for (int ch = tid; ch < 128 * (A2K / 8); ch += NWAVES * 64) { const int n = part * 128 + ch / (A2K / 8), q = ch % (A2K / 8), t = n >> 4, k = n & 15;
        float v[8];
        if (q < 64) { const int s = q >> 1, k0 = (q & 1) * 8;
            f32x4 x0 = (f32x4){0.f, 0.f, 0.f, 0.f}, x1 = x0;
            if (t >= s) { const LAS f32x4* kp = (const LAS f32x4*)(KF + (t - s) * KFS + k * SK + k0); x0 += kp[0]; x1 += kp[1]; }
            if (s >= t) { const LAS f32x4* kp = (const LAS f32x4*)(KF + (CT + (s - t)) * KFS + k * SK + k0); x0 += kp[0]; x1 += kp[1]; }
            v[0] = x0.x; v[1] = x0.y; v[2] = x0.z; v[3] = x0.w; v[4] = x1.x; v[5] = x1.y; v[6] = x1.z; v[7] = x1.w;
            if (t == s && (k >> 3) == (q & 1)) { const float dk = dvec[k];
#pragma unroll
                for (int e = 0; e < 8; ++e) v[e] += ((k & 7) == e) ? dk : 0.f; }
        } else { const int pt = (q - 64) >> 3, p0 = ((q - 64) & 7) * 8, dir = pt >> 1, tau = dir == 0 ? t + 1 : CT - t;
#pragma unroll
            for (int e = 0; e < 8; ++e) { const int p = p0 + e; const f32x2 c = CC[(dir * SP + p) * SK + k], w = PWR[(dir * SP + p) * 33 + tau];
                const float re = c.x * w.x - c.y * w.y, im = c.x * w.y + c.y * w.x; v[e] = (pt & 1) ? -im : re; }
        }
        v4u o; o.x = cvt_pk_bf16(v[0], v[1]); o.y = cvt_pk_bf16(v[2], v[3]); o.z = cvt_pk_bf16(v[4], v[5]); o.w = cvt_pk_bf16(v[6], v[7]);
        *(v4u*)(bty + (size_t)n * A2K + q * 8) = o; }
    bf16* bts = (bf16*)(F.ws + WS_BTS) + (size_t)g * 256 * (CT * SK);
    for (int ch = tid; ch < 64 * 64; ch += NWAVES * 64) { const int p = ch >> 6, q = ch & 63, pt = part, n = pt * 64 + p, dir = pt >> 1, s = q >> 1, k0 = (q & 1) * 8, tau = dir == 0 ? CT - 1 - s : s;
        const f32x2 w = PWR[(dir * SP + p) * 33 + tau]; float v[8];
#pragma unroll
        for (int e = 0; e < 8; ++e) { const f32x2 b = BB[(dir * SP + p) * SK + k0 + e]; const float re = w.x * b.x - w.y * b.y, im = w.x * b.y + w.y * b.x; v[e] = (pt & 1) ? im : re; }
        v4u o; o.x = cvt_pk_bf16(v[0], v[1]); o.y = cvt_pk_bf16(v[2], v[3]); o.z = cvt_pk_bf16(v[4], v[5]); o.w = cvt_pk_bf16(v[6], v[7]);
        *(v4u*)(bts + (size_t)n * (CT * SK) + q * 8) = o; }
    __syncthreads();
}

template <bool FINAL, bool CTXSUM = false>
__device__ __forceinline__ void norm_rows(Frame& F, const float* in_lat, const float* in_ctx, int nrows, const float* gvec, int shift_idx, int scale_idx, bf16* outb, float* outf, const float* part = nullptr) {
    const int gw = F.vcu * NWAVES + F.wave, NGW = F.G * NWAVES;
    const float* mod = (const float*)(F.ws + WS_MOD);
    for (int m = gw; m < nrows; m += NGW) {
        const bool isctx = m >= ML; const int mi = isctx ? 4 : (m >> 12);
        const f32x4* xr = (const f32x4*)(isctx ? in_ctx + (size_t)(m - ML) * D : in_lat + (size_t)m * D) + F.lane;
        f32x4 v[16]; float ss = 0.f;
        if (CTXSUM && isctx) {
            const f32x4* p0 = (const f32x4*)(part + (size_t)(m - ML) * D) + F.lane;
#pragma unroll
            for (int j = 0; j < 16; ++j) v[j] = p0[64 * j];
#pragma unroll
            for (int sp = 1; sp < 4; ++sp) { const f32x4* ps = p0 + (size_t)sp * MC * (D / 4);
#pragma unroll
                for (int j = 0; j < 16; ++j) v[j] += ps[64 * j]; }
            const f32x4* gt = (const f32x4*)(mod + (size_t)4 * (NMOD * D) + (size_t)2 * D) + F.lane;
#pragma unroll
            for (int j = 0; j < 16; ++j) v[j] = xr[64 * j] + (gt[64 * j] * 0.5f) * v[j];
#pragma unroll
            for (int j = 0; j < 16; ++j) ss += (v[j].x * v[j].x + v[j].y * v[j].y) + (v[j].z * v[j].z + v[j].w * v[j].w);
        } else {
#pragma unroll
        for (int j = 0; j < 16; ++j) { v[j] = xr[64 * j]; ss += (v[j].x * v[j].x + v[j].y * v[j].y) + (v[j].z * v[j].z + v[j].w * v[j].w); }
        }
        const float rstd = 1.0f / sqrtf(wave_sum(ss) * (1.0f / D) + RMS_EPS);
        const f32x4* gp = (const f32x4*)gvec + F.lane;
        if constexpr (FINAL) {
            f32x4* op = (f32x4*)(outf + (size_t)m * D) + F.lane;
#pragma unroll
            for (int j = 0; j < 16; ++j) op[64 * j] = v[j] * rstd * gp[64 * j];
        } else {
            const f32x4* shp = (const f32x4*)(mod + (size_t)mi * (NMOD * D) + (size_t)shift_idx * D) + F.lane;
            const f32x4* scp = (const f32x4*)(mod + (size_t)mi * (NMOD * D) + (size_t)scale_idx * D) + F.lane;
            v2u* op = (v2u*)(outb + (size_t)m * D) + F.lane;
#pragma unroll
            for (int j = 0; j < 16; ++j) { const f32x4 o = (v[j] * rstd * gp[64 * j]) * (scp[64 * j] + 1.0f) + shp[64 * j];
                v2u w; w.x = cvt_pk_bf16(o.x, o.y); w.y = cvt_pk_bf16(o.z, o.w); op[64 * j] = w; }
        }
    }
}

template <bool FINAL>
__device__ __forceinline__ void norm_prep(Frame& F, LAS float* LA, LAS float* LB, const float* gvec, const float* mod, int mi, int shift_idx, int scale_idx) {
    for (int c = F.tid; c < D; c += NWAVES * 64) { const float g = gvec[c];
        if (FINAL) { LA[c] = g; LB[c] = 0.f; }
        else { LA[c] = g * (1.0f + mod[(size_t)mi * (NMOD * D) + (size_t)scale_idx * D + c]); LB[c] = mod[(size_t)mi * (NMOD * D) + (size_t)shift_idx * D + c]; } }
}
#define NIDX(j) (((j) >> 1) * 128 + ((j) & 1))
template <bool FINAL>
__device__ __forceinline__ void norm_row_out(Frame& F, const f32x4 (&v)[16], const LAS float* LA, const LAS float* LB, bf16* outb, float* outf, size_t m) {
    float ss = 0.f;
#pragma unroll
    for (int j = 0; j < 16; ++j) ss += (v[j].x * v[j].x + v[j].y * v[j].y) + (v[j].z * v[j].z + v[j].w * v[j].w);
    const float rstd = 1.0f / sqrtf(wave_sum(ss) * (1.0f / D) + RMS_EPS);
    const LAS f32x4* la = (const LAS f32x4*)LA + 2 * F.lane; const LAS f32x4* lb = (const LAS f32x4*)LB + 2 * F.lane;
    if constexpr (FINAL) { f32x4* op = (f32x4*)(outf + m * D) + 2 * F.lane;
#pragma unroll
        for (int j = 0; j < 16; ++j) op[NIDX(j)] = (v[j] * rstd) * la[NIDX(j)];
    } else { v4u* op = (v4u*)(outb + m * D) + F.lane;
#pragma unroll
        for (int jj = 0; jj < 8; ++jj) { const f32x4 o0 = (v[2 * jj] * rstd) * la[128 * jj] + lb[128 * jj], o1 = (v[2 * jj + 1] * rstd) * la[128 * jj + 1] + lb[128 * jj + 1];
            v4u w; w.x = cvt_pk_bf16(o0.x, o0.y); w.y = cvt_pk_bf16(o0.z, o0.w); w.z = cvt_pk_bf16(o1.x, o1.y); w.w = cvt_pk_bf16(o1.z, o1.w); op[64 * jj] = w; } }
}
template <bool FINAL, bool CTXSUM>
__device__ __forceinline__ void norm_phase(Frame& F, const float* in_lat, const float* in_ctx, bool do_ctx, const float* gvec, int shift_idx, int scale_idx, bf16* outb, float* outf, const float* part) {
    LAS float* LA = (LAS float*)F.lds; LAS float* LB = LA + D;
    const float* mod = (const float*)(F.ws + WS_MOD);
    const int nb = F.G / 4, b = (int)blockIdx.x / nb, bi = (int)blockIdx.x % nb;
    norm_prep<FINAL>(F, LA, LB, gvec, mod, b, shift_idx, scale_idx);
    __syncthreads();
    {
        f32x4 va[16], vb[16];
        int k = F.wave;
#define NP_ROW(kk) ((size_t)b * SEQ + bi + (size_t)nb * (kk))
#define NP_VALID(kk) (bi + nb * (kk) < SEQ)
#define NP_LOAD(dst, kk) do { const f32x4* xr_ = (const f32x4*)(in_lat + NP_ROW(kk) * D) + 2 * F.lane; _Pragma("unroll") for (int j = 0; j < 16; ++j) dst[j] = xr_[NIDX(j)]; } while (0)
        if (NP_VALID(k)) {
            NP_LOAD(va, k);
            for (;;) {
                const int k2 = k + NWAVES; const bool has2 = NP_VALID(k2);
                if (has2) NP_LOAD(vb, k2);
                norm_row_out<FINAL>(F, va, LA, LB, outb, outf, NP_ROW(k));
                if (!has2) break;
                const int k3 = k2 + NWAVES; const bool has3 = NP_VALID(k3);
                if (has3) NP_LOAD(va, k3);
                norm_row_out<FINAL>(F, vb, LA, LB, outb, outf, NP_ROW(k2));
                if (!has3) break;
                k = k3;
            }
        }
#undef NP_ROW
#undef NP_VALID
#undef NP_LOAD
    }
    if (do_ctx) {
        __syncthreads();
        norm_prep<FINAL>(F, LA, LB, gvec, mod, 4, shift_idx, scale_idx);
        __syncthreads();
        for (int r = (int)blockIdx.x + F.G * F.wave; r < MC; r += F.G * NWAVES) {
            const f32x4* xr = (const f32x4*)(in_ctx + (size_t)r * D) + 2 * F.lane; f32x4 v[16];
            if constexpr (CTXSUM) {
                const f32x4* ps = (const f32x4*)(part + (size_t)r * D) + 2 * F.lane;
#pragma unroll
                for (int j = 0; j < 16; ++j) v[j] = (f32x4){0.f, 0.f, 0.f, 0.f};
#pragma unroll 1
                for (int sp = 0; sp < 4; ++sp) {
#pragma unroll
                    for (int j = 0; j < 16; ++j) v[j] += ps[NIDX(j)];
                    ps += (size_t)MC * (D / 4); }
                const f32x4* gt = (const f32x4*)(mod + (size_t)4 * (NMOD * D) + (size_t)2 * D) + 2 * F.lane;
#pragma unroll
                for (int j = 0; j < 16; ++j) v[j] = xr[NIDX(j)] + (gt[NIDX(j)] * 0.5f) * v[j];
            } else {
#pragma unroll
                for (int j = 0; j < 16; ++j) v[j] = xr[NIDX(j)];
            }
            norm_row_out<FINAL>(F, v, LA, LB, outb, outf, (size_t)ML + r);
        }
    }
    __syncthreads();
}

__device__ __forceinline__ void ctx_scan(Frame& F) {
    const f32x2* bbar = (const f32x2*)(F.ws + WS_BBAR); const f32x2* lamb = (const f32x2*)(F.ws + WS_LAMB); f32x2* hctx = (f32x2*)(F.ws + WS_LAMB + 131072);
    const float* uscp = (const float*)(F.ws + WS_Z);
    LAS float* LU = (LAS float*)F.lds;
    for (int bg = blockIdx.x; bg < BATCH * SG; bg += F.G) {
        const int b = bg >> 6, g = bg & 63;
        for (int i = F.tid; i < CTXL * 4; i += NWAVES * 64) { const int t = i >> 2, q = i & 3; const float* src = uscp + (size_t)(b * CTXL + t) * SW + g * SK + q * 4;
            f32x4 v = *(const f32x4*)src;
#pragma unroll
            for (int sp = 1; sp < 4; ++sp) v += *(const f32x4*)(src + (size_t)sp * MC * SW);
            *(LAS f32x4*)(LU + t * 16 + q * 4) = v; }
        __syncthreads();
        if (F.wave < 2) {
            const int dir = F.wave, p = F.lane, idx = (dir * SG + g) * SP + p;
            f32x2 bb[16];
#pragma unroll
            for (int k = 0; k < 16; ++k) bb[k] = bbar[(size_t)idx * SK + k];
            const f32x2 lam = lamb[idx]; float hr = 0.f, hi = 0.f;
#pragma unroll 4
            for (int s_ = 0; s_ < CTXL; ++s_) { const int t = dir == 0 ? s_ : CTXL - 1 - s_;
                const LAS f32x4* up = (const LAS f32x4*)(LU + t * 16); float br = 0.f, bi = 0.f;
#pragma unroll
                for (int q = 0; q < 4; ++q) { const f32x4 u4 = up[q];
#pragma unroll
                    for (int e = 0; e < 4; ++e) { br += bb[q * 4 + e].x * u4[e]; bi += bb[q * 4 + e].y * u4[e]; } }
                const float nr = lam.x * hr - lam.y * hi + br, ni = lam.x * hi + lam.y * hr + bi; hr = nr; hi = ni; }
            hctx[((dir * BATCH + b) * SG + g) * SP + p] = (f32x2){hr, hi};
        }
        __syncthreads();
    }
}
__device__ __forceinline__ void chunk_recurrence(Frame& F) {
    const f32x2* lamT = (const f32x2*)(F.ws + WS_LAMB + 65536); const f32x2* hctx = (const f32x2*)(F.ws + WS_LAMB + 131072);
    const float* S = (const float*)(F.ws + WS_S); bf16* A2 = (bf16*)(F.ws + WS_A2);
    LAS float* LS = (LAS float*)F.lds;
    for (int gb = blockIdx.x; gb < SG * BATCH; gb += F.G) {
        const int g = gb >> 2, b = gb & 3; const size_t row0 = (size_t)g * A2R + b * NCH;
        const f32x4* src = (const f32x4*)(S + row0 * 256);
#pragma unroll
        for (int i = 0; i < 16; ++i) { const int o = i * (NWAVES * 64) + F.tid; ((LAS f32x4*)LS)[o] = src[o]; }
        __syncthreads();
        if (F.wave < 2) {
            const int dir = F.wave, p = F.lane;
            const f32x2 lt = lamT[(dir * SG + g) * SP + p]; const f32x2 h0 = hctx[((dir * BATCH + b) * SG + g) * SP + p]; float hr = h0.x, hi = h0.y;
#pragma unroll 4
            for (int s_ = 0; s_ < NCH; ++s_) { const int c = dir == 0 ? s_ : NCH - 1 - s_;
                const float sr = LS[c * 256 + dir * 128 + p], si = LS[c * 256 + dir * 128 + 64 + p];
                bf16* ap = A2 + (row0 + c) * A2K + CT * SK + dir * 128 + p;
                ap[0] = (bf16)(cvt_pk_bf16(hr, 0.f) & 0xffffu); ap[64] = (bf16)(cvt_pk_bf16(hi, 0.f) & 0xffffu);
                const float nr = lt.x * hr - lt.y * hi + sr, ni = lt.x * hi + lt.y * hr + si; hr = nr; hi = ni; }
        }
        __syncthreads();
    }
}
__device__ __forceinline__ void pool_units(Frame& F) {
    LAS float* L = (LAS float*)(F.lds); constexpr int RS = 520;
    const bf16* UP = (const bf16*)(F.ws + WS_UP); bf16* MIX = (bf16*)(F.ws + WS_MIX);
    const int tid = F.tid;
    const bool bal = F.G == 256; const int bx = (int)blockIdx.x, nmine = bal ? (bx < 128 ? 3 : 5) : (BATCH * 256 - bx + F.G - 1) / F.G;
    const int vr = (bx & 7) * 16 + ((bx >> 3) - 16);
    for (int ui = 0; ui < nmine; ++ui) {
        const int unit = !bal ? bx + ui * F.G : (ui < 3 ? F.vcu + ui * 256 : (ui == 3 ? 768 + vr : 896 + vr));
        const int b = unit >> 8, slice = unit & 255, w = 2 << (slice >> 6), hw = w >> 1;
        const v4u* src = (const v4u*)(UP + (size_t)(b * 256 + slice) * SEQ * 8);
        v4u keep[8];
#pragma unroll
        for (int i = 0; i < 8; ++i) { const int tok = i * 512 + tid; keep[i] = src[tok]; }
#pragma unroll
        for (int i = 0; i < 8; ++i) { const int tok = i * 512 + tid, r = tok >> 6, c = tok & 63; LAS f32x4* d = (LAS f32x4*)(L + r * RS + c * 8);
            d[0] = (f32x4){bf_lo(keep[i].x), bf_hi(keep[i].x), bf_lo(keep[i].y), bf_hi(keep[i].y)}; d[1] = (f32x4){bf_lo(keep[i].z), bf_hi(keep[i].z), bf_lo(keep[i].w), bf_hi(keep[i].w)}; }
        __syncthreads();
        { const int r = tid >> 3, ch = tid & 7; LAS float* p = L + r * RS + ch; float run = 0.f;
#pragma unroll 8
          for (int c = 0; c < 64; ++c) { run += p[c * 8]; p[c * 8] = run; } }
        __syncthreads();
        { const int c = tid >> 3, ch = tid & 7; LAS float* p = L + c * 8 + ch; float run = 0.f;
#pragma unroll 8
          for (int r = 0; r < 64; ++r) { run += p[r * RS]; p[r * RS] = run; } }
        __syncthreads();
#pragma unroll
        for (int i = 0; i < 8; ++i) { const int tok = i * 512 + tid, r = tok >> 6, c = tok & 63;
            const int rlo = r - hw < 0 ? 0 : r - hw, rhi = r + hw > 64 ? 64 : r + hw, clo = c - hw < 0 ? 0 : c - hw, chi = c + hw > 64 ? 64 : c + hw;
            const float inv = 1.0f / (float)((rhi - rlo) * (chi - clo));
            f32x4 s0, s1;
            { const LAS f32x4* q = (const LAS f32x4*)(L + (rhi - 1) * RS + (chi - 1) * 8); s0 = q[0]; s1 = q[1]; }
            if (rlo > 0) { const LAS f32x4* q = (const LAS f32x4*)(L + (rlo - 1) * RS + (chi - 1) * 8); s0 -= q[0]; s1 -= q[1]; }
            if (clo > 0) { const LAS f32x4* q = (const LAS f32x4*)(L + (rhi - 1) * RS + (clo - 1) * 8); s0 -= q[0]; s1 -= q[1]; }
            if (rlo > 0 && clo > 0) { const LAS f32x4* q = (const LAS f32x4*)(L + (rlo - 1) * RS + (clo - 1) * 8); s0 += q[0]; s1 += q[1]; }
            const f32x4 v0 = (f32x4){bf_lo(keep[i].x), bf_hi(keep[i].x), bf_lo(keep[i].y), bf_hi(keep[i].y)}, v1 = (f32x4){bf_lo(keep[i].z), bf_hi(keep[i].z), bf_lo(keep[i].w), bf_hi(keep[i].w)};
            const f32x4 o0 = s0 * inv - v0, o1 = s1 * inv - v1;
            v4u wv; wv.x = cvt_pk_bf16(o0.x, o0.y); wv.y = cvt_pk_bf16(o0.z, o0.w); wv.z = cvt_pk_bf16(o1.x, o1.y); wv.w = cvt_pk_bf16(o1.z, o1.w);
            *(v4u*)(MIX + (size_t)(b * SEQ + tok) * PW_ + slice * 8) = wv; }
        __syncthreads();
    }
}

constexpr int NPHASES = 16;
#ifndef WGM_FFN
#define WGM_FFN 8
#endif
#ifndef DUP_MASK
#define DUP_MASK 0
#endif
#ifndef DUP_SUB
#define DUP_SUB 0
#endif
#define REPS(k) _Pragma("unroll") for (int rep_ = 0; rep_ < ((((DUP_MASK) >> (k)) & 1) ? 2 : 1); ++rep_)
#ifndef MK_N_LAUNCHES
#define MK_N_LAUNCHES 1
#endif
struct Args { const float* in[27]; float* out; unsigned char* ws; int ph_lo, ph_hi; };
static_assert(sizeof(Args) == 27 * 8 + 8 + 8 + 8, "Args has no padding");

__global__ void __launch_bounds__(NWAVES * 64, 2) fwd_kernel(Args args) {
    extern __shared__ __attribute__((aligned(16))) unsigned char lds[];
    Frame F;
    F.lds = (LAS unsigned char*)lds;
    F.tid = threadIdx.x; F.lane = F.tid & 63; F.wave = __builtin_amdgcn_readfirstlane(F.tid >> 6);
    F.G = gridDim.x; { const int bx = blockIdx.x; F.vcu = (F.G % 8 == 0) ? (bx % 8) * (F.G / 8) + bx / 8 : bx; }
#pragma unroll
    for (int i = 0; i < 27; ++i) F.in[i] = args.in[i];
    F.out = args.out; F.ws = args.ws;
    volatile LAS unsigned* MISC = (volatile LAS unsigned*)(F.lds + MISC_OFF);
    if (F.tid < 32) MISC[F.tid] = 0u;
    __syncthreads();
    unsigned* ctl = (unsigned*)(F.ws + WS_CTL);
    XcdBarrier bar; bar.bar = ctl + CW_BAR; bar.x = 0; bar.st = nullptr;
    if (MK_N_LAUNCHES == 1) bar = xcd_barrier_post(ctl + CW_BAR, MISC + 8);
#define GRID_BAR() do { if (MK_N_LAUNCHES == 1) xcd_barrier(bar); } while (0)
    const int lo = args.ph_lo, hi = args.ph_hi;
#define IN(k) (lo <= (k) && (k) < hi)
    bool qdone = false;
#define FILL_TAIL(p, mand) do { if (!qdone) { phase_done(F, ctl + CW_DONE + 64 * (p)); qdone = fill_transposes(F, (mand), ctl + CW_DONE + 64 * (p)); } } while (0)
#define FILL_MAND(mand) do { if (!qdone) qdone = fill_transposes(F, (mand), nullptr); } while (0)
#define BOTH(k) (IN(k) && IN((k) + 1))
    unsigned char* ws = F.ws;
    LAS unsigned char* ring = F.lds + RING_OFF;
    volatile LAS int* DSLOT = (volatile LAS int*)(F.lds + MISC_OFF + 96);
    const float* mod = (const float*)(ws + WS_MOD);

    if (IN(0)) REPS(0) {
        for (int w = blockIdx.x; w < SG * 4; w += F.G) p0_ssm_part(F, w >> 2, w & 3);
        p0_mod(F);
        (void)fill_transposes(F, Q_W1B, nullptr);
        if (BOTH(0)) GRID_BAR();
    }
    if (IN(1)) REPS(1) {
        if (F.G % 4 == 0) norm_phase<false, false>(F, F.in[I_X], F.in[I_CTX], true, F.in[I_NORMG], 0, 1, (bf16*)(ws + WS_U), nullptr, nullptr);
        else norm_rows<false>(F, F.in[I_X], F.in[I_CTX], MA, F.in[I_NORMG], 0, 1, (bf16*)(ws + WS_U), nullptr);
        if (BOTH(1)) GRID_BAR();
#if defined(EXP_BARS)
        for (int eb = 0; eb < EXP_BARS; ++eb) GRID_BAR();
#endif
        }
    if (IN(2)) REPS(2) {
        pg8::Gemm g{(const char*)(ws + WS_U), (const char*)(ws + WS_W1A), D, D, D, 0, 0};
        pg8::DynOrder<pg8::StaticOrder> S; S.B.init(MA, 2 * DFF, F.G, (int)blockIdx.x, WGM_FFN); S.ctr = ctl + CW_DYN + 128 * 2; S.slot = DSLOT; S.G = F.G; S.c = (int)blockIdx.x;
        EpiGated<0> E{(bf16*)(ws + WS_H), DFF};
#if defined(EXP_VAR)
        pg8::gemm_phase<EpiGated<0>, pg8::DynOrder<pg8::StaticOrder>, PG8_ALIGN, PG8_SP2, EXP_VAR>(ring, g, S, E); GRID_BAR();
#endif
        pg8::gemm_phase<EpiGated<0>, pg8::DynOrder<pg8::StaticOrder>, PG8_ALIGN, PG8_SP2, PG8_VAR>(ring, g, S, E);
        FILL_TAIL(2, Q_W1B); if (BOTH(2)) GRID_BAR();
    }
    if (IN(3)) REPS(3) {
        pg8::Gemm g{(const char*)(ws + WS_H), (const char*)(ws + WS_W1B), DFF, DFF, DFF, 0, 0};
        pg8::DynOrder<pg8::SplitKOrder> S; S.ctr = ctl + CW_DYN + 128 * 3; S.slot = DSLOT; S.G = F.G; S.c = (int)blockIdx.x;
        S.B.S.init(ML, D, F.G, (int)blockIdx.x, 4); S.B.pm0 = ML / BM; S.B.npn = D / BM; S.B.ntiles = (MC / BM) * (D / BM); S.B.kt_a = 44; S.B.kt_b = 42;
        EpiResid E{F.in[I_X], F.in[I_CTX], (float*)(ws + WS_X), mod, 2, 0.5f, (float*)(ws + WS_T)};
#if defined(EXP3_VAR)
        pg8::gemm_phase<EpiResid, pg8::DynOrder<pg8::SplitKOrder>, PG8_ALIGN, PG8_SP2, EXP3_VAR>(ring, g, S, E); GRID_BAR();
#endif
        pg8::gemm_phase<EpiResid, pg8::DynOrder<pg8::SplitKOrder>, PG8_ALIGN, PG8_SP2, PG8_VAR>(ring, g, S, E);
        FILL_TAIL(3, Q_WIN); if (BOTH(3)) GRID_BAR();
    }
    if (IN(4)) REPS(4) { const float* X = (const float*)(ws + WS_X);
        if (F.G % 4 == 0) norm_phase<false, true>(F, X, F.in[I_CTX], true, F.in[I_NORMG] + D, 3, 4, (bf16*)(ws + WS_U), nullptr, (const float*)(ws + WS_T));
        else norm_rows<false, true>(F, X, F.in[I_CTX], MA, F.in[I_NORMG] + D, 3, 4, (bf16*)(ws + WS_U), nullptr, (const float*)(ws + WS_T));
        if (BOTH(4)) GRID_BAR(); }
    if (IN(5)) REPS(5) {
        pg8::Gemm g{(const char*)(ws + WS_U), (const char*)(ws + WS_WIN), D, D, D, 0, 0};
        pg8::DynOrder<pg8::SplitKOrder> S; S.ctr = ctl + CW_DYN + 128 * 5; S.slot = DSLOT; S.G = F.G; S.c = (int)blockIdx.x;
        S.B.S.init(ML, DIN, F.G, (int)blockIdx.x, WGM_FFN); S.B.pm0 = ML / BM; S.B.npn = SW / BM; S.B.ntiles = (MC / BM) * (SW / BM); S.B.kt_a = 16; S.B.kt_b = 16;
        EpiWin E{(bf16*)(ws + WS_A2), (float*)(ws + WS_Z), (bf16*)(ws + WS_UP), (bf16*)(ws + WS_GT)};
        pg8::gemm_phase<EpiWin, pg8::DynOrder<pg8::SplitKOrder>, PG8_ALIGN, PG8_SP2, PG8_VAR>(ring, g, S, E);
        FILL_TAIL(5, Q_WIN); if (BOTH(5)) GRID_BAR();
    }
    if (IN(6)) REPS(6) {
        { pg8::Gemm g{(const char*)(ws + WS_A2), (const char*)(ws + WS_BTS), A2K, CT * SK, CT * SK, (long)A2R * A2K * 2, (long)256 * CT * SK * 2};
          pg8::GroupOrder S{A2R / BM, 1, SG, F.G, (int)blockIdx.x};
          EpiF32G E{(float*)(ws + WS_S), 256, (size_t)A2R * 256};
          pg8::gemm_phase<EpiF32G, pg8::GroupOrder, PG8_ALIGN, PG8_SP2, PG8_VAR>(ring, g, S, E); }
        ctx_scan(F);
        __syncthreads();
        pool_units(F);
        FILL_MAND(Q_POOL); if (BOTH(6)) GRID_BAR();
    }
    if (IN(7)) REPS(7) {
        chunk_recurrence(F);
        { pg8::Gemm g{(const char*)(ws + WS_MIX), (const char*)(ws + WS_WPOOL), PW_, 512, 512, (long)512 * 2, (long)512 * 512 * 2};
          pg8::GroupOrder S{ML / BM, 512 / BM, 4, F.G, (int)blockIdx.x};
          EpiPool E{(bf16*)(ws + WS_YB), F.in[I_POOLS]};
          pg8::gemm_phase<EpiPool, pg8::GroupOrder, PG8_ALIGN, PG8_SP2, PG8_VAR>(ring, g, S, E); }
        FILL_MAND(Q_WB); if (BOTH(7)) GRID_BAR();
    }
    if (IN(8)) REPS(8) {
        { pg8::Gemm g{(const char*)(ws + WS_A2), (const char*)(ws + WS_BTY), A2K, A2K, A2K, (long)A2R * A2K * 2, (long)(CT * SK) * A2K * 2};
          pg8::GroupOrder S{A2R / BM, (CT * SK) / BM, SG, F.G, F.vcu};
          EpiY E{(bf16*)(ws + WS_Z)};
          pg8::gemm_phase<EpiY, pg8::GroupOrder, PG8_ALIGN, PG8_SP2, PG8_VAR>(ring, g, S, E); }
        { pg8::Gemm g{(const char*)(ws + WS_YB), (const char*)(ws + WS_WB), PW_, PW_, PW_, 0, 0}; pg8::StaticOrder S; S.init(ML, D, F.G, (int)blockIdx.x);
          EpiBranch<false> E{(bf16*)(ws + WS_T), (const bf16*)(ws + WS_GT), D};
          pg8::gemm_phase<EpiBranch<false>, pg8::StaticOrder, PG8_ALIGN, PG8_SP2, PG8_VAR>(ring, g, S, E); }
        FILL_MAND(Q_GLU); if (BOTH(8)) GRID_BAR();
    }
    if (IN(9)) REPS(9) {
        pg8::Gemm g{(const char*)(ws + WS_Z), (const char*)(ws + WS_WGLU), SW, SW, SW, 0, 0}; pg8::StaticOrder S; S.init(ML, 2 * SW, F.G, (int)blockIdx.x);
        EpiGated<1> E{(bf16*)(ws + WS_GL), SW};
        pg8::gemm_phase<EpiGated<1>, pg8::StaticOrder, PG8_ALIGN, PG8_SP2, PG8_VAR>(ring, g, S, E);
        FILL_MAND(Q_WA); if (BOTH(9)) GRID_BAR();
    }
    if (IN(10)) {
        pg8::Gemm g{(const char*)(ws + WS_GL), (const char*)(ws + WS_WA), SW, SW, SW, 0, 0}; pg8::StaticOrder S; S.init(ML, D, F.G, (int)blockIdx.x);
        EpiBranch<true> E{(bf16*)(ws + WS_T), (const bf16*)(ws + WS_GT), 0};
        pg8::gemm_phase<EpiBranch<true>, pg8::StaticOrder, PG8_ALIGN, PG8_SP2, PG8_VAR>(ring, g, S, E);
        FILL_MAND(Q_WOUT); if (BOTH(10)) GRID_BAR();
    }
    if (IN(11)) {
        pg8::Gemm g{(const char*)(ws + WS_T), (const char*)(ws + WS_WOUT), D, D, D, 0, 0}; pg8::StaticOrder S; S.init(ML, D, F.G, (int)blockIdx.x);
        EpiResid E{(const float*)(ws + WS_X), (const float*)(ws + WS_X) + (size_t)ML * D, (float*)(ws + WS_X), mod, 5, 1.0f, nullptr};
        pg8::gemm_phase<EpiResid, pg8::StaticOrder, PG8_ALIGN, PG8_SP2, PG8_VAR>(ring, g, S, E);
        FILL_MAND(Q_W2A); if (BOTH(11)) GRID_BAR();
    }
    if (IN(12)) REPS(12) { const float* X = (const float*)(ws + WS_X);
        if (F.G % 4 == 0) norm_phase<false, false>(F, X, nullptr, false, F.in[I_NORMG] + 2 * D, 6, 7, (bf16*)(ws + WS_U), nullptr, nullptr);
        else norm_rows<false>(F, X, X + (size_t)ML * D, ML, F.in[I_NORMG] + 2 * D, 6, 7, (bf16*)(ws + WS_U), nullptr);
        if (BOTH(12)) GRID_BAR(); }
    if (IN(13)) REPS(13) {
        pg8::Gemm g{(const char*)(ws + WS_U), (const char*)(ws + WS_W2A), D, D, D, 0, 0};
        pg8::DynOrder<pg8::StaticOrder> S; S.B.init(ML, 2 * DFF, F.G, (int)blockIdx.x, WGM_FFN); S.ctr = ctl + CW_DYN + 128 * 13; S.slot = DSLOT; S.G = F.G; S.c = (int)blockIdx.x;
        EpiGated<0> E{(bf16*)(ws + WS_H), DFF};
        pg8::gemm_phase<EpiGated<0>, pg8::DynOrder<pg8::StaticOrder>, PG8_ALIGN, PG8_SP2, PG8_VAR>(ring, g, S, E);
        FILL_TAIL(13, Q_W2B); if (BOTH(13)) GRID_BAR();
    }
    if (IN(14)) {
        pg8::Gemm g{(const char*)(ws + WS_H), (const char*)(ws + WS_W2B), DFF, DFF, DFF, 0, 0}; pg8::StaticOrder S; S.init(ML, D, F.G, (int)blockIdx.x, 4);
        EpiResid E{(const float*)(ws + WS_X), (const float*)(ws + WS_X) + (size_t)ML * D, (float*)(ws + WS_X), mod, 8, 0.5f, nullptr};
        pg8::gemm_phase<EpiResid, pg8::StaticOrder, PG8_ALIGN, PG8_SP2, PG8_VAR>(ring, g, S, E);
        if (BOTH(14)) GRID_BAR();
    }
    if (IN(15)) REPS(15) { const float* X = (const float*)(ws + WS_X);
        if (F.G % 4 == 0) norm_phase<true, false>(F, X, nullptr, false, F.in[I_FINALG], 0, 0, nullptr, F.out, nullptr);
        else norm_rows<true>(F, X, X, ML, F.in[I_FINALG], 0, 0, nullptr, F.out); }
#undef IN
#undef BOTH
#undef GRID_BAR
}

extern "C" void kernel_launch(void* const* d_in, const int* in_sizes, int n_in, void* d_out, int out_size, void* d_ws, size_t ws_size, hipStream_t stream) {
    static int grid = 0;
    if (grid == 0) {
        if (n_in != 27 || in_sizes[0] != ML * D || out_size != ML * D || ws_size < WS_END) { fprintf(stderr, "kernel_launch: unexpected shapes (n_in %d, in0 %d, out %d, ws %zu < %zu); nothing launched\n", n_in, n_in > 0 ? in_sizes[0] : -1, out_size, ws_size, (size_t)WS_END); grid = -1; return; }
        int dev = 0, cus = 0, per_cu = 0;
        if (hipGetDevice(&dev) != hipSuccess || hipDeviceGetAttribute(&cus, hipDeviceAttributeMultiprocessorCount, dev) != hipSuccess) { fprintf(stderr, "kernel_launch: device query failed\n"); grid = -1; return; }
        if (hipFuncSetAttribute((const void*)fwd_kernel, hipFuncAttributeMaxDynamicSharedMemorySize, LDS_BYTES) != hipSuccess) { fprintf(stderr, "kernel_launch: hipFuncSetAttribute failed\n"); grid = -1; return; }
        if (hipOccupancyMaxActiveBlocksPerMultiprocessor(&per_cu, (const void*)fwd_kernel, NWAVES * 64, LDS_BYTES) != hipSuccess || per_cu < 1) fprintf(stderr, "kernel_launch: note: occupancy query reports %d workgroups per CU\n", per_cu);
        (void)hipGetLastError();
        grid = cus;
    }
    if (grid < 0) return;
    if (hipMemsetAsync((char*)d_ws + WS_CTL, 0, CTL_ZERO_BYTES, stream) != hipSuccess) { fprintf(stderr, "kernel_launch: memset failed\n"); return; }
    Args a{};
    for (int i = 0; i < 27; ++i) a.in[i] = (const float*)d_in[i];
    a.out = (float*)d_out; a.ws = (unsigned char*)d_ws;
    for (int li = 0; li < MK_N_LAUNCHES; ++li) {
        a.ph_lo = (MK_N_LAUNCHES == 1) ? 0 : li; a.ph_hi = (MK_N_LAUNCHES == 1) ? NPHASES : li + 1;
        hipLaunchKernelGGL(fwd_kernel, dim3(grid), dim3(NWAVES * 64), LDS_BYTES, stream, a);
        const hipError_t le = hipPeekAtLastError();
        if (le != hipSuccess) { fprintf(stderr, "kernel_launch: launch %d failed: %s\n", li, hipGetErrorName(le)); break; }
    }
}
```

```cpp
#include <hip/hip_runtime.h>
#include <cstdio>
#include <cstdint>

namespace pg8 {
#define PG8_LAS __attribute__((address_space(3)))
typedef unsigned short bf16_t;
typedef short bf16x8 __attribute__((ext_vector_type(8)));
typedef float f32x4 __attribute__((ext_vector_type(4)));
typedef unsigned u32x4 __attribute__((ext_vector_type(4)));
constexpr int BM = 256, BK = 64, HALF = 128, HTB = HALF * BK * 2  , STAGE_BYTES = 8 * HTB, NXCD = 8, WGM = 8;

__host__ __device__ __forceinline__ int lds_byte(int r, int c) { const int st = (r >> 4) * 2 + (c >> 5), rr = r & 15, cc = c & 31, ob = rr * 64 + cc * 2; return st * 1024 + (ob ^ (((ob >> 9) & 1) << 5)); }
__host__ __device__ __forceinline__ void stage_rc(int b, int& R, int& C) { const int st = b / 1024, sb = b % 1024, swz = sb ^ (((sb >> 9) & 1) << 5); R = (st >> 1) * 16 + swz / 64; C = (st & 1) * 32 + (swz % 64) / 2; }
__host__ __device__ __forceinline__ int perm32(int rho) { const int n = rho >> 4, i = rho & 15; return 8 * (i >> 2) + 4 * n + (i & 3); }

struct Unit { int pm, pn, g, kt0, nkt; };
struct Gemm { const char* A; const char* Bt; int lda, ldb, K; long gsa, gsb; };

struct StaticOrder {
    int nM, nN, nwg, G, c, wgm;
    __host__ __device__ void init(int M, int N, int G_, int c_, int wgm_ = WGM) { nM = M / BM; nN = N / BM; nwg = nM * nN; G = G_; c = c_; wgm = wgm_; }
    static constexpr bool DYNAMIC = false;
    __host__ __device__ int total() const { return nwg; }
    __host__ __device__ bool next(int i, Unit& u) const { return at((long)i * G + c, u); }
    __host__ __device__ bool at(long L, Unit& u) const {
        if (L >= nwg) return false;
        int wgid = (int)L; { const int q = nwg / NXCD, r = nwg % NXCD, xcd = wgid % NXCD, off = wgid / NXCD; wgid = (xcd < r ? xcd * (q + 1) : r * (q + 1) + (xcd - r) * q) + off; }
        const int nig = wgm * nN, gid = wgid / nig, fm = gid * wgm, gsz = (nM - fm) < wgm ? (nM - fm) : wgm;
        u.pm = fm + ((wgid % nig) % gsz); u.pn = (wgid % nig) / gsz; u.g = 0; u.kt0 = 0; u.nkt = 0; return true;
    }
    __device__ __forceinline__ void a_ready(const Unit&) const {}
    __device__ __forceinline__ void done(const Unit&) const {}
};
struct GroupOrder {
    static constexpr bool DYNAMIC = false;
    int nM, nN, ng, G, c;
    __device__ bool next(int i, Unit& u) const {
        const long L = (long)i * G + c; const int per = nM * nN; if (L >= (long)ng * per) return false;
        u.g = (int)(L / per); const int r = (int)(L % per); u.pm = r % nM; u.pn = r / nM; u.kt0 = 0; u.nkt = 0; return true;
    }
    __device__ __forceinline__ void a_ready(const Unit&) const {}
    __device__ __forceinline__ void done(const Unit&) const {}
};

struct SplitKOrder {
    StaticOrder S; int pm0, npn, ntiles, kt_a, kt_b;
    static constexpr bool DYNAMIC = false;
    __device__ int total() const { return S.nwg + 4 * ntiles; }
    __device__ bool next(int i, Unit& u) const { return at((long)i * S.G + S.c, u); }
    __device__ bool at(long L, Unit& u) const {
        if (L < S.nwg) return S.at(L, u);
        const int j = (int)(L - S.nwg); if (j >= 4 * ntiles) return false;
        const int split = j & 3, tile = j >> 2;
        u.pm = pm0 + tile / npn; u.pn = tile % npn; u.g = split + 1; u.kt0 = split < 2 ? split * kt_a : 2 * kt_a + (split - 2) * kt_b; u.nkt = split < 2 ? kt_a : kt_b; return true;
    }
    __device__ __forceinline__ void a_ready(const Unit&) const {}
    __device__ __forceinline__ void done(const Unit&) const {}
};

template <class Base> struct DynOrder {
    static constexpr bool DYNAMIC = true;
    Base B; unsigned* ctr; volatile PG8_LAS int* slot; int G, c;
    __device__ int total() const { return B.total(); }
    __device__ bool at(long L, Unit& u) const { return B.at(L, u); }
    __device__ int pull() const {
        const int x = c & 7, tot = B.total();
        for (int s_ = 0; s_ < 8; ++s_) { const int y = (x + s_) & 7, n0 = (G - y + 7) >> 3;
            const unsigned k = (unsigned)n0 + __hip_atomic_fetch_add(ctr + 16 * y, 1u, __ATOMIC_RELAXED, __HIP_MEMORY_SCOPE_AGENT);
            const long L = 8l * (long)k + y; if (L < tot) return (int)L; }
        return -1;
    }
    __device__ __forceinline__ void a_ready(const Unit&) const {}
    __device__ __forceinline__ void done(const Unit&) const {}
};

__device__ __forceinline__ unsigned cvt_pk_bf16(float lo, float hi) { unsigned r; asm volatile("v_cvt_pk_bf16_f32 %0, %1, %2" : "=v"(r) : "v"(lo), "v"(hi)); return r; }
__device__ __forceinline__ float sigmoidf_fast(float x) { return __builtin_amdgcn_rcpf(1.0f + __expf(-x)); }
__device__ __forceinline__ float bf_lo(unsigned w) { return __uint_as_float(w << 16); }
__device__ __forceinline__ float bf_hi(unsigned w) { return __uint_as_float(w & 0xffff0000u); }

template <class Epi, class Sched, bool ALIGN_EPI = false, bool SP2 = false, int VAR = 0>
__device__ __forceinline__ void gemm_phase(PG8_LAS unsigned char* lds, const Gemm g, const Sched& S, const Epi& E) {
    const int tid = threadIdx.x, wid = __builtin_amdgcn_readfirstlane(tid >> 6), lane = tid & 63, wr = wid >> 2, wc = wid & 3, fr = lane & 15, fq = lane >> 4;
    const int K = g.K, nt = K / BK;
    unsigned voffA[2], voffB[2];
#pragma unroll
    for (int i = 0; i < 2; ++i) { int R, C; stage_rc(tid * 16 + i * 8192, R, C); const int Rb = Epi::PERM ? ((R & ~31) + perm32(R & 31)) : R;
        voffA[i] = (unsigned)(R * g.lda + C) * 2u; voffB[i] = (unsigned)(Rb * g.ldb + C) * 2u; }
    const size_t kstep = (size_t)(BK * 2);
    const size_t hsA = (size_t)HALF * g.lda * 2, hsB = (size_t)HALF * g.ldb * 2;
    const size_t tsA = 2 * hsA, tsB = 2 * hsB;
    const unsigned ldsw = (unsigned)wid * 1024u;
    const int aoff = lds_byte(wr * 64 + fr, fq * 8), boff = lds_byte(wc * 32 + fr, fq * 8);
#define PG8_SA(b, h) (((b) * 2 + (h)) * HTB)
#define PG8_SB(b, h) ((4 + (b) * 2 + (h)) * HTB)
#define PG8_STAGE(bufoff, gbase, voff) do { if (!(VAR & 1)) _Pragma("unroll") for (int _i = 0; _i < 2; ++_i) \
        __builtin_amdgcn_global_load_lds((const unsigned*)((const char*)(gbase) + (voff)[_i]), (PG8_LAS unsigned*)(lds + (bufoff) + ldsw + _i * 8192), 16, 0, 0); } while (0)
#define PG8_LDA(dst, b, h) do { if (!(VAR & 2)) _Pragma("unroll") for (int m = 0; m < 4; ++m) _Pragma("unroll") for (int k = 0; k < 2; ++k) dst[m][k] = *(const PG8_LAS bf16x8*)(lds + PG8_SA(b, h) + aoff + m * 2048 + k * 1024); } while (0)
#define PG8_LDB(dst, b, h) do { if (!(VAR & 2)) _Pragma("unroll") for (int n = 0; n < 2; ++n) _Pragma("unroll") for (int k = 0; k < 2; ++k) dst[n][k] = *(const PG8_LAS bf16x8*)(lds + PG8_SB(b, h) + boff + n * 2048 + k * 1024); } while (0)
#define PG8_MMA(ai, bj, At, Bt) do { if (!(VAR & 128)) __builtin_amdgcn_s_setprio(1); if (!(VAR & 4)) _Pragma("unroll") for (int m = 0; m < 4; ++m) _Pragma("unroll") for (int n = 0; n < 2; ++n) _Pragma("unroll") for (int k = 0; k < 2; ++k) \
        acc[ai][bj][m][n] = __builtin_amdgcn_mfma_f32_16x16x32_bf16(Bt[n][k], At[m][k], acc[ai][bj][m][n], 0, 0, 0); if (!(VAR & 128)) __builtin_amdgcn_s_setprio(0); } while (0)
#define PG8_WAIT_V(n) asm volatile("s_waitcnt vmcnt(" #n ")" ::: "memory")
#define PG8_WAIT_L(n) asm volatile("s_waitcnt lgkmcnt(" #n ")" ::: "memory")
#define PG8_BAR __builtin_amdgcn_s_barrier()
#define PG8_SCHED __builtin_amdgcn_sched_barrier(0)
    Unit cur, nxt; int ui = 0;
    if constexpr (Sched::DYNAMIC) {
        if (!S.at(S.c, cur)) return;
        if (tid == 0) S.slot[1] = S.pull();
        __syncthreads();
    } else { if (!S.next(0, cur)) return; }
    if constexpr (VAR & 128) { if (wr == 1) __builtin_amdgcn_s_setprio(1); }
    f32x4 acc[2][2][4][2];
#pragma unroll
    for (int a = 0; a < 2; ++a)
#pragma unroll
        for (int b = 0; b < 2; ++b)
#pragma unroll
            for (int m = 0; m < 4; ++m)
#pragma unroll
                for (int n = 0; n < 2; ++n) acc[a][b][m][n] = (f32x4){0.f, 0.f, 0.f, 0.f};
    bf16x8 At[4][2], B0[2][2], B1[2][2];
    if (VAR & 2) {
#pragma unroll
        for (int m = 0; m < 4; ++m)
#pragma unroll
            for (int k = 0; k < 2; ++k) { At[m][k] = (bf16x8){0, 0, 0, 0, 0, 0, 0, 0}; asm volatile("" : "+v"(At[m][k])); }
#pragma unroll
        for (int n = 0; n < 2; ++n)
#pragma unroll
            for (int k = 0; k < 2; ++k) { B0[n][k] = (bf16x8){0, 0, 0, 0, 0, 0, 0, 0}; B1[n][k] = B0[n][k]; asm volatile("" : "+v"(B0[n][k])); asm volatile("" : "+v"(B1[n][k])); }
    }
    const bool grouped = g.gsa != 0 || g.gsb != 0;
    const char* cA = g.A + (grouped ? (size_t)cur.g * g.gsa : 0) + (size_t)((VAR & 8) ? 0 : cur.pm) * tsA + (size_t)cur.kt0 * kstep; const char* cB = g.Bt + (grouped ? (size_t)cur.g * g.gsb : 0) + (size_t)((VAR & 8) ? 0 : cur.pn) * tsB + (size_t)cur.kt0 * kstep;
    S.a_ready(cur);
    if constexpr (SP2) {
        PG8_STAGE(PG8_SB(0, 0), cB, voffB); PG8_STAGE(PG8_SB(0, 1), cB + hsB, voffB); PG8_STAGE(PG8_SA(0, 0), cA, voffA); PG8_STAGE(PG8_SA(0, 1), cA + hsA, voffA);
        if (wr == 1) PG8_BAR;
        PG8_WAIT_V(2); PG8_BAR;
        PG8_STAGE(PG8_SB(1, 0), cB + kstep, voffB); PG8_STAGE(PG8_SA(1, 0), cA + kstep, voffA); PG8_STAGE(PG8_SB(1, 1), cB + hsB + kstep, voffB);
        PG8_WAIT_V(6); PG8_BAR;
    } else {
        PG8_STAGE(PG8_SB(0, 0), cB, voffB); PG8_STAGE(PG8_SA(0, 0), cA, voffA); PG8_STAGE(PG8_SB(0, 1), cB + hsB, voffB); PG8_STAGE(PG8_SA(0, 1), cA + hsA, voffA);
        if (wr == 1) PG8_BAR;
        PG8_WAIT_V(4); PG8_BAR;
        PG8_STAGE(PG8_SB(1, 0), cB + kstep, voffB); PG8_STAGE(PG8_SA(1, 0), cA + kstep, voffA); PG8_STAGE(PG8_SB(1, 1), cB + hsB + kstep, voffB);
        PG8_WAIT_V(6); PG8_BAR;
    }
    unsigned sink = 0u; const int tidx = wid * 12 + lane; const bool t_isA = tidx < 64; constexpr int PD = 4;
    for (;;) {
        bool has_next = false; const char* nA = cA; const char* nB = cB;
#define PG8_NEXT_PTRS() do { nA = has_next ? g.A + (grouped ? (size_t)nxt.g * g.gsa : 0) + (size_t)((VAR & 8) ? 0 : nxt.pm) * tsA + (size_t)nxt.kt0 * kstep : cA; \
                             nB = has_next ? g.Bt + (grouped ? (size_t)nxt.g * g.gsb : 0) + (size_t)((VAR & 8) ? 0 : nxt.pn) * tsB + (size_t)nxt.kt0 * kstep : cB; } while (0)
        if constexpr (!Sched::DYNAMIC) { has_next = S.next(ui + 1, nxt); PG8_NEXT_PTRS(); }
        const int ntu = cur.nkt ? cur.nkt : nt;
        const unsigned toff = t_isA ? (unsigned)(((cur.pn & 3) * 64 + tidx) * g.lda) * 2u : (unsigned)(((cur.pm & 7) * 32 + (tidx - 64)) * g.ldb) * 2u;
#define PG8_TOUCH(tt) do { if constexpr (VAR & 64) { const int tp_ = (tt) + PD; const char* ta_ = tp_ < ntu ? cA + (size_t)tp_ * kstep : nA + (size_t)(tp_ - ntu) * kstep; \
            const char* tb_ = tp_ < ntu ? cB + (size_t)tp_ * kstep : nB + (size_t)(tp_ - ntu) * kstep; const char* tpp_ = (t_isA ? ta_ : tb_) + toff; \
            if (lane < 12) asm volatile("global_load_dword %0, %1, off" : "+v"(sink) : "v"(tpp_) : "memory"); } } while (0)
        for (int t = 0; t < ntu; t += 2) {
            const bool last = (t == ntu - 2);
            if constexpr (Sched::DYNAMIC) { if (last) {
                const int nL = __builtin_amdgcn_readfirstlane(S.slot[(ui + 1) & 1]); has_next = nL >= 0; if (has_next) has_next = S.at(nL, nxt); PG8_NEXT_PTRS(); } }
            const char* a1 = cA + (size_t)(t + 1) * kstep;
            const char* a2 = last ? nA : cA + (size_t)(t + 2) * kstep; const char* b2 = last ? nB : cB + (size_t)(t + 2) * kstep;
            const char* a3 = a2 + kstep; const char* b3 = b2 + kstep;
            if (last && has_next) S.a_ready(nxt);
            if constexpr (SP2) {
            if constexpr (VAR & 256) { PG8_STAGE(PG8_SA(1, 1), a1 + hsA, voffA); PG8_SCHED; PG8_LDB(B0, 0, 0); PG8_LDB(B1, 0, 1); PG8_SCHED; PG8_LDA(At, 0, 0); } else {
            PG8_LDB(B0, 0, 0); PG8_LDB(B1, 0, 1); PG8_SCHED; PG8_LDA(At, 0, 0); PG8_STAGE(PG8_SA(1, 1), a1 + hsA, voffA); } PG8_TOUCH(t);
            if constexpr ((VAR & 96) == 96) { PG8_WAIT_L(0); PG8_BAR; PG8_MMA(0, 0, At, B0); PG8_MMA(0, 1, At, B1); PG8_WAIT_V(10); PG8_BAR; PG8_SCHED; } else
            if constexpr (VAR & 32) { if (wr == 1) PG8_WAIT_V(8); PG8_WAIT_L(0); PG8_BAR; PG8_MMA(0, 0, At, B0); PG8_MMA(0, 1, At, B1); if (wr == 0) PG8_WAIT_V(8); PG8_BAR; PG8_SCHED; } else {
            PG8_WAIT_V(8); PG8_WAIT_L(0); PG8_BAR; PG8_MMA(0, 0, At, B0); PG8_MMA(0, 1, At, B1); PG8_BAR; PG8_SCHED; }
            if constexpr (VAR & 16) {
            PG8_LDA(At, 0, 1); PG8_STAGE(PG8_SB(0, 0), b2, voffB); PG8_STAGE(PG8_SB(0, 1), b2 + hsB, voffB);
            PG8_WAIT_V(6); PG8_WAIT_L(0); PG8_BAR; PG8_MMA(1, 0, At, B0); PG8_SCHED; PG8_STAGE(PG8_SA(0, 0), a2, voffA); PG8_SCHED; PG8_MMA(1, 1, At, B1); PG8_BAR; PG8_SCHED;
            } else {
            if constexpr (VAR & 256) { PG8_STAGE(PG8_SB(0, 0), b2, voffB); PG8_STAGE(PG8_SB(0, 1), b2 + hsB, voffB); PG8_STAGE(PG8_SA(0, 0), a2, voffA); PG8_SCHED; PG8_LDA(At, 0, 1); } else {
            PG8_LDA(At, 0, 1); PG8_STAGE(PG8_SB(0, 0), b2, voffB); PG8_STAGE(PG8_SB(0, 1), b2 + hsB, voffB); PG8_STAGE(PG8_SA(0, 0), a2, voffA); }
            if constexpr ((VAR & 96) == 96) { PG8_WAIT_L(0); PG8_BAR; PG8_MMA(1, 0, At, B0); PG8_MMA(1, 1, At, B1); PG8_WAIT_V(9); PG8_BAR; PG8_SCHED; } else
            if constexpr (VAR & 32) { if (wr == 1) PG8_WAIT_V(8); PG8_WAIT_L(0); PG8_BAR; PG8_MMA(1, 0, At, B0); PG8_MMA(1, 1, At, B1); if (wr == 0) PG8_WAIT_V(8); PG8_BAR; PG8_SCHED; } else {
            PG8_WAIT_V(8); PG8_WAIT_L(0); PG8_BAR; PG8_MMA(1, 0, At, B0); PG8_MMA(1, 1, At, B1); PG8_BAR; PG8_SCHED; }
            }
            if constexpr (VAR & 256) { PG8_STAGE(PG8_SA(0, 1), a2 + hsA, voffA); PG8_SCHED; PG8_LDB(B0, 1, 0); PG8_LDB(B1, 1, 1); PG8_SCHED; PG8_LDA(At, 1, 0); } else {
            PG8_LDB(B0, 1, 0); PG8_LDB(B1, 1, 1); PG8_SCHED; PG8_LDA(At, 1, 0); PG8_STAGE(PG8_SA(0, 1), a2 + hsA, voffA); } PG8_TOUCH(t + 1);
            if constexpr ((VAR & 96) == 96) { PG8_WAIT_L(0); PG8_BAR; PG8_MMA(0, 0, At, B0); PG8_MMA(0, 1, At, B1); PG8_WAIT_V(10); PG8_BAR; PG8_SCHED; } else
            if constexpr (VAR & 32) { if (wr == 1) PG8_WAIT_V(8); PG8_WAIT_L(0); PG8_BAR; PG8_MMA(0, 0, At, B0); PG8_MMA(0, 1, At, B1); if (wr == 0) PG8_WAIT_V(8); PG8_BAR; PG8_SCHED; } else {
            PG8_WAIT_V(8); PG8_WAIT_L(0); PG8_BAR; PG8_MMA(0, 0, At, B0); PG8_MMA(0, 1, At, B1); PG8_BAR; PG8_SCHED; }
            if constexpr (VAR & 16) {
            PG8_LDA(At, 1, 1); PG8_STAGE(PG8_SB(1, 0), b3, voffB); PG8_STAGE(PG8_SB(1, 1), b3 + hsB, voffB);
            PG8_WAIT_V(6); PG8_WAIT_L(0); PG8_BAR; PG8_MMA(1, 0, At, B0); PG8_SCHED; PG8_STAGE(PG8_SA(1, 0), a3, voffA); PG8_SCHED; PG8_MMA(1, 1, At, B1); PG8_BAR; PG8_SCHED;
            } else {
            if constexpr (VAR & 256) { PG8_STAGE(PG8_SB(1, 0), b3, voffB); PG8_STAGE(PG8_SB(1, 1), b3 + hsB, voffB); PG8_STAGE(PG8_SA(1, 0), a3, voffA); PG8_SCHED; PG8_LDA(At, 1, 1); } else {
            PG8_LDA(At, 1, 1); PG8_STAGE(PG8_SB(1, 0), b3, voffB); PG8_STAGE(PG8_SB(1, 1), b3 + hsB, voffB); PG8_STAGE(PG8_SA(1, 0), a3, voffA); }
            if constexpr ((VAR & 96) == 96) { PG8_WAIT_L(0); PG8_BAR; PG8_MMA(1, 0, At, B0); PG8_MMA(1, 1, At, B1); PG8_WAIT_V(9); PG8_BAR; PG8_SCHED; } else
            if constexpr (VAR & 32) { if (wr == 1) PG8_WAIT_V(8); PG8_WAIT_L(0); PG8_BAR; PG8_MMA(1, 0, At, B0); PG8_MMA(1, 1, At, B1); if (wr == 0) PG8_WAIT_V(8); PG8_BAR; PG8_SCHED; } else {
            PG8_WAIT_V(8); PG8_WAIT_L(0); PG8_BAR; PG8_MMA(1, 0, At, B0); PG8_MMA(1, 1, At, B1); PG8_BAR; PG8_SCHED; }
            }
            } else {
            PG8_LDB(B0, 0, 0); PG8_SCHED; PG8_LDA(At, 0, 0); PG8_STAGE(PG8_SA(1, 1), a1 + hsA, voffA);
            PG8_WAIT_L(8); PG8_BAR; PG8_WAIT_L(0); PG8_MMA(0, 0, At, B0); PG8_BAR; PG8_SCHED;
            PG8_LDB(B1, 0, 1); PG8_STAGE(PG8_SB(0, 0), b2, voffB);
            PG8_BAR; PG8_WAIT_L(0); PG8_MMA(0, 1, At, B1); PG8_BAR;
            PG8_LDA(At, 0, 1); PG8_STAGE(PG8_SA(0, 0), a2, voffA);
            PG8_BAR; PG8_WAIT_L(0); PG8_MMA(1, 0, At, B0); PG8_BAR; PG8_SCHED;
            PG8_STAGE(PG8_SB(0, 1), b2 + hsB, voffB);
            PG8_WAIT_V(6); PG8_BAR; PG8_MMA(1, 1, At, B1); PG8_BAR;
            PG8_LDB(B0, 1, 0); PG8_SCHED; PG8_LDA(At, 1, 0); PG8_STAGE(PG8_SA(0, 1), a2 + hsA, voffA);
            PG8_WAIT_L(8); PG8_BAR; PG8_WAIT_L(0); PG8_MMA(0, 0, At, B0); PG8_BAR; PG8_SCHED;
            PG8_LDB(B1, 1, 1); PG8_STAGE(PG8_SB(1, 0), b3, voffB);
            PG8_BAR; PG8_WAIT_L(0); PG8_MMA(0, 1, At, B1); PG8_BAR;
            PG8_LDA(At, 1, 1); PG8_STAGE(PG8_SA(1, 0), a3, voffA);
            PG8_BAR; PG8_WAIT_L(0); PG8_MMA(1, 0, At, B0); PG8_BAR; PG8_SCHED;
            PG8_STAGE(PG8_SB(1, 1), b3 + hsB, voffB);
            PG8_WAIT_V(6); PG8_BAR; PG8_MMA(1, 1, At, B1); PG8_BAR;
            }
        }
        if constexpr (ALIGN_EPI) { if (wr == 0) PG8_BAR; }
        int pulled = -1;
        if constexpr (Sched::DYNAMIC) { if (has_next && tid == 0) pulled = S.pull(); }
        E(acc, cur, wr, wc, fr, fq); S.done(cur);
        if constexpr (Sched::DYNAMIC) { if (has_next && tid == 0) S.slot[ui & 1] = pulled; }
        if (!has_next) break;
#pragma unroll
        for (int a = 0; a < 2; ++a)
#pragma unroll
            for (int b = 0; b < 2; ++b)
#pragma unroll
                for (int m = 0; m < 4; ++m)
#pragma unroll
                    for (int n = 0; n < 2; ++n) acc[a][b][m][n] = (f32x4){0.f, 0.f, 0.f, 0.f};
        cur = nxt; cA = nA; cB = nB; ++ui;
        if constexpr (ALIGN_EPI) { if (wr == 1) PG8_BAR; }
    }
    if constexpr (VAR & 128) __builtin_amdgcn_s_setprio(0);
    PG8_WAIT_V(0);
    asm volatile("" :: "v"(sink));
    if constexpr (!ALIGN_EPI) { if (wr == 0) PG8_BAR; }
    PG8_BAR;
#undef PG8_TOUCH
#undef PG8_NEXT_PTRS
#undef PG8_SA
#undef PG8_SB
#undef PG8_STAGE
#undef PG8_LDA
#undef PG8_LDB
#undef PG8_MMA
#undef PG8_WAIT_V
#undef PG8_WAIT_L
#undef PG8_BAR
#undef PG8_SCHED
}
}

#ifndef PG8_SP2
#define PG8_SP2 true
#endif
#ifndef PG8_ALIGN
#define PG8_ALIGN true
#endif
#ifndef PG8_VAR
#define PG8_VAR 0
#endif

constexpr int NWAVES = 8;
constexpr int D = 4096, BATCH = 4, SEQ = 4096, CTXL = 256, DFF = 11008, NMOD = 9;
constexpr int ML = BATCH * SEQ;
constexpr int MC = BATCH * CTXL;
constexpr int MA = ML + MC;
constexpr int SW = 1024, SG = 64, SK = 16, SP = 64;
constexpr int PW_ = 2048;
constexpr int DIN = SW + PW_ + 2 * D;
constexpr int CT = 32;
constexpr int NCH = SEQ / CT;
constexpr int A2R = BATCH * NCH;
constexpr int A2K = CT * SK + 4 * SP;
constexpr float RMS_EPS = 1e-6f;

constexpr size_t MiB = 1u << 20;
constexpr size_t WS_CTL = 0, CTL_ZERO_BYTES = 32768;
constexpr size_t WS_MOD = 1 * MiB;
constexpr size_t WS_BBAR = 2 * MiB;
constexpr size_t WS_LAMB = 3 * MiB;
constexpr size_t WS_USC = 4 * MiB;
constexpr size_t WS_S = 6 * MiB;
constexpr size_t WS_A2 = 38 * MiB;
constexpr size_t WS_BTY = 86 * MiB;
constexpr size_t WS_BTS = 134 * MiB;
constexpr size_t WS_W1A = 150 * MiB, WS_W1B = 322 * MiB, WS_W2A = 408 * MiB, WS_W2B = 580 * MiB;
constexpr size_t WS_WIN = 666 * MiB, WS_WGLU = 754 * MiB, WS_WA = 758 * MiB, WS_WPOOL = 766 * MiB, WS_WB = 768 * MiB, WS_WOUT = 784 * MiB;
constexpr size_t WS_U = 816 * MiB;
constexpr size_t WS_MIX = WS_U, WS_YB = WS_U + 64 * MiB;
constexpr size_t WS_H = 952 * MiB;
constexpr size_t WS_UP = WS_H, WS_GT = WS_H + 64 * MiB;
constexpr size_t WS_X = 1318 * MiB;
constexpr size_t WS_Z = 1590 * MiB, WS_GL = 1622 * MiB, WS_T = 1654 * MiB;
constexpr size_t WS_END = 1782 * MiB;
static_assert(WS_H + (size_t)MA * DFF * 2 <= WS_X && WS_GT + (size_t)ML * 2 * D * 2 <= WS_X && WS_U + (size_t)MA * D * 2 <= WS_H && WS_X + (size_t)MA * D * 4 <= WS_Z, "ws map");
constexpr int CW_TMO = 0, CW_QUEUE = 64, CW_DONE = 512  , CW_DYN = 1536  , CW_BAR = 4096;

constexpr int RING_OFF = 0;
constexpr int MISC_OFF = 144000;
constexpr int LDS_BYTES = 147456;

#define GAS __attribute__((address_space(1)))
#define LAS __attribute__((address_space(3)))
typedef unsigned short bf16;
typedef unsigned v4u __attribute__((ext_vector_type(4)));
typedef unsigned v2u __attribute__((ext_vector_type(2)));
typedef float f32x4 __attribute__((ext_vector_type(4)));
typedef GAS unsigned gu32;
#define RLX_AGENT __ATOMIC_RELAXED, __HIP_MEMORY_SCOPE_AGENT
#define LDS_WAIT() asm volatile("s_waitcnt lgkmcnt(0)" ::: "memory")
#define VM_WAIT() asm volatile("s_waitcnt vmcnt(0)" ::: "memory")
using pg8::cvt_pk_bf16; using pg8::sigmoidf_fast; using pg8::bf_lo; using pg8::bf_hi;

#define XB_TMO      128
#define XB_XCNT(j)  (256  + 64 * (j))
#define XB_XSUB(j)  (1280 + 64 * (j))
#define XB_XGEN(j)  (2304 + 64 * (j))
#define XB_TOP      3328
#define XB_TOPGEN   3392
#define XCD_BAR_WORDS 3456
#define XB_SPIN_CAP (1u << 18)
__device__ __forceinline__ unsigned xb_ld(unsigned* p)              { return __hip_atomic_load(p, __ATOMIC_RELAXED, __HIP_MEMORY_SCOPE_AGENT); }
__device__ __forceinline__ unsigned xb_add(unsigned* p, unsigned v) { return __hip_atomic_fetch_add(p, v, __ATOMIC_RELAXED, __HIP_MEMORY_SCOPE_AGENT); }
__device__ __forceinline__ unsigned xb_xcc_id() { return (unsigned)__builtin_amdgcn_s_getreg((3 << 11) | 20) & 0xFu; }
#define XB_SPIN(cond, bar) do { unsigned _sp = 0; while (cond) { __builtin_amdgcn_s_sleep(1); \
    if ((++_sp & 255u) == 0u) { if (xb_ld(&(bar)[XB_TMO])) break; if (_sp > XB_SPIN_CAP) { atomicAdd(&(bar)[XB_TMO], 1u); break; } } } } while (0)
struct XcdBarrier { unsigned* bar; unsigned x; volatile LAS unsigned* st; };
__device__ __forceinline__ XcdBarrier xcd_barrier_post(unsigned* bar, volatile LAS unsigned* st) {
    XcdBarrier b; b.bar = bar; b.x = xb_xcc_id(); b.st = st;
    if (threadIdx.x == 0) (void)xb_add(&bar[XB_XCNT(b.x)], 1u);
    return b;
}
__device__ __forceinline__ void xcd_barrier_complete(unsigned* bar, unsigned x, unsigned& nloc, unsigned& nx) {
    const unsigned G = gridDim.x * gridDim.y * gridDim.z;
    unsigned sum, cnt, mine, sp = 0u;
    for (;;) {
        sum = 0u; cnt = 0u; mine = 0u;
#pragma unroll
        for (unsigned j = 0; j < 16; ++j) { const unsigned c = xb_ld(&bar[XB_XCNT(j)]); sum += c; cnt += (c > 0u) ? 1u : 0u; mine = (j == x) ? c : mine; }
        if (sum == G) break;
        __builtin_amdgcn_s_sleep(1);
        if ((++sp & 255u) == 0u) { if (xb_ld(&bar[XB_TMO])) break; if (sp > XB_SPIN_CAP) { atomicAdd(&bar[XB_TMO], 1u); break; } }
    }
    nloc = mine > 0u ? mine : 1u; nx = cnt > 0u ? cnt : 1u;
}
__device__ __forceinline__ void xcd_barrier(const XcdBarrier& b) {
    asm volatile("s_waitcnt vmcnt(0)" ::: "memory");
    __syncthreads();
    if (threadIdx.x == 0) {
        unsigned* bar = b.bar;
        __builtin_amdgcn_s_waitcnt(0);
        unsigned nloc = b.st[0], nx = b.st[1];
        if (nloc == 0u) { xcd_barrier_complete(bar, b.x, nloc, nx); b.st[0] = nloc; b.st[1] = nx; }
        const unsigned old = xb_add(&bar[XB_XSUB(b.x)], 1u);
        const unsigned gen = old / nloc;
        if (old + 1u == (gen + 1u) * nloc) {
            __builtin_amdgcn_fence(__ATOMIC_RELEASE, "agent");
            asm volatile("s_waitcnt vmcnt(0)" ::: "memory");
            const unsigned og = xb_add(&bar[XB_TOP], 1u);
            const unsigned tg = og / nx;
            if (og + 1u == (tg + 1u) * nx) xb_add(&bar[XB_TOPGEN], 1u);
            else XB_SPIN(xb_ld(&bar[XB_TOPGEN]) == tg, bar);
            __builtin_amdgcn_fence(__ATOMIC_ACQUIRE, "agent");
            xb_add(&bar[XB_XGEN(b.x)], 1u);
            asm volatile("s_waitcnt vmcnt(0)" ::: "memory");
        } else {
            XB_SPIN(xb_ld(&bar[XB_XGEN(b.x)]) == gen, bar);
            __builtin_amdgcn_fence(__ATOMIC_ACQUIRE, "agent");
            asm volatile("s_waitcnt vmcnt(0)" ::: "memory");
        }
    }
    __syncthreads();
}

struct Frame {
    LAS unsigned char* lds;
    int tid, lane, wave, vcu, G;
    const float* in[27];
    float* out; unsigned char* ws;
};
enum { I_X = 0, I_C, I_CTX, I_CCTX, I_WMOD, I_BMOD, I_NORMG, I_FINALG, I_F1IN, I_F1OUT, I_F2IN, I_F2OUT, I_WIN, I_LRE, I_LIM, I_LSTEP, I_BRE, I_BIM, I_CRE, I_CIM, I_SD, I_WGLU, I_WBA, I_POOLW, I_POOLS, I_WBB, I_WOUT };

__device__ __forceinline__ float wave_sum(float v) {
#pragma unroll
    for (int o = 1; o < 64; o <<= 1) v += __shfl_xor(v, o);
    return v;
}

using pg8::Unit; using pg8::BM; using pg8::HALF;
template <int MODE> struct EpiGated {
    static constexpr bool PERM = true;
    bf16* O; int ldo;
    __device__ __forceinline__ void operator()(const f32x4 (&acc)[2][2][4][2], const Unit& u, int wr, int wc, int fr, int fq) const {
        const int row0 = u.pm * BM + wr * 64 + fr, col0 = u.pn * HALF + wc * 32 + 8 * fq;
#pragma unroll
        for (int ai = 0; ai < 2; ++ai)
#pragma unroll
            for (int m = 0; m < 4; ++m) {
                float o[8];
#pragma unroll
                for (int n = 0; n < 2; ++n)
#pragma unroll
                    for (int j = 0; j < 4; ++j) { const float a = acc[ai][0][m][n][j], b = acc[ai][1][m][n][j];
                        o[n * 4 + j] = MODE == 0 ? a * sigmoidf_fast(a) * b : a * sigmoidf_fast(b); }
                v4u w; w.x = cvt_pk_bf16(o[0], o[1]); w.y = cvt_pk_bf16(o[2], o[3]); w.z = cvt_pk_bf16(o[4], o[5]); w.w = cvt_pk_bf16(o[6], o[7]);
                *(v4u*)(O + (size_t)(row0 + ai * HALF + m * 16) * ldo + col0) = w;
            }
    }
};
struct EpiResid {
    static constexpr bool PERM = false;
    const float* in_lat; const float* in_ctx; float* X; const float* mod; int gidx; float coef; float* part;
    __device__ __forceinline__ void operator()(const f32x4 (&acc)[2][2][4][2], const Unit& u, int wr, int wc, int fr, int fq) const {
        const int row0 = u.pm * BM + wr * 64 + fr, col0 = u.pn * BM + wc * 32 + 4 * fq;
        if (u.g != 0) {
#pragma unroll
            for (int ai = 0; ai < 2; ++ai)
#pragma unroll
                for (int m = 0; m < 4; ++m) { float* rowp = part + ((size_t)(u.g - 1) * MC + (size_t)(row0 + ai * HALF + m * 16 - ML)) * D + col0;
#pragma unroll
                    for (int bj = 0; bj < 2; ++bj)
#pragma unroll
                        for (int n = 0; n < 2; ++n) *(f32x4*)(rowp + bj * HALF + n * 16) = acc[ai][bj][m][n]; }
            return;
        }
        const bool isctx = u.pm >= ML / BM; const int mi = isctx ? 4 : (u.pm >> 4);
        const float* gp = mod + (size_t)mi * (NMOD * D) + (size_t)gidx * D + col0;
        f32x4 gv[2][2];
#pragma unroll
        for (int bj = 0; bj < 2; ++bj)
#pragma unroll
            for (int n = 0; n < 2; ++n) gv[bj][n] = *(const f32x4*)(gp + bj * HALF + n * 16) * coef;
        const float* src = isctx ? in_ctx - (size_t)ML * D : in_lat;
#pragma unroll
        for (int ai = 0; ai < 2; ++ai) {
            f32x4 xi[4][2][2];
#pragma unroll
            for (int m = 0; m < 4; ++m) { const size_t off = (size_t)(row0 + ai * HALF + m * 16) * D + col0;
#pragma unroll
                for (int bj = 0; bj < 2; ++bj)
#pragma unroll
                    for (int n = 0; n < 2; ++n) xi[m][bj][n] = *(const f32x4*)(src + off + bj * HALF + n * 16); }
            asm volatile("" ::: "memory");
#pragma unroll
            for (int m = 0; m < 4; ++m) { const size_t off = (size_t)(row0 + ai * HALF + m * 16) * D + col0;
#pragma unroll
                for (int bj = 0; bj < 2; ++bj)
#pragma unroll
                    for (int n = 0; n < 2; ++n) *(f32x4*)(X + off + bj * HALF + n * 16) = xi[m][bj][n] + gv[bj][n] * acc[ai][bj][m][n]; }
            asm volatile("" ::: "memory");
        }
    }
};
struct EpiWin {
    static constexpr bool PERM = true;
    bf16* A2; float* USCP; bf16* UP; bf16* GT;
    __device__ __forceinline__ void operator()(const f32x4 (&acc)[2][2][4][2], const Unit& u, int wr, int wc, int fr, int fq) const {
        const int row0 = u.pm * BM + wr * 64 + fr;
        if (u.g != 0) {
#pragma unroll
            for (int ai = 0; ai < 2; ++ai)
#pragma unroll
                for (int m = 0; m < 4; ++m) { float* rowp = USCP + ((size_t)(u.g - 1) * MC + (size_t)(row0 + ai * HALF + m * 16 - ML)) * SW + u.pn * BM + wc * 32 + 8 * fq;
#pragma unroll
                    for (int bj = 0; bj < 2; ++bj) { *(f32x4*)(rowp + bj * HALF) = acc[ai][bj][m][0]; *(f32x4*)(rowp + bj * HALF + 4) = acc[ai][bj][m][1]; } }
            return;
        }
#pragma unroll
        for (int ai = 0; ai < 2; ++ai)
#pragma unroll
            for (int m = 0; m < 4; ++m) { const int row = row0 + ai * HALF + m * 16;
#pragma unroll
                for (int bj = 0; bj < 2; ++bj) {
                    const int cl = bj * HALF + wc * 32 + 8 * fq;
                    f32x4 v0 = acc[ai][bj][m][0], v1 = acc[ai][bj][m][1];
                    bf16* dst;
                    if (u.pn < 4) {
                        const int c = u.pn * BM + cl;
                        { const int b = row >> 12, t = row & 4095, g = c >> 4, k0 = c & 15;
                               dst = A2 + ((size_t)(g * A2R + b * NCH + (t >> 5)) * A2K + (t & 31) * SK + k0); }
                    } else if (u.pn < 12) {
                        const int ch = (u.pn - 4) * BM + cl, b = row >> 12, t = row & 4095;
                        dst = UP + ((size_t)((b * 256 + (ch >> 3)) * SEQ + t) * 8);
                    } else {
#pragma unroll
                        for (int j = 0; j < 4; ++j) { v0[j] = sigmoidf_fast(v0[j]); v1[j] = sigmoidf_fast(v1[j]); }
                        dst = GT + (size_t)row * (2 * D) + (u.pn - 12) * BM + cl;
                    }
                    v4u w; w.x = cvt_pk_bf16(v0[0], v0[1]); w.y = cvt_pk_bf16(v0[2], v0[3]); w.z = cvt_pk_bf16(v1[0], v1[1]); w.w = cvt_pk_bf16(v1[2], v1[3]);
                    *(v4u*)dst = w; } }
    }
};
struct EpiF32G {
    static constexpr bool PERM = false;
    float* C; int ldc; size_t gs;
    __device__ __forceinline__ void operator()(const f32x4 (&acc)[2][2][4][2], const Unit& u, int wr, int wc, int fr, int fq) const {
        const int row0 = u.pm * BM + wr * 64 + fr, col0 = u.pn * BM + wc * 32 + 4 * fq;
#pragma unroll
        for (int ai = 0; ai < 2; ++ai)
#pragma unroll
            for (int m = 0; m < 4; ++m) { float* rowp = C + (size_t)u.g * gs + (size_t)(row0 + ai * HALF + m * 16) * ldc + col0;
#pragma unroll
                for (int bj = 0; bj < 2; ++bj)
#pragma unroll
                    for (int n = 0; n < 2; ++n) *(f32x4*)(rowp + bj * HALF + n * 16) = acc[ai][bj][m][n]; }
    }
};
__device__ __forceinline__ float gelu_tanh(float x) { const float u2 = 1.5957691216f * (x + 0.044715f * x * x * x); return x * sigmoidf_fast(u2); }
struct EpiY {
    static constexpr bool PERM = true;
    bf16* Z;
    __device__ __forceinline__ void operator()(const f32x4 (&acc)[2][2][4][2], const Unit& u, int wr, int wc, int fr, int fq) const {
        const int row0 = u.pm * BM + wr * 64 + fr;
#pragma unroll
        for (int ai = 0; ai < 2; ++ai)
#pragma unroll
            for (int m = 0; m < 4; ++m) { const int R = row0 + ai * HALF + m * 16, b = R >> 7, cc = R & 127;
#pragma unroll
                for (int bj = 0; bj < 2; ++bj) { const int n_ = u.pn * BM + bj * HALF + wc * 32 + 8 * fq, tl = n_ >> 4, k0 = n_ & 15;
                    float o[8];
#pragma unroll
                    for (int n = 0; n < 2; ++n)
#pragma unroll
                        for (int j = 0; j < 4; ++j) o[n * 4 + j] = gelu_tanh(acc[ai][bj][m][n][j]);
                    v4u w; w.x = cvt_pk_bf16(o[0], o[1]); w.y = cvt_pk_bf16(o[2], o[3]); w.z = cvt_pk_bf16(o[4], o[5]); w.w = cvt_pk_bf16(o[6], o[7]);
                    *(v4u*)(Z + (size_t)(b * SEQ + cc * CT + tl) * SW + u.g * SK + k0) = w; } }
    }
};
struct EpiPool {
    static constexpr bool PERM = true;
    bf16* YB; const float* scale;
    __device__ __forceinline__ void operator()(const f32x4 (&acc)[2][2][4][2], const Unit& u, int wr, int wc, int fr, int fq) const {
        const int row0 = u.pm * BM + wr * 64 + fr, col0 = u.g * 512 + u.pn * BM + wc * 32 + 8 * fq;
        f32x4 sv[2][2];
#pragma unroll
        for (int bj = 0; bj < 2; ++bj)
#pragma unroll
            for (int n = 0; n < 2; ++n) sv[bj][n] = *(const f32x4*)(scale + col0 + bj * HALF + 4 * n);
#pragma unroll
        for (int ai = 0; ai < 2; ++ai)
#pragma unroll
            for (int m = 0; m < 4; ++m) { bf16* rowp = YB + (size_t)(row0 + ai * HALF + m * 16) * PW_ + col0;
#pragma unroll
                for (int bj = 0; bj < 2; ++bj) { const f32x4 v0 = acc[ai][bj][m][0] * sv[bj][0], v1 = acc[ai][bj][m][1] * sv[bj][1];
                    v4u w; w.x = cvt_pk_bf16(v0[0], v0[1]); w.y = cvt_pk_bf16(v0[2], v0[3]); w.z = cvt_pk_bf16(v1[0], v1[1]); w.w = cvt_pk_bf16(v1[2], v1[3]);
                    *(v4u*)(rowp + bj * HALF) = w; } }
    }
};
template <bool ADD> struct EpiBranch {
    static constexpr bool PERM = true;
    bf16* T; const bf16* GT; int goff;
    __device__ __forceinline__ void operator()(const f32x4 (&acc)[2][2][4][2], const Unit& u, int wr, int wc, int fr, int fq) const {
        const int row0 = u.pm * BM + wr * 64 + fr, col0 = u.pn * BM + wc * 32 + 8 * fq;
#pragma unroll
        for (int ai = 0; ai < 2; ++ai) {
            v4u gws[4][2], tws[4][2];
#pragma unroll
            for (int m = 0; m < 4; ++m) { const size_t row = (size_t)(row0 + ai * HALF + m * 16);
#pragma unroll
                for (int bj = 0; bj < 2; ++bj) { gws[m][bj] = *(const v4u*)(GT + row * (2 * D) + goff + col0 + bj * HALF);
                    if (ADD) tws[m][bj] = *(const v4u*)(T + row * D + col0 + bj * HALF); else tws[m][bj] = (v4u){0u, 0u, 0u, 0u}; } }
            asm volatile("" ::: "memory");
#pragma unroll
            for (int m = 0; m < 4; ++m) { const size_t row = (size_t)(row0 + ai * HALF + m * 16);
#pragma unroll
                for (int bj = 0; bj < 2; ++bj) {
                    const v4u gw = gws[m][bj]; const v4u tw = tws[m][bj];
                    bf16* tp = T + row * D + col0 + bj * HALF;
                    float o[8]; const f32x4 v0 = acc[ai][bj][m][0], v1 = acc[ai][bj][m][1];
                    o[0] = bf_lo(gw.x) * v0[0]; o[1] = bf_hi(gw.x) * v0[1]; o[2] = bf_lo(gw.y) * v0[2]; o[3] = bf_hi(gw.y) * v0[3];
                    o[4] = bf_lo(gw.z) * v1[0]; o[5] = bf_hi(gw.z) * v1[1]; o[6] = bf_lo(gw.w) * v1[2]; o[7] = bf_hi(gw.w) * v1[3];
                    if (ADD) { o[0] += bf_lo(tw.x); o[1] += bf_hi(tw.x); o[2] += bf_lo(tw.y); o[3] += bf_hi(tw.y); o[4] += bf_lo(tw.z); o[5] += bf_hi(tw.z); o[6] += bf_lo(tw.w); o[7] += bf_hi(tw.w); }
                    v4u w; w.x = cvt_pk_bf16(o[0], o[1]); w.y = cvt_pk_bf16(o[2], o[3]); w.z = cvt_pk_bf16(o[4], o[5]); w.w = cvt_pk_bf16(o[6], o[7]);
                    *(v4u*)tp = w; } }
            asm volatile("" ::: "memory");
        }
    }
};

__device__ __forceinline__ void p0_mod(Frame& F) {
    LAS float* sc = (LAS float*)(F.lds);
    LAS float* red = (LAS float*)(F.lds + 81920);
    const float* c = F.in[I_C]; const float* cctx = F.in[I_CCTX]; const float* wmod = F.in[I_WMOD]; const float* bmod = F.in[I_BMOD];
    float* mod = (float*)(F.ws + WS_MOD);
    for (int i = F.tid; i < 5 * D; i += NWAVES * 64) { const int v = i >> 12, k = i & (D - 1); const float x = v < 4 ? c[v * D + k] : cctx[k]; sc[i] = x * sigmoidf_fast(x); }
    __syncthreads();
    const int col4 = F.tid % 36, ksub = F.tid / 36;
    for (int chunk = blockIdx.x; chunk < 256; chunk += F.G) {
        float acc[5][4];
#pragma unroll
        for (int v = 0; v < 5; ++v)
#pragma unroll
            for (int e = 0; e < 4; ++e) acc[v][e] = 0.f;
        if (ksub < 14) {
            const float* wp = wmod + (size_t)chunk * 144 + col4 * 4;
#pragma unroll 8
            for (int k = ksub; k < D; k += 14) { const f32x4 w = __builtin_nontemporal_load((const f32x4*)(wp + (size_t)k * (NMOD * D)));
#pragma unroll
                for (int v = 0; v < 5; ++v) { const float s = sc[v * D + k];
#pragma unroll
                    for (int e = 0; e < 4; ++e) acc[v][e] += s * w[e]; } }
#pragma unroll
            for (int v = 0; v < 5; ++v)
#pragma unroll
                for (int e = 0; e < 4; ++e) red[(ksub * 36 + col4) * 20 + v * 4 + e] = acc[v][e];
        }
        __syncthreads();
        for (int o = F.tid; o < 720; o += NWAVES * 64) { const int v = o / 144, cl = o % 144; float s = bmod[chunk * 144 + cl];
#pragma unroll
            for (int q = 0; q < 14; ++q) s += red[(q * 36 + (cl >> 2)) * 20 + v * 4 + (cl & 3)];
            mod[(size_t)v * (NMOD * D) + chunk * 144 + cl] = s; }
        __syncthreads();
    }
}

__device__ __forceinline__ void p0_transpose_item(const float* W, int N, bf16* WT, int ldt, int dst_row0, LAS float* scr, int k0, int n0, int lane) {
    f32x4 v[16];
    const float* src = W + (size_t)(k0 + (lane >> 4)) * N + n0 + (lane & 15) * 4;
#pragma unroll
    for (int i = 0; i < 16; ++i) v[i] = __builtin_nontemporal_load((const f32x4*)(src + (size_t)(4 * i) * N));
#pragma unroll
    for (int i = 0; i < 16; ++i) { LAS float* d = scr + (4 * i + (lane >> 4)) * 65 + (lane & 15) * 4; d[0] = v[i].x; d[1] = v[i].y; d[2] = v[i].z; d[3] = v[i].w; }
    LDS_WAIT(); asm volatile("" ::: "memory");
    const int c = lane >> 3, nn = lane & 7;
#pragma unroll
    for (int j = 0; j < 8; ++j) { const int n = nn + 8 * j; const LAS float* s = scr + (8 * c) * 65 + n;
        v4u o; o.x = cvt_pk_bf16(s[0 * 65], s[1 * 65]); o.y = cvt_pk_bf16(s[2 * 65], s[3 * 65]); o.z = cvt_pk_bf16(s[4 * 65], s[5 * 65]); o.w = cvt_pk_bf16(s[6 * 65], s[7 * 65]);
        __builtin_nontemporal_store(o, (GAS v4u*)(WT + (size_t)(dst_row0 + n) * ldt + k0 + 8 * c)); }
    LDS_WAIT(); asm volatile("" ::: "memory");
}
constexpr int IT_FA = (D / 64) * (2 * DFF / 64), IT_FB = (DFF / 64) * (D / 64), IT_WIN = (D / 64) * (DIN / 64), IT_GLU = (SW / 64) * (2 * SW / 64), IT_WA = (SW / 64) * (D / 64),
              IT_POOL = 4 * (512 / 64) * (512 / 64), IT_WB = (PW_ / 64) * (D / 64), IT_WOUT = (D / 64) * (D / 64);
constexpr int Q_W1A = IT_FA, Q_W1B = Q_W1A + IT_FB, Q_WIN = Q_W1B + IT_WIN, Q_POOL = Q_WIN + IT_POOL, Q_WB = Q_POOL + IT_WB, Q_GLU = Q_WB + IT_GLU, Q_WA = Q_GLU + IT_WA,
              Q_WOUT = Q_WA + IT_WOUT, Q_W2A = Q_WOUT + IT_FA, Q_W2B = Q_W2A + IT_FB;
constexpr int IT_TOTAL = Q_W2B;
__device__ __forceinline__ int gated_row(int n0, int half) { const int j = n0 < half ? n0 : n0 - half; return (j >> 7) * 256 + (j & 127) + (n0 < half ? 0 : 128); }
__device__ __forceinline__ void p0_one_item(Frame& F, int r, LAS float* scr) {
    unsigned char* ws = F.ws; const int lane = F.lane;
#define TR_PLAIN(W, Kd, Nd, WT) do { const int nblk = (Nd) / 64, kb = r / nblk, nb = r % nblk; p0_transpose_item(W, Nd, (bf16*)(WT), Kd, 64 * nb, scr, 64 * kb, 64 * nb, lane); } while (0)
#define TR_GATED(W, Kd, Nd, WT) do { const int nblk = (Nd) / 64, kb = r / nblk, nb = r % nblk; p0_transpose_item(W, Nd, (bf16*)(WT), Kd, gated_row(64 * nb, (Nd) / 2), scr, 64 * kb, 64 * nb, lane); } while (0)
    if (r < IT_FA) { TR_GATED(F.in[I_F1IN], D, 2 * DFF, ws + WS_W1A); return; } r -= IT_FA;
    if (r < IT_FB) { TR_PLAIN(F.in[I_F1OUT], DFF, D, ws + WS_W1B); return; } r -= IT_FB;
    if (r < IT_WIN) { TR_PLAIN(F.in[I_WIN], D, DIN, ws + WS_WIN); return; } r -= IT_WIN;
    if (r < IT_POOL) { const int gi = r / 64; r %= 64; TR_PLAIN(F.in[I_POOLW] + (size_t)gi * 512 * 512, 512, 512, ws + WS_WPOOL + (size_t)gi * 512 * 512 * 2); return; } r -= IT_POOL;
    if (r < IT_WB) { TR_PLAIN(F.in[I_WBB], PW_, D, ws + WS_WB); return; } r -= IT_WB;
    if (r < IT_GLU) { TR_GATED(F.in[I_WGLU], SW, 2 * SW, ws + WS_WGLU); return; } r -= IT_GLU;
    if (r < IT_WA) { TR_PLAIN(F.in[I_WBA], SW, D, ws + WS_WA); return; } r -= IT_WA;
    if (r < IT_WOUT) { TR_PLAIN(F.in[I_WOUT], D, D, ws + WS_WOUT); return; } r -= IT_WOUT;
    if (r < IT_FA) { TR_GATED(F.in[I_F2IN], D, 2 * DFF, ws + WS_W2A); return; } r -= IT_FA;
    TR_PLAIN(F.in[I_F2OUT], DFF, D, ws + WS_W2B);
#undef TR_PLAIN
#undef TR_GATED
}
__device__ __forceinline__ bool fill_transposes(Frame& F, int mandatory, unsigned* done_ctr) {
    LAS float* scr = (LAS float*)(F.lds + F.wave * 16640);
    volatile LAS int* sh = (volatile LAS int*)(F.lds + MISC_OFF + 64);
    unsigned* q = (unsigned*)(F.ws + WS_CTL) + CW_QUEUE;
    constexpr int PER_WAVE = 2, CHB = PER_WAVE * NWAVES;
    for (;;) {
        if (F.tid == 0) { int base = -1; const int head = (int)__hip_atomic_load(q, __ATOMIC_RELAXED, __HIP_MEMORY_SCOPE_AGENT);
            const bool go = head < mandatory || (head < IT_TOTAL && done_ctr != nullptr && __hip_atomic_load(done_ctr, __ATOMIC_RELAXED, __HIP_MEMORY_SCOPE_AGENT) < (unsigned)F.G);
            if (go) { base = (int)__hip_atomic_fetch_add(q, (unsigned)CHB, __ATOMIC_RELAXED, __HIP_MEMORY_SCOPE_AGENT); if (base >= IT_TOTAL) base = -2; }
            else if (head >= IT_TOTAL) base = -2;
            sh[0] = base; }
        __syncthreads();
        const int base = sh[0];
        __syncthreads();
        if (base < 0) return base == -2;
        const int b0 = base + F.wave * PER_WAVE, end = b0 + PER_WAVE < IT_TOTAL ? b0 + PER_WAVE : IT_TOTAL;
        for (int it = b0; it < end; ++it) p0_one_item(F, it, scr);
    }
}
__device__ __forceinline__ void phase_done(Frame& F, unsigned* done_ctr) {
    __syncthreads();
    if (F.tid == 0) __hip_atomic_fetch_add(done_ctr, 1u, __ATOMIC_RELAXED, __HIP_MEMORY_SCOPE_AGENT);
}

typedef float f32x2 __attribute__((ext_vector_type(2)));
constexpr int KFS = 272;
__device__ __forceinline__ void p0_ssm_part(Frame& F, int g, int part) {
    LAS f32x2* PWR = (LAS f32x2*)(F.lds);
    LAS f32x2* BB = (LAS f32x2*)(F.lds + 33792);
    LAS f32x2* CC = (LAS f32x2*)(F.lds + 33792 + 16384);
    LAS float* KF = (LAS float*)(F.lds + 33792 + 32768);
    const int tid = F.tid;
    if (tid < 128) {
        const int dir = tid >> 6, p = tid & 63, idx = (dir * SG + g) * SP + p;
        const double lr = fmin((double)F.in[I_LRE][idx], -1e-4), li = (double)F.in[I_LIM][idx], st = exp((double)F.in[I_LSTEP][dir * SG + g]);
        const double mag = exp(lr * st), ang = li * st, lbr = mag * cos(ang), lbi = mag * sin(ang);
        const double nr = lbr - 1.0, ni = lbi, den = lr * lr + li * li, fr_ = (nr * lr + ni * li) / den, fi_ = (ni * lr - nr * li) / den;
        double pr = 1.0, pi = 0.0;
        for (int tau = 0; tau <= CT; ++tau) { PWR[(dir * SP + p) * 33 + tau] = (f32x2){(float)pr, (float)pi}; const double t = pr * lbr - pi * lbi; pi = pr * lbi + pi * lbr; pr = t; }
        f32x2* bbar = (f32x2*)(F.ws + WS_BBAR);
        for (int k = 0; k < SK; ++k) { const double br = (double)F.in[I_BRE][idx * SK + k], bi = (double)F.in[I_BIM][idx * SK + k];
            const f32x2 bb = (f32x2){(float)(fr_ * br - fi_ * bi), (float)(fr_ * bi + fi_ * br)}; BB[(dir * SP + p) * SK + k] = bb; if (part == 0) bbar[(size_t)idx * SK + k] = bb; }
        if (part == 0) { f32x2* lamb = (f32x2*)(F.ws + WS_LAMB); f32x2* lamT = (f32x2*)(F.ws + WS_LAMB + 65536);
            lamb[idx] = (f32x2){(float)lbr, (float)lbi}; lamT[idx] = PWR[(dir * SP + p) * 33 + CT]; }
    }
    for (int o = tid; o < 2048; o += NWAVES * 64) { const int dir = o >> 10, k = (o >> 6) & 15, p = o & 63, cidx = ((dir * SG + g) * SK + k) * SP + p; CC[(dir * SP + p) * SK + k] = (f32x2){F.in[I_CRE][cidx], F.in[I_CIM][cidx]}; }
    __syncthreads();
    for (int combo = tid; combo < 1024; combo += NWAVES * 64) { const int dir = combo >> 9, tau = (combo >> 4) & 31, k = combo & 15;
        float a[16];
#pragma unroll
        for (int e = 0; e < 16; ++e) a[e] = 0.f;
        for (int p = 0; p < SP; ++p) { const f32x2 c = CC[(dir * SP + p) * SK + k], w = PWR[(dir * SP + p) * 33 + tau]; const float gr = c.x * w.x - c.y * w.y, gi = c.x * w.y + c.y * w.x;
#pragma unroll
            for (int e = 0; e < 16; ++e) { const f32x2 b = BB[(dir * SP + p) * SK + e]; a[e] += gr * b.x - gi * b.y; } }
#pragma unroll
        for (int e = 0; e < 16; ++e) KF[(dir * CT + tau) * KFS + k * SK + e] = a[e]; }
    __syncthreads();
    bf16* bty = (bf16*)(F.ws + WS_BTY) + (size_t)g * (CT * SK) * A2K;
    const float* dvec = F.in[I_SD] + g * SK;
    for (int ch = tid; ch < 128 * (A2K / 8); ch += NWAVES * 64) { const int n = part * 128 + ch / (A2K / 8), q = ch % (A2K / 8), t = n >> 4, k = n & 15;
        float v[8];
        if (q < 64) { const int s = q >> 1, k0 = (q & 1) * 8;
            f32x4 x0 = (f32x4){0.f, 0.f, 0.f, 0.f}, x1 = x0;
            if (t >= s) { const LAS f32x4* kp = (const LAS f32x4*)(KF + (t - s) * KFS + k * SK + k0); x0 += kp[0]; x1 += kp[1]; }
            if (s >= t) { const LAS f32x4* kp = (const LAS f32x4*)(KF + (CT + (s - t)) * KFS + k * SK + k0); x0 += kp[0]; x1 += kp[1]; }
            v[0] = x0.x; v[1] = x0.y; v[2] = x0.z; v[3] = x0.w; v[4] = x1.x; v[5] = x1.y; v[6] = x1.z; v[7] = x1.w;
            if (t == s && (k >> 3) == (q & 1)) { const float dk = dvec[k];
#pragma unroll
                for (int e = 0; e < 8; ++e) v[e] += ((k & 7) == e) ? dk : 0.f; }
        } else { const int pt = (q - 64) >> 3, p0 = ((q - 64) & 7) * 8, dir = pt >> 1, tau = dir == 0 ? t + 1 : CT - t;
#pragma unroll
            for (int e = 0; e < 8; ++e) { const int p = p0 + e; const f32x2 c = CC[(dir * SP + p) * SK + k], w = PWR[(dir * SP + p) * 33 + tau];
                const float re = c.x * w.x - c.y * w.y, im = c.x * w.y + c.y * w.x; v[e] = (pt & 1) ? -im : re; }
        }
        v4u o; o.x = cvt_pk_bf16(v[0], v[1]); o.y = cvt_pk_bf16(v[2], v[3]); o.z = cvt_pk_bf16(v[4], v[5]); o.w = cvt_pk_bf16(v[6], v[7]);
        *(v4u*)(bty + (size_t)n * A2K + q * 8) = o; }
    bf16* bts = (bf16*)(F.ws + WS_BTS) + (size_t)g * 256 * (CT * SK);
    for (int ch = tid; ch < 64 * 64; ch += NWAVES * 64) { const int p = ch >> 6, q = ch & 63, pt = part, n = pt * 64 + p, dir = pt >> 1, s = q >> 1, k0 = (q & 1) * 8, tau = dir == 0 ? CT - 1 - s : s;
        const f32x2 w = PWR[(dir * SP + p) * 33 + tau]; float v[8];
#pragma unroll
        for (int e = 0; e < 8; ++e) { const f32x2 b = BB[(dir * SP + p) * SK + k0 + e]; const float re = w.x * b.x - w.y * b.y, im = w.x * b.y + w.y * b.x; v[e] = (pt & 1) ? im : re; }
        v4u o; o.x = cvt_pk_bf16(v[0], v[1]); o.y = cvt_pk_bf16(v[2], v[3]); o.z = cvt_pk_bf16(v[4], v[5]); o.w = cvt_pk_bf16(v[6], v[7]);
        *(v4u*)(bts + (size_t)n * (CT * SK) + q * 8) = o; }
    __syncthreads();
}

template <bool FINAL, bool CTXSUM = false>
__device__ __forceinline__ void norm_rows(Frame& F, const float* in_lat, const float* in_ctx, int nrows, const float* gvec, int shift_idx, int scale_idx, bf16* outb, float* outf, const float* part = nullptr) {
    const int gw = F.vcu * NWAVES + F.wave, NGW = F.G * NWAVES;
    const float* mod = (const float*)(F.ws + WS_MOD);
    for (int m = gw; m < nrows; m += NGW) {
        const bool isctx = m >= ML; const int mi = isctx ? 4 : (m >> 12);
        const f32x4* xr = (const f32x4*)(isctx ? in_ctx + (size_t)(m - ML) * D : in_lat + (size_t)m * D) + F.lane;
        f32x4 v[16]; float ss = 0.f;
        if (CTXSUM && isctx) {
            const f32x4* p0 = (const f32x4*)(part + (size_t)(m - ML) * D) + F.lane;
#pragma unroll
            for (int j = 0; j < 16; ++j) v[j] = p0[64 * j];
#pragma unroll
            for (int sp = 1; sp < 4; ++sp) { const f32x4* ps = p0 + (size_t)sp * MC * (D / 4);
#pragma unroll
                for (int j = 0; j < 16; ++j) v[j] += ps[64 * j]; }
            const f32x4* gt = (const f32x4*)(mod + (size_t)4 * (NMOD * D) + (size_t)2 * D) + F.lane;
#pragma unroll
            for (int j = 0; j < 16; ++j) v[j] = xr[64 * j] + (gt[64 * j] * 0.5f) * v[j];
#pragma unroll
            for (int j = 0; j < 16; ++j) ss += (v[j].x * v[j].x + v[j].y * v[j].y) + (v[j].z * v[j].z + v[j].w * v[j].w);
        } else {
#pragma unroll
        for (int j = 0; j < 16; ++j) { v[j] = xr[64 * j]; ss += (v[j].x * v[j].x + v[j].y * v[j].y) + (v[j].z * v[j].z + v[j].w * v[j].w); }
        }
        const float rstd = 1.0f / sqrtf(wave_sum(ss) * (1.0f / D) + RMS_EPS);
        const f32x4* gp = (const f32x4*)gvec + F.lane;
        if constexpr (FINAL) {
            f32x4* op = (f32x4*)(outf + (size_t)m * D) + F.lane;
#pragma unroll
            for (int j = 0; j < 16; ++j) op[64 * j] = v[j] * rstd * gp[64 * j];
        } else {
            const f32x4* shp = (const f32x4*)(mod + (size_t)mi * (NMOD * D) + (size_t)shift_idx * D) + F.lane;
            const f32x4* scp = (const f32x4*)(mod + (size_t)mi * (NMOD * D) + (size_t)scale_idx * D) + F.lane;
            v2u* op = (v2u*)(outb + (size_t)m * D) + F.lane;
#pragma unroll
            for (int j = 0; j < 16; ++j) { const f32x4 o = (v[j] * rstd * gp[64 * j]) * (scp[64 * j] + 1.0f) + shp[64 * j];
                v2u w; w.x = cvt_pk_bf16(o.x, o.y); w.y = cvt_pk_bf16(o.z, o.w); op[64 * j] = w; }
        }
    }
}

template <bool FINAL>
__device__ __forceinline__ void norm_prep(Frame& F, LAS float* LA, LAS float* LB, const float* gvec, const float* mod, int mi, int shift_idx, int scale_idx) {
    for (int c = F.tid; c < D; c += NWAVES * 64) { const float g = gvec[c];
        if (FINAL) { LA[c] = g; LB[c] = 0.f; }
        else { LA[c] = g * (1.0f + mod[(size_t)mi * (NMOD * D) + (size_t)scale_idx * D + c]); LB[c] = mod[(size_t)mi * (NMOD * D) + (size_t)shift_idx * D + c]; } }
}
#define NIDX(j) (((j) >> 1) * 128 + ((j) & 1))
template <bool FINAL>
__device__ __forceinline__ void norm_row_out(Frame& F, const f32x4 (&v)[16], const LAS float* LA, const LAS float* LB, bf16* outb, float* outf, size_t m) {
    float ss = 0.f;
#pragma unroll
    for (int j = 0; j < 16; ++j) ss += (v[j].x * v[j].x + v[j].y * v[j].y) + (v[j].z * v[j].z + v[j].w * v[j].w);
    const float rstd = 1.0f / sqrtf(wave_sum(ss) * (1.0f / D) + RMS_EPS);
    const LAS f32x4* la = (const LAS f32x4*)LA + 2 * F.lane; const LAS f32x4* lb = (const LAS f32x4*)LB + 2 * F.lane;
    if constexpr (FINAL) { f32x4* op = (f32x4*)(outf + m * D) + 2 * F.lane;
#pragma unroll
        for (int j = 0; j < 16; ++j) op[NIDX(j)] = (v[j] * rstd) * la[NIDX(j)];
    } else { v4u* op = (v4u*)(outb + m * D) + F.lane;
#pragma unroll
        for (int jj = 0; jj < 8; ++jj) { const f32x4 o0 = (v[2 * jj] * rstd) * la[128 * jj] + lb[128 * jj], o1 = (v[2 * jj + 1] * rstd) * la[128 * jj + 1] + lb[128 * jj + 1];
            v4u w; w.x = cvt_pk_bf16(o0.x, o0.y); w.y = cvt_pk_bf16(o0.z, o0.w); w.z = cvt_pk_bf16(o1.x, o1.y); w.w = cvt_pk_bf16(o1.z, o1.w); op[64 * jj] = w; } }
}
template <bool FINAL, bool CTXSUM>
__device__ __forceinline__ void norm_phase(Frame& F, const float* in_lat, const float* in_ctx, bool do_ctx, const float* gvec, int shift_idx, int scale_idx, bf16* outb, float* outf, const float* part) {
    LAS float* LA = (LAS float*)F.lds; LAS float* LB = LA + D;
    const float* mod = (const float*)(F.ws + WS_MOD);
    const int nb = F.G / 4, b = (int)blockIdx.x / nb, bi = (int)blockIdx.x % nb;
    norm_prep<FINAL>(F, LA, LB, gvec, mod, b, shift_idx, scale_idx);
    __syncthreads();
    {
        f32x4 va[16], vb[16];
        int k = F.wave;
#define NP_ROW(kk) ((size_t)b * SEQ + bi + (size_t)nb * (kk))
#define NP_VALID(kk) (bi + nb * (kk) < SEQ)
#define NP_LOAD(dst, kk) do { const f32x4* xr_ = (const f32x4*)(in_lat + NP_ROW(kk) * D) + 2 * F.lane; _Pragma("unroll") for (int j = 0; j < 16; ++j) dst[j] = xr_[NIDX(j)]; } while (0)
        if (NP_VALID(k)) {
            NP_LOAD(va, k);
            for (;;) {
                const int k2 = k + NWAVES; const bool has2 = NP_VALID(k2);
                if (has2) NP_LOAD(vb, k2);
                norm_row_out<FINAL>(F, va, LA, LB, outb, outf, NP_ROW(k));
                if (!has2) break;
                const int k3 = k2 + NWAVES; const bool has3 = NP_VALID(k3);
                if (has3) NP_LOAD(va, k3);
                norm_row_out<FINAL>(F, vb, LA, LB, outb, outf, NP_ROW(k2));
                if (!has3) break;
                k = k3;
            }
        }
#undef NP_ROW
#undef NP_VALID
#undef NP_LOAD
    }
    if (do_ctx) {
        __syncthreads();
        norm_prep<FINAL>(F, LA, LB, gvec, mod, 4, shift_idx, scale_idx);
        __syncthreads();
        for (int r = (int)blockIdx.x + F.G * F.wave; r < MC; r += F.G * NWAVES) {
            const f32x4* xr = (const f32x4*)(in_ctx + (size_t)r * D) + 2 * F.lane; f32x4 v[16];
            if constexpr (CTXSUM) {
                const f32x4* ps = (const f32x4*)(part + (size_t)r * D) + 2 * F.lane;
#pragma unroll
                for (int j = 0; j < 16; ++j) v[j] = (f32x4){0.f, 0.f, 0.f, 0.f};
#pragma unroll 1
                for (int sp = 0; sp < 4; ++sp) {
#pragma unroll
                    for (int j = 0; j < 16; ++j) v[j] += ps[NIDX(j)];
                    ps += (size_t)MC * (D / 4); }
                const f32x4* gt = (const f32x4*)(mod + (size_t)4 * (NMOD * D) + (size_t)2 * D) + 2 * F.lane;
#pragma unroll
                for (int j = 0; j < 16; ++j) v[j] = xr[NIDX(j)] + (gt[NIDX(j)] * 0.5f) * v[j];
            } else {
#pragma unroll
                for (int j = 0; j < 16; ++j) v[j] = xr[NIDX(j)];
            }
            norm_row_out<FINAL>(F, v, LA, LB, outb, outf, (size_t)ML + r);
        }
    }
    __syncthreads();
}

__device__ __forceinline__ void ctx_scan(Frame& F) {
    const f32x2* bbar = (const f32x2*)(F.ws + WS_BBAR); const f32x2* lamb = (const f32x2*)(F.ws + WS_LAMB); f32x2* hctx = (f32x2*)(F.ws + WS_LAMB + 131072);
    const float* uscp = (const float*)(F.ws + WS_Z);
    LAS float* LU = (LAS float*)F.lds;
    for (int bg = blockIdx.x; bg < BATCH * SG; bg += F.G) {
        const int b = bg >> 6, g = bg & 63;
        for (int i = F.tid; i < CTXL * 4; i += NWAVES * 64) { const int t = i >> 2, q = i & 3; const float* src = uscp + (size_t)(b * CTXL + t) * SW + g * SK + q * 4;
            f32x4 v = *(const f32x4*)src;
#pragma unroll
            for (int sp = 1; sp < 4; ++sp) v += *(const f32x4*)(src + (size_t)sp * MC * SW);
            *(LAS f32x4*)(LU + t * 16 + q * 4) = v; }
        __syncthreads();
        if (F.wave < 2) {
            const int dir = F.wave, p = F.lane, idx = (dir * SG + g) * SP + p;
            f32x2 bb[16];
#pragma unroll
            for (int k = 0; k < 16; ++k) bb[k] = bbar[(size_t)idx * SK + k];
            const f32x2 lam = lamb[idx]; float hr = 0.f, hi = 0.f;
#pragma unroll 4
            for (int s_ = 0; s_ < CTXL; ++s_) { const int t = dir == 0 ? s_ : CTXL - 1 - s_;
                const LAS f32x4* up = (const LAS f32x4*)(LU + t * 16); float br = 0.f, bi = 0.f;
#pragma unroll
                for (int q = 0; q < 4; ++q) { const f32x4 u4 = up[q];
#pragma unroll
                    for (int e = 0; e < 4; ++e) { br += bb[q * 4 + e].x * u4[e]; bi += bb[q * 4 + e].y * u4[e]; } }
                const float nr = lam.x * hr - lam.y * hi + br, ni = lam.x * hi + lam.y * hr + bi; hr = nr; hi = ni; }
            hctx[((dir * BATCH + b) * SG + g) * SP + p] = (f32x2){hr, hi};
        }
        __syncthreads();
    }
}
__device__ __forceinline__ void chunk_recurrence(Frame& F) {
    const f32x2* lamT = (const f32x2*)(F.ws + WS_LAMB + 65536); const f32x2* hctx = (const f32x2*)(F.ws + WS_LAMB + 131072);
    const float* S = (const float*)(F.ws + WS_S); bf16* A2 = (bf16*)(F.ws + WS_A2);
    LAS float* LS = (LAS float*)F.lds;
    for (int gb = blockIdx.x; gb < SG * BATCH; gb += F.G) {
        const int g = gb >> 2, b = gb & 3; const size_t row0 = (size_t)g * A2R + b * NCH;
        const f32x4* src = (const f32x4*)(S + row0 * 256);
#pragma unroll
        for (int i = 0; i < 16; ++i) { const int o = i * (NWAVES * 64) + F.tid; ((LAS f32x4*)LS)[o] = src[o]; }
        __syncthreads();
        if (F.wave < 2) {
            const int dir = F.wave, p = F.lane;
            const f32x2 lt = lamT[(dir * SG + g) * SP + p]; const f32x2 h0 = hctx[((dir * BATCH + b) * SG + g) * SP + p]; float hr = h0.x, hi = h0.y;
#pragma unroll 4
            for (int s_ = 0; s_ < NCH; ++s_) { const int c = dir == 0 ? s_ : NCH - 1 - s_;
                const float sr = LS[c * 256 + dir * 128 + p], si = LS[c * 256 + dir * 128 + 64 + p];
                bf16* ap = A2 + (row0 + c) * A2K + CT * SK + dir * 128 + p;
                ap[0] = (bf16)(cvt_pk_bf16(hr, 0.f) & 0xffffu); ap[64] = (bf16)(cvt_pk_bf16(hi, 0.f) & 0xffffu);
                const float nr = lt.x * hr - lt.y * hi + sr, ni = lt.x * hi + lt.y * hr + si; hr = nr; hi = ni; }
        }
        __syncthreads();
    }
}
__device__ __forceinline__ void pool_units(Frame& F) {
    LAS float* L = (LAS float*)(F.lds); constexpr int RS = 520;
    const bf16* UP = (const bf16*)(F.ws + WS_UP); bf16* MIX = (bf16*)(F.ws + WS_MIX);
    const int tid = F.tid;
    const bool bal = F.G == 256; const int bx = (int)blockIdx.x, nmine = bal ? (bx < 128 ? 3 : 5) : (BATCH * 256 - bx + F.G - 1) / F.G;
    const int vr = (bx & 7) * 16 + ((bx >> 3) - 16);
    for (int ui = 0; ui < nmine; ++ui) {
        const int unit = !bal ? bx + ui * F.G : (ui < 3 ? F.vcu + ui * 256 : (ui == 3 ? 768 + vr : 896 + vr));
        const int b = unit >> 8, slice = unit & 255, w = 2 << (slice >> 6), hw = w >> 1;
        const v4u* src = (const v4u*)(UP + (size_t)(b * 256 + slice) * SEQ * 8);
        v4u keep[8];
#pragma unroll
        for (int i = 0; i < 8; ++i) { const int tok = i * 512 + tid; keep[i] = src[tok]; }
#pragma unroll
        for (int i = 0; i < 8; ++i) { const int tok = i * 512 + tid, r = tok >> 6, c = tok & 63; LAS f32x4* d = (LAS f32x4*)(L + r * RS + c * 8);
            d[0] = (f32x4){bf_lo(keep[i].x), bf_hi(keep[i].x), bf_lo(keep[i].y), bf_hi(keep[i].y)}; d[1] = (f32x4){bf_lo(keep[i].z), bf_hi(keep[i].z), bf_lo(keep[i].w), bf_hi(keep[i].w)}; }
        __syncthreads();
        { const int r = tid >> 3, ch = tid & 7; LAS float* p = L + r * RS + ch; float run = 0.f;
#pragma unroll 8
          for (int c = 0; c < 64; ++c) { run += p[c * 8]; p[c * 8] = run; } }
        __syncthreads();
        { const int c = tid >> 3, ch = tid & 7; LAS float* p = L + c * 8 + ch; float run = 0.f;
#pragma unroll 8
          for (int r = 0; r < 64; ++r) { run += p[r * RS]; p[r * RS] = run; } }
        __syncthreads();
#pragma unroll
        for (int i = 0; i < 8; ++i) { const int tok = i * 512 + tid, r = tok >> 6, c = tok & 63;
            const int rlo = r - hw < 0 ? 0 : r - hw, rhi = r + hw > 64 ? 64 : r + hw, clo = c - hw < 0 ? 0 : c - hw, chi = c + hw > 64 ? 64 : c + hw;
            const float inv = 1.0f / (float)((rhi - rlo) * (chi - clo));
            f32x4 s0, s1;
            { const LAS f32x4* q = (const LAS f32x4*)(L + (rhi - 1) * RS + (chi - 1) * 8); s0 = q[0]; s1 = q[1]; }
            if (rlo > 0) { const LAS f32x4* q = (const LAS f32x4*)(L + (rlo - 1) * RS + (chi - 1) * 8); s0 -= q[0]; s1 -= q[1]; }
            if (clo > 0) { const LAS f32x4* q = (const LAS f32x4*)(L + (rhi - 1) * RS + (clo - 1) * 8); s0 -= q[0]; s1 -= q[1]; }
            if (rlo > 0 && clo > 0) { const LAS f32x4* q = (const LAS f32x4*)(L + (rlo - 1) * RS + (clo - 1) * 8); s0 += q[0]; s1 += q[1]; }
            const f32x4 v0 = (f32x4){bf_lo(keep[i].x), bf_hi(keep[i].x), bf_lo(keep[i].y), bf_hi(keep[i].y)}, v1 = (f32x4){bf_lo(keep[i].z), bf_hi(keep[i].z), bf_lo(keep[i].w), bf_hi(keep[i].w)};
            const f32x4 o0 = s0 * inv - v0, o1 = s1 * inv - v1;
            v4u wv; wv.x = cvt_pk_bf16(o0.x, o0.y); wv.y = cvt_pk_bf16(o0.z, o0.w); wv.z = cvt_pk_bf16(o1.x, o1.y); wv.w = cvt_pk_bf16(o1.z, o1.w);
            *(v4u*)(MIX + (size_t)(b * SEQ + tok) * PW_ + slice * 8) = wv; }
        __syncthreads();
    }
}

constexpr int NPHASES = 16;
#ifndef WGM_FFN
#define WGM_FFN 8
#endif
#ifndef DUP_MASK
#define DUP_MASK 0
#endif
#ifndef DUP_SUB
#define DUP_SUB 0
#endif
#define REPS(k) _Pragma("unroll") for (int rep_ = 0; rep_ < ((((DUP_MASK) >> (k)) & 1) ? 2 : 1); ++rep_)
#ifndef MK_N_LAUNCHES
#define MK_N_LAUNCHES 1
#endif
struct Args { const float* in[27]; float* out; unsigned char* ws; int ph_lo, ph_hi; };
static_assert(sizeof(Args) == 27 * 8 + 8 + 8 + 8, "Args has no padding");

__global__ void __launch_bounds__(NWAVES * 64, 2) fwd_kernel(Args args) {
    extern __shared__ __attribute__((aligned(16))) unsigned char lds[];
    Frame F;
    F.lds = (LAS unsigned char*)lds;
    F.tid = threadIdx.x; F.lane = F.tid & 63; F.wave = __builtin_amdgcn_readfirstlane(F.tid >> 6);
    F.G = gridDim.x; { const int bx = blockIdx.x; F.vcu = (F.G % 8 == 0) ? (bx % 8) * (F.G / 8) + bx / 8 : bx; }
#pragma unroll
    for (int i = 0; i < 27; ++i) F.in[i] = args.in[i];
    F.out = args.out; F.ws = args.ws;
    volatile LAS unsigned* MISC = (volatile LAS unsigned*)(F.lds + MISC_OFF);
    if (F.tid < 32) MISC[F.tid] = 0u;
    __syncthreads();
    unsigned* ctl = (unsigned*)(F.ws + WS_CTL);
    XcdBarrier bar; bar.bar = ctl + CW_BAR; bar.x = 0; bar.st = nullptr;
    if (MK_N_LAUNCHES == 1) bar = xcd_barrier_post(ctl + CW_BAR, MISC + 8);
#define GRID_BAR() do { if (MK_N_LAUNCHES == 1) xcd_barrier(bar); } while (0)
    const int lo = args.ph_lo, hi = args.ph_hi;
#define IN(k) (lo <= (k) && (k) < hi)
#if defined(EXP_T_LO)
    unsigned long long tA_ = 0ull, tB_ = 0ull;
#define TSTAMP(k) do { if ((k) == EXP_T_LO) tA_ = __builtin_amdgcn_s_memrealtime(); if ((k) == EXP_T_HI) tB_ = __builtin_amdgcn_s_memrealtime(); } while (0)
#else
#define TSTAMP(k) do { } while (0)
#endif
    bool qdone = false;
#define FILL_TAIL(p, mand) do { if (!qdone) { phase_done(F, ctl + CW_DONE + 64 * (p)); qdone = fill_transposes(F, (mand), ctl + CW_DONE + 64 * (p)); } } while (0)
#define FILL_MAND(mand) do { if (!qdone) qdone = fill_transposes(F, (mand), nullptr); } while (0)
#define BOTH(k) (IN(k) && IN((k) + 1))
    unsigned char* ws = F.ws;
    LAS unsigned char* ring = F.lds + RING_OFF;
    volatile LAS int* DSLOT = (volatile LAS int*)(F.lds + MISC_OFF + 96);
    const float* mod = (const float*)(ws + WS_MOD);

    TSTAMP(0);
    if (IN(0)) REPS(0) {
        for (int w = blockIdx.x; w < SG * 4; w += F.G) p0_ssm_part(F, w >> 2, w & 3);
        p0_mod(F);
        (void)fill_transposes(F, Q_W1B, nullptr);
        if (BOTH(0)) GRID_BAR();
    }
    TSTAMP(1);
    if (IN(1)) REPS(1) {
        if (F.G % 4 == 0) norm_phase<false, false>(F, F.in[I_X], F.in[I_CTX], true, F.in[I_NORMG], 0, 1, (bf16*)(ws + WS_U), nullptr, nullptr);
        else norm_rows<false>(F, F.in[I_X], F.in[I_CTX], MA, F.in[I_NORMG], 0, 1, (bf16*)(ws + WS_U), nullptr);
        if (BOTH(1)) GRID_BAR();
#if defined(EXP_BARS)
        for (int eb = 0; eb < EXP_BARS; ++eb) GRID_BAR();
#endif
        }
    TSTAMP(2);
    if (IN(2)) REPS(2) {
        pg8::Gemm g{(const char*)(ws + WS_U), (const char*)(ws + WS_W1A), D, D, D, 0, 0};
        pg8::DynOrder<pg8::StaticOrder> S; S.B.init(MA, 2 * DFF, F.G, (int)blockIdx.x, WGM_FFN); S.ctr = ctl + CW_DYN + 128 * 2; S.slot = DSLOT; S.G = F.G; S.c = (int)blockIdx.x;
        EpiGated<0> E{(bf16*)(ws + WS_H), DFF};
#if defined(EXP_VAR)
        pg8::gemm_phase<EpiGated<0>, pg8::DynOrder<pg8::StaticOrder>, PG8_ALIGN, PG8_SP2, EXP_VAR>(ring, g, S, E); GRID_BAR();
#endif
        pg8::gemm_phase<EpiGated<0>, pg8::DynOrder<pg8::StaticOrder>, PG8_ALIGN, PG8_SP2, PG8_VAR>(ring, g, S, E);
        FILL_TAIL(2, Q_W1B); if (BOTH(2)) GRID_BAR();
    }
    TSTAMP(3);
    if (IN(3)) REPS(3) {
        pg8::Gemm g{(const char*)(ws + WS_H), (const char*)(ws + WS_W1B), DFF, DFF, DFF, 0, 0};
        pg8::DynOrder<pg8::SplitKOrder> S; S.ctr = ctl + CW_DYN + 128 * 3; S.slot = DSLOT; S.G = F.G; S.c = (int)blockIdx.x;
        S.B.S.init(ML, D, F.G, (int)blockIdx.x, 2); S.B.pm0 = ML / BM; S.B.npn = D / BM; S.B.ntiles = (MC / BM) * (D / BM); S.B.kt_a = 44; S.B.kt_b = 42;
        EpiResid E{F.in[I_X], F.in[I_CTX], (float*)(ws + WS_X), mod, 2, 0.5f, (float*)(ws + WS_T)};
#if defined(EXP3_VAR)
        pg8::gemm_phase<EpiResid, pg8::DynOrder<pg8::SplitKOrder>, PG8_ALIGN, PG8_SP2, EXP3_VAR>(ring, g, S, E); GRID_BAR();
#endif
        pg8::gemm_phase<EpiResid, pg8::DynOrder<pg8::SplitKOrder>, PG8_ALIGN, PG8_SP2, PG8_VAR>(ring, g, S, E);
        FILL_TAIL(3, Q_WIN); if (BOTH(3)) GRID_BAR();
    }
    TSTAMP(4);
    if (IN(4)) REPS(4) { const float* X = (const float*)(ws + WS_X);
        if (F.G % 4 == 0) norm_phase<false, true>(F, X, F.in[I_CTX], true, F.in[I_NORMG] + D, 3, 4, (bf16*)(ws + WS_U), nullptr, (const float*)(ws + WS_T));
        else norm_rows<false, true>(F, X, F.in[I_CTX], MA, F.in[I_NORMG] + D, 3, 4, (bf16*)(ws + WS_U), nullptr, (const float*)(ws + WS_T));
        if (BOTH(4)) GRID_BAR(); }
    TSTAMP(5);
    if (IN(5)) REPS(5) {
        pg8::Gemm g{(const char*)(ws + WS_U), (const char*)(ws + WS_WIN), D, D, D, 0, 0};
        pg8::DynOrder<pg8::SplitKOrder> S; S.ctr = ctl + CW_DYN + 128 * 5; S.slot = DSLOT; S.G = F.G; S.c = (int)blockIdx.x;
        S.B.S.init(ML, DIN, F.G, (int)blockIdx.x, WGM_FFN); S.B.pm0 = ML / BM; S.B.npn = SW / BM; S.B.ntiles = (MC / BM) * (SW / BM); S.B.kt_a = 16; S.B.kt_b = 16;
        EpiWin E{(bf16*)(ws + WS_A2), (float*)(ws + WS_Z), (bf16*)(ws + WS_UP), (bf16*)(ws + WS_GT)};
        pg8::gemm_phase<EpiWin, pg8::DynOrder<pg8::SplitKOrder>, PG8_ALIGN, PG8_SP2, PG8_VAR>(ring, g, S, E);
        FILL_TAIL(5, Q_WIN); if (BOTH(5)) GRID_BAR();
    }
    TSTAMP(6);
    if (IN(6)) REPS(6) {
        { pg8::Gemm g{(const char*)(ws + WS_A2), (const char*)(ws + WS_BTS), A2K, CT * SK, CT * SK, (long)A2R * A2K * 2, (long)256 * CT * SK * 2};
          pg8::GroupOrder S{A2R / BM, 1, SG, F.G, (int)blockIdx.x};
          EpiF32G E{(float*)(ws + WS_S), 256, (size_t)A2R * 256};
          pg8::gemm_phase<EpiF32G, pg8::GroupOrder, PG8_ALIGN, PG8_SP2, PG8_VAR>(ring, g, S, E); }
        ctx_scan(F);
        __syncthreads();
        pool_units(F);
        FILL_MAND(Q_POOL); if (BOTH(6)) GRID_BAR();
    }
    TSTAMP(7);
    if (IN(7)) REPS(7) {
        chunk_recurrence(F);
        { pg8::Gemm g{(const char*)(ws + WS_MIX), (const char*)(ws + WS_WPOOL), PW_, 512, 512, (long)512 * 2, (long)512 * 512 * 2};
          pg8::GroupOrder S{ML / BM, 512 / BM, 4, F.G, (int)blockIdx.x};
          EpiPool E{(bf16*)(ws + WS_YB), F.in[I_POOLS]};
          pg8::gemm_phase<EpiPool, pg8::GroupOrder, PG8_ALIGN, PG8_SP2, PG8_VAR>(ring, g, S, E); }
        FILL_MAND(Q_WB); if (BOTH(7)) GRID_BAR();
    }
    TSTAMP(8);
    if (IN(8)) REPS(8) {
        { pg8::Gemm g{(const char*)(ws + WS_A2), (const char*)(ws + WS_BTY), A2K, A2K, A2K, (long)A2R * A2K * 2, (long)(CT * SK) * A2K * 2};
          pg8::GroupOrder S{A2R / BM, (CT * SK) / BM, SG, F.G, F.vcu};
          EpiY E{(bf16*)(ws + WS_Z)};
          pg8::gemm_phase<EpiY, pg8::GroupOrder, PG8_ALIGN, PG8_SP2, PG8_VAR>(ring, g, S, E); }
        { pg8::Gemm g{(const char*)(ws + WS_YB), (const char*)(ws + WS_WB), PW_, PW_, PW_, 0, 0}; pg8::StaticOrder S; S.init(ML, D, F.G, (int)blockIdx.x, 4);
          EpiBranch<false> E{(bf16*)(ws + WS_T), (const bf16*)(ws + WS_GT), D};
          pg8::gemm_phase<EpiBranch<false>, pg8::StaticOrder, PG8_ALIGN, PG8_SP2, PG8_VAR>(ring, g, S, E); }
        FILL_MAND(Q_GLU); if (BOTH(8)) GRID_BAR();
    }
    TSTAMP(9);
    if (IN(9)) REPS(9) {
        pg8::Gemm g{(const char*)(ws + WS_Z), (const char*)(ws + WS_WGLU), SW, SW, SW, 0, 0}; pg8::StaticOrder S; S.init(ML, 2 * SW, F.G, (int)blockIdx.x);
        EpiGated<1> E{(bf16*)(ws + WS_GL), SW};
        pg8::gemm_phase<EpiGated<1>, pg8::StaticOrder, PG8_ALIGN, PG8_SP2, PG8_VAR>(ring, g, S, E);
        FILL_MAND(Q_WA); if (BOTH(9)) GRID_BAR();
    }
    TSTAMP(10);
    if (IN(10)) {
        pg8::Gemm g{(const char*)(ws + WS_GL), (const char*)(ws + WS_WA), SW, SW, SW, 0, 0}; pg8::StaticOrder S; S.init(ML, D, F.G, (int)blockIdx.x);
        EpiBranch<true> E{(bf16*)(ws + WS_T), (const bf16*)(ws + WS_GT), 0};
        pg8::gemm_phase<EpiBranch<true>, pg8::StaticOrder, PG8_ALIGN, PG8_SP2, PG8_VAR>(ring, g, S, E);
        FILL_MAND(Q_WOUT); if (BOTH(10)) GRID_BAR();
    }
    TSTAMP(11);
    if (IN(11)) {
        pg8::Gemm g{(const char*)(ws + WS_T), (const char*)(ws + WS_WOUT), D, D, D, 0, 0}; pg8::StaticOrder S; S.init(ML, D, F.G, (int)blockIdx.x, 4);
        EpiResid E{(const float*)(ws + WS_X), (const float*)(ws + WS_X) + (size_t)ML * D, (float*)(ws + WS_X), mod, 5, 1.0f, nullptr};
        pg8::gemm_phase<EpiResid, pg8::StaticOrder, PG8_ALIGN, PG8_SP2, PG8_VAR>(ring, g, S, E);
        FILL_MAND(Q_W2A); if (BOTH(11)) GRID_BAR();
    }
    TSTAMP(12);
    if (IN(12)) REPS(12) { const float* X = (const float*)(ws + WS_X);
        if (F.G % 4 == 0) norm_phase<false, false>(F, X, nullptr, false, F.in[I_NORMG] + 2 * D, 6, 7, (bf16*)(ws + WS_U), nullptr, nullptr);
        else norm_rows<false>(F, X, X + (size_t)ML * D, ML, F.in[I_NORMG] + 2 * D, 6, 7, (bf16*)(ws + WS_U), nullptr);
        if (BOTH(12)) GRID_BAR(); }
    TSTAMP(13);
    if (IN(13)) REPS(13) {
        pg8::Gemm g{(const char*)(ws + WS_U), (const char*)(ws + WS_W2A), D, D, D, 0, 0};
        pg8::DynOrder<pg8::StaticOrder> S; S.B.init(ML, 2 * DFF, F.G, (int)blockIdx.x, WGM_FFN); S.ctr = ctl + CW_DYN + 128 * 13; S.slot = DSLOT; S.G = F.G; S.c = (int)blockIdx.x;
        EpiGated<0> E{(bf16*)(ws + WS_H), DFF};
        pg8::gemm_phase<EpiGated<0>, pg8::DynOrder<pg8::StaticOrder>, PG8_ALIGN, PG8_SP2, PG8_VAR>(ring, g, S, E);
        FILL_TAIL(13, Q_W2B); if (BOTH(13)) GRID_BAR();
    }
    TSTAMP(14);
    if (IN(14)) {
        pg8::Gemm g{(const char*)(ws + WS_H), (const char*)(ws + WS_W2B), DFF, DFF, DFF, 0, 0}; pg8::StaticOrder S; S.init(ML, D, F.G, (int)blockIdx.x, 2);
        EpiResid E{(const float*)(ws + WS_X), (const float*)(ws + WS_X) + (size_t)ML * D, (float*)(ws + WS_X), mod, 8, 0.5f, nullptr};
        pg8::gemm_phase<EpiResid, pg8::StaticOrder, PG8_ALIGN, PG8_SP2, PG8_VAR>(ring, g, S, E);
        if (BOTH(14)) GRID_BAR();
    }
    TSTAMP(15);
    if (IN(15)) REPS(15) { const float* X = (const float*)(ws + WS_X);
        if (F.G % 4 == 0) norm_phase<true, false>(F, X, nullptr, false, F.in[I_FINALG], 0, 0, nullptr, F.out, nullptr);
        else norm_rows<true>(F, X, X, ML, F.in[I_FINALG], 0, 0, nullptr, F.out); }
    TSTAMP(16);
#if defined(EXP_T_LO)
    if (blockIdx.x == 0) { const unsigned long long t0_ = __builtin_amdgcn_s_memrealtime(), w_ = (tB_ - tA_) * EXP_T_MUL; while (__builtin_amdgcn_s_memrealtime() - t0_ < w_) __builtin_amdgcn_s_sleep(8); }
#endif
#undef IN
#undef BOTH
#undef GRID_BAR
}

extern "C" void kernel_launch(void* const* d_in, const int* in_sizes, int n_in, void* d_out, int out_size, void* d_ws, size_t ws_size, hipStream_t stream) {
    static int grid = 0;
    if (grid == 0) {
        if (n_in != 27 || in_sizes[0] != ML * D || out_size != ML * D || ws_size < WS_END) { fprintf(stderr, "kernel_launch: unexpected shapes (n_in %d, in0 %d, out %d, ws %zu < %zu); nothing launched\n", n_in, n_in > 0 ? in_sizes[0] : -1, out_size, ws_size, (size_t)WS_END); grid = -1; return; }
        int dev = 0, cus = 0, per_cu = 0;
        if (hipGetDevice(&dev) != hipSuccess || hipDeviceGetAttribute(&cus, hipDeviceAttributeMultiprocessorCount, dev) != hipSuccess) { fprintf(stderr, "kernel_launch: device query failed\n"); grid = -1; return; }
        if (hipFuncSetAttribute((const void*)fwd_kernel, hipFuncAttributeMaxDynamicSharedMemorySize, LDS_BYTES) != hipSuccess) { fprintf(stderr, "kernel_launch: hipFuncSetAttribute failed\n"); grid = -1; return; }
        if (hipOccupancyMaxActiveBlocksPerMultiprocessor(&per_cu, (const void*)fwd_kernel, NWAVES * 64, LDS_BYTES) != hipSuccess || per_cu < 1) fprintf(stderr, "kernel_launch: note: occupancy query reports %d workgroups per CU\n", per_cu);
        (void)hipGetLastError();
        grid = cus;
    }
    if (grid < 0) return;
    if (hipMemsetAsync((char*)d_ws + WS_CTL, 0, CTL_ZERO_BYTES, stream) != hipSuccess) { fprintf(stderr, "kernel_launch: memset failed\n"); return; }
    Args a{};
    for (int i = 0; i < 27; ++i) a.in[i] = (const float*)d_in[i];
    a.out = (float*)d_out; a.ws = (unsigned char*)d_ws;
    for (int li = 0; li < MK_N_LAUNCHES; ++li) {
        a.ph_lo = (MK_N_LAUNCHES == 1) ? 0 : li; a.ph_hi = (MK_N_LAUNCHES == 1) ? NPHASES : li + 1;
        hipLaunchKernelGGL(fwd_kernel, dim3(grid), dim3(NWAVES * 64), LDS_BYTES, stream, a);
        const hipError_t le = hipPeekAtLastError();
        if (le != hipSuccess) { fprintf(stderr, "kernel_launch: launch %d failed: %s\n", li, hipGetErrorName(le)); break; }
    }
}
```

```cpp
#include <hip/hip_runtime.h>
#include <cstdio>
#include <cstdint>

namespace pg8 {
#define PG8_LAS __attribute__((address_space(3)))
typedef unsigned short bf16_t;
typedef short bf16x8 __attribute__((ext_vector_type(8)));
typedef float f32x4 __attribute__((ext_vector_type(4)));
typedef unsigned u32x4 __attribute__((ext_vector_type(4)));
constexpr int BM = 256, BK = 64, HALF = 128, HTB = HALF * BK * 2  , STAGE_BYTES = 8 * HTB, NXCD = 8, WGM = 8;

__host__ __device__ __forceinline__ int lds_byte(int r, int c) { const int st = (r >> 4) * 2 + (c >> 5), rr = r & 15, cc = c & 31, ob = rr * 64 + cc * 2; return st * 1024 + (ob ^ (((ob >> 9) & 1) << 5)); }
__host__ __device__ __forceinline__ void stage_rc(int b, int& R, int& C) { const int st = b / 1024, sb = b % 1024, swz = sb ^ (((sb >> 9) & 1) << 5); R = (st >> 1) * 16 + swz / 64; C = (st & 1) * 32 + (swz % 64) / 2; }
__host__ __device__ __forceinline__ int perm32(int rho) { const int n = rho >> 4, i = rho & 15; return 8 * (i >> 2) + 4 * n + (i & 3); }

struct Unit { int pm, pn, g, kt0, nkt; };
struct Gemm { const char* A; const char* Bt; int lda, ldb, K; long gsa, gsb; };

struct StaticOrder {
    int nM, nN, nwg, G, c, wgm;
    __host__ __device__ void init(int M, int N, int G_, int c_, int wgm_ = WGM) { nM = M / BM; nN = N / BM; nwg = nM * nN; G = G_; c = c_; wgm = wgm_; }
    static constexpr bool DYNAMIC = false;
    __host__ __device__ int total() const { return nwg; }
    __host__ __device__ bool next(int i, Unit& u) const { return at((long)i * G + c, u); }
    __host__ __device__ bool at(long L, Unit& u) const {
        if (L >= nwg) return false;
        int wgid = (int)L; { const int q = nwg / NXCD, r = nwg % NXCD, xcd = wgid % NXCD, off = wgid / NXCD; wgid = (xcd < r ? xcd * (q + 1) : r * (q + 1) + (xcd - r) * q) + off; }
        const int nig = wgm * nN, gid = wgid / nig, fm = gid * wgm, gsz = (nM - fm) < wgm ? (nM - fm) : wgm;
        u.pm = fm + ((wgid % nig) % gsz); u.pn = (wgid % nig) / gsz; u.g = 0; u.kt0 = 0; u.nkt = 0; return true;
    }
    __device__ __forceinline__ void a_ready(const Unit&) const {}
    __device__ __forceinline__ void done(const Unit&) const {}
};
struct GroupOrder {
    static constexpr bool DYNAMIC = false;
    int nM, nN, ng, G, c;
    __device__ bool next(int i, Unit& u) const {
        const long L = (long)i * G + c; const int per = nM * nN; if (L >= (long)ng * per) return false;
        u.g = (int)(L / per); const int r = (int)(L % per); u.pm = r % nM; u.pn = r / nM; u.kt0 = 0; u.nkt = 0; return true;
    }
    __device__ __forceinline__ void a_ready(const Unit&) const {}
    __device__ __forceinline__ void done(const Unit&) const {}
};

struct SplitKOrder {
    StaticOrder S; int pm0, npn, ntiles, kt_a, kt_b;
    static constexpr bool DYNAMIC = false;
    __device__ int total() const { return S.nwg + 4 * ntiles; }
    __device__ bool next(int i, Unit& u) const { return at((long)i * S.G + S.c, u); }
    __device__ bool at(long L, Unit& u) const {
        if (L < S.nwg) return S.at(L, u);
        const int j = (int)(L - S.nwg); if (j >= 4 * ntiles) return false;
        const int split = j & 3, tile = j >> 2;
        u.pm = pm0 + tile / npn; u.pn = tile % npn; u.g = split + 1; u.kt0 = split < 2 ? split * kt_a : 2 * kt_a + (split - 2) * kt_b; u.nkt = split < 2 ? kt_a : kt_b; return true;
    }
    __device__ __forceinline__ void a_ready(const Unit&) const {}
    __device__ __forceinline__ void done(const Unit&) const {}
};

template <class Base> struct DynOrder {
    static constexpr bool DYNAMIC = true;
    Base B; unsigned* ctr; volatile PG8_LAS int* slot; int G, c;
    __device__ int total() const { return B.total(); }
    __device__ bool at(long L, Unit& u) const { return B.at(L, u); }
    __device__ int pull() const {
        const int x = c & 7, tot = B.total();
        for (int s_ = 0; s_ < 8; ++s_) { const int y = (x + s_) & 7, n0 = (G - y + 7) >> 3;
            const unsigned k = (unsigned)n0 + __hip_atomic_fetch_add(ctr + 16 * y, 1u, __ATOMIC_RELAXED, __HIP_MEMORY_SCOPE_AGENT);
            const long L = 8l * (long)k + y; if (L < tot) return (int)L; }
        return -1;
    }
    __device__ __forceinline__ void a_ready(const Unit&) const {}
    __device__ __forceinline__ void done(const Unit&) const {}
};

__device__ __forceinline__ unsigned cvt_pk_bf16(float lo, float hi) { unsigned r; asm volatile("v_cvt_pk_bf16_f32 %0, %1, %2" : "=v"(r) : "v"(lo), "v"(hi)); return r; }
__device__ __forceinline__ float sigmoidf_fast(float x) { return __builtin_amdgcn_rcpf(1.0f + __expf(-x)); }
__device__ __forceinline__ float bf_lo(unsigned w) { return __uint_as_float(w << 16); }
__device__ __forceinline__ float bf_hi(unsigned w) { return __uint_as_float(w & 0xffff0000u); }

template <class Epi, class Sched, bool ALIGN_EPI = false, bool SP2 = false, int VAR = 0>
__device__ __forceinline__ void gemm_phase(PG8_LAS unsigned char* lds, const Gemm g, const Sched& S, const Epi& E) {
    const int tid = threadIdx.x, wid = __builtin_amdgcn_readfirstlane(tid >> 6), lane = tid & 63, wr = wid >> 2, wc = wid & 3, fr = lane & 15, fq = lane >> 4;
    const int K = g.K, nt = K / BK;
    unsigned voffA[2], voffB[2];
#pragma unroll
    for (int i = 0; i < 2; ++i) { int R, C; stage_rc(tid * 16 + i * 8192, R, C); const int Rb = Epi::PERM ? ((R & ~31) + perm32(R & 31)) : R;
        voffA[i] = (unsigned)(R * g.lda + C) * 2u; voffB[i] = (unsigned)(Rb * g.ldb + C) * 2u; }
    const size_t kstep = (size_t)(BK * 2);
    const size_t hsA = (size_t)HALF * g.lda * 2, hsB = (size_t)HALF * g.ldb * 2;
    const size_t tsA = 2 * hsA, tsB = 2 * hsB;
    const unsigned ldsw = (unsigned)wid * 1024u;
    const int aoff = lds_byte(wr * 64 + fr, fq * 8), boff = lds_byte(wc * 32 + fr, fq * 8);
#define PG8_SA(b, h) (((b) * 2 + (h)) * HTB)
#define PG8_SB(b, h) ((4 + (b) * 2 + (h)) * HTB)
#define PG8_STAGE(bufoff, gbase, voff) do { if (!(VAR & 1)) _Pragma("unroll") for (int _i = 0; _i < 2; ++_i) \
        __builtin_amdgcn_global_load_lds((const unsigned*)((const char*)(gbase) + (voff)[_i]), (PG8_LAS unsigned*)(lds + (bufoff) + ldsw + _i * 8192), 16, 0, 0); } while (0)
#define PG8_LDA(dst, b, h) do { if (!(VAR & 2)) _Pragma("unroll") for (int m = 0; m < 4; ++m) _Pragma("unroll") for (int k = 0; k < 2; ++k) dst[m][k] = *(const PG8_LAS bf16x8*)(lds + PG8_SA(b, h) + aoff + m * 2048 + k * 1024); } while (0)
#define PG8_LDB(dst, b, h) do { if (!(VAR & 2)) _Pragma("unroll") for (int n = 0; n < 2; ++n) _Pragma("unroll") for (int k = 0; k < 2; ++k) dst[n][k] = *(const PG8_LAS bf16x8*)(lds + PG8_SB(b, h) + boff + n * 2048 + k * 1024); } while (0)
#define PG8_MMA(ai, bj, At, Bt) do { if (!(VAR & 128)) __builtin_amdgcn_s_setprio(1); if (!(VAR & 4)) _Pragma("unroll") for (int m = 0; m < 4; ++m) _Pragma("unroll") for (int n = 0; n < 2; ++n) _Pragma("unroll") for (int k = 0; k < 2; ++k) \
        acc[ai][bj][m][n] = __builtin_amdgcn_mfma_f32_16x16x32_bf16(Bt[n][k], At[m][k], acc[ai][bj][m][n], 0, 0, 0); if (!(VAR & 128)) __builtin_amdgcn_s_setprio(0); } while (0)
#define PG8_WAIT_V(n) asm volatile("s_waitcnt vmcnt(" #n ")" ::: "memory")
#define PG8_WAIT_L(n) asm volatile("s_waitcnt lgkmcnt(" #n ")" ::: "memory")
#define PG8_BAR __builtin_amdgcn_s_barrier()
#define PG8_SCHED __builtin_amdgcn_sched_barrier(0)
    Unit cur, nxt; int ui = 0;
    if constexpr (Sched::DYNAMIC) {
        if (!S.at(S.c, cur)) return;
        if (tid == 0) S.slot[1] = S.pull();
        __syncthreads();
    } else { if (!S.next(0, cur)) return; }
    if constexpr (VAR & 128) { if (wr == 1) __builtin_amdgcn_s_setprio(1); }
    f32x4 acc[2][2][4][2];
#pragma unroll
    for (int a = 0; a < 2; ++a)
#pragma unroll
        for (int b = 0; b < 2; ++b)
#pragma unroll
            for (int m = 0; m < 4; ++m)
#pragma unroll
                for (int n = 0; n < 2; ++n) acc[a][b][m][n] = (f32x4){0.f, 0.f, 0.f, 0.f};
    bf16x8 At[4][2], B0[2][2], B1[2][2];
    if (VAR & 2) {
#pragma unroll
        for (int m = 0; m < 4; ++m)
#pragma unroll
            for (int k = 0; k < 2; ++k) { At[m][k] = (bf16x8){0, 0, 0, 0, 0, 0, 0, 0}; asm volatile("" : "+v"(At[m][k])); }
#pragma unroll
        for (int n = 0; n < 2; ++n)
#pragma unroll
            for (int k = 0; k < 2; ++k) { B0[n][k] = (bf16x8){0, 0, 0, 0, 0, 0, 0, 0}; B1[n][k] = B0[n][k]; asm volatile("" : "+v"(B0[n][k])); asm volatile("" : "+v"(B1[n][k])); }
    }
    const bool grouped = g.gsa != 0 || g.gsb != 0;
    const char* cA = g.A + (grouped ? (size_t)cur.g * g.gsa : 0) + (size_t)((VAR & 8) ? 0 : cur.pm) * tsA + (size_t)cur.kt0 * kstep; const char* cB = g.Bt + (grouped ? (size_t)cur.g * g.gsb : 0) + (size_t)((VAR & 8) ? 0 : cur.pn) * tsB + (size_t)cur.kt0 * kstep;
    S.a_ready(cur);
    if constexpr (SP2) {
        PG8_STAGE(PG8_SB(0, 0), cB, voffB); PG8_STAGE(PG8_SB(0, 1), cB + hsB, voffB); PG8_STAGE(PG8_SA(0, 0), cA, voffA); PG8_STAGE(PG8_SA(0, 1), cA + hsA, voffA);
        if (wr == 1) PG8_BAR;
        PG8_WAIT_V(2); PG8_BAR;
        PG8_STAGE(PG8_SB(1, 0), cB + kstep, voffB); PG8_STAGE(PG8_SA(1, 0), cA + kstep, voffA); PG8_STAGE(PG8_SB(1, 1), cB + hsB + kstep, voffB);
        PG8_WAIT_V(6); PG8_BAR;
    } else {
        PG8_STAGE(PG8_SB(0, 0), cB, voffB); PG8_STAGE(PG8_SA(0, 0), cA, voffA); PG8_STAGE(PG8_SB(0, 1), cB + hsB, voffB); PG8_STAGE(PG8_SA(0, 1), cA + hsA, voffA);
        if (wr == 1) PG8_BAR;
        PG8_WAIT_V(4); PG8_BAR;
        PG8_STAGE(PG8_SB(1, 0), cB + kstep, voffB); PG8_STAGE(PG8_SA(1, 0), cA + kstep, voffA); PG8_STAGE(PG8_SB(1, 1), cB + hsB + kstep, voffB);
        PG8_WAIT_V(6); PG8_BAR;
    }
    unsigned sink = 0u; const int tidx = wid * 12 + lane; const bool t_isA = tidx < 64; constexpr int PD = 4;
    for (;;) {
        bool has_next = false; const char* nA = cA; const char* nB = cB;
#define PG8_NEXT_PTRS() do { nA = has_next ? g.A + (grouped ? (size_t)nxt.g * g.gsa : 0) + (size_t)((VAR & 8) ? 0 : nxt.pm) * tsA + (size_t)nxt.kt0 * kstep : cA; \
                             nB = has_next ? g.Bt + (grouped ? (size_t)nxt.g * g.gsb : 0) + (size_t)((VAR & 8) ? 0 : nxt.pn) * tsB + (size_t)nxt.kt0 * kstep : cB; } while (0)
        if constexpr (!Sched::DYNAMIC) { has_next = S.next(ui + 1, nxt); PG8_NEXT_PTRS(); }
        const int ntu = cur.nkt ? cur.nkt : nt;
        const unsigned toff = t_isA ? (unsigned)(((cur.pn & 3) * 64 + tidx) * g.lda) * 2u : (unsigned)(((cur.pm & 7) * 32 + (tidx - 64)) * g.ldb) * 2u;
#define PG8_TOUCH(tt) do { if constexpr (VAR & 64) { const int tp_ = (tt) + PD; const char* ta_ = tp_ < ntu ? cA + (size_t)tp_ * kstep : nA + (size_t)(tp_ - ntu) * kstep; \
            const char* tb_ = tp_ < ntu ? cB + (size_t)tp_ * kstep : nB + (size_t)(tp_ - ntu) * kstep; const char* tpp_ = (t_isA ? ta_ : tb_) + toff; \
            if (lane < 12) asm volatile("global_load_dword %0, %1, off" : "+v"(sink) : "v"(tpp_) : "memory"); } } while (0)
        for (int t = 0; t < ntu; t += 2) {
            const bool last = (t == ntu - 2);
            if constexpr (Sched::DYNAMIC) { if (last) {
                const int nL = __builtin_amdgcn_readfirstlane(S.slot[(ui + 1) & 1]); has_next = nL >= 0; if (has_next) has_next = S.at(nL, nxt); PG8_NEXT_PTRS(); } }
            const char* a1 = cA + (size_t)(t + 1) * kstep;
            const char* a2 = last ? nA : cA + (size_t)(t + 2) * kstep; const char* b2 = last ? nB : cB + (size_t)(t + 2) * kstep;
            const char* a3 = a2 + kstep; const char* b3 = b2 + kstep;
            if (last && has_next) S.a_ready(nxt);
            if constexpr (SP2) {
            if constexpr (VAR & 256) { PG8_STAGE(PG8_SA(1, 1), a1 + hsA, voffA); PG8_SCHED; PG8_LDB(B0, 0, 0); PG8_LDB(B1, 0, 1); PG8_SCHED; PG8_LDA(At, 0, 0); } else {
            PG8_LDB(B0, 0, 0); PG8_LDB(B1, 0, 1); PG8_SCHED; PG8_LDA(At, 0, 0); PG8_STAGE(PG8_SA(1, 1), a1 + hsA, voffA); } PG8_TOUCH(t);
            if constexpr ((VAR & 96) == 96) { PG8_WAIT_L(0); PG8_BAR; PG8_MMA(0, 0, At, B0); PG8_MMA(0, 1, At, B1); PG8_WAIT_V(10); PG8_BAR; PG8_SCHED; } else
            if constexpr (VAR & 32) { if (wr == 1) PG8_WAIT_V(8); PG8_WAIT_L(0); PG8_BAR; PG8_MMA(0, 0, At, B0); PG8_MMA(0, 1, At, B1); if (wr == 0) PG8_WAIT_V(8); PG8_BAR; PG8_SCHED; } else {
            PG8_WAIT_V(8); PG8_WAIT_L(0); PG8_BAR; PG8_MMA(0, 0, At, B0); PG8_MMA(0, 1, At, B1); PG8_BAR; PG8_SCHED; }
            if constexpr (VAR & 16) {
            PG8_LDA(At, 0, 1); PG8_STAGE(PG8_SB(0, 0), b2, voffB); PG8_STAGE(PG8_SB(0, 1), b2 + hsB, voffB);
            PG8_WAIT_V(6); PG8_WAIT_L(0); PG8_BAR; PG8_MMA(1, 0, At, B0); PG8_SCHED; PG8_STAGE(PG8_SA(0, 0), a2, voffA); PG8_SCHED; PG8_MMA(1, 1, At, B1); PG8_BAR; PG8_SCHED;
            } else {
            if constexpr (VAR & 256) { PG8_STAGE(PG8_SB(0, 0), b2, voffB); PG8_STAGE(PG8_SB(0, 1), b2 + hsB, voffB); PG8_STAGE(PG8_SA(0, 0), a2, voffA); PG8_SCHED; PG8_LDA(At, 0, 1); } else {
            PG8_LDA(At, 0, 1); PG8_STAGE(PG8_SB(0, 0), b2, voffB); PG8_STAGE(PG8_SB(0, 1), b2 + hsB, voffB); PG8_STAGE(PG8_SA(0, 0), a2, voffA); }
            if constexpr ((VAR & 96) == 96) { PG8_WAIT_L(0); PG8_BAR; PG8_MMA(1, 0, At, B0); PG8_MMA(1, 1, At, B1); PG8_WAIT_V(9); PG8_BAR; PG8_SCHED; } else
            if constexpr (VAR & 32) { if (wr == 1) PG8_WAIT_V(8); PG8_WAIT_L(0); PG8_BAR; PG8_MMA(1, 0, At, B0); PG8_MMA(1, 1, At, B1); if (wr == 0) PG8_WAIT_V(8); PG8_BAR; PG8_SCHED; } else {
            PG8_WAIT_V(8); PG8_WAIT_L(0); PG8_BAR; PG8_MMA(1, 0, At, B0); PG8_MMA(1, 1, At, B1); PG8_BAR; PG8_SCHED; }
            }
            if constexpr (VAR & 256) { PG8_STAGE(PG8_SA(0, 1), a2 + hsA, voffA); PG8_SCHED; PG8_LDB(B0, 1, 0); PG8_LDB(B1, 1, 1); PG8_SCHED; PG8_LDA(At, 1, 0); } else {
            PG8_LDB(B0, 1, 0); PG8_LDB(B1, 1, 1); PG8_SCHED; PG8_LDA(At, 1, 0); PG8_STAGE(PG8_SA(0, 1), a2 + hsA, voffA); } PG8_TOUCH(t + 1);
            if constexpr ((VAR & 96) == 96) { PG8_WAIT_L(0); PG8_BAR; PG8_MMA(0, 0, At, B0); PG8_MMA(0, 1, At, B1); PG8_WAIT_V(10); PG8_BAR; PG8_SCHED; } else
            if constexpr (VAR & 32) { if (wr == 1) PG8_WAIT_V(8); PG8_WAIT_L(0); PG8_BAR; PG8_MMA(0, 0, At, B0); PG8_MMA(0, 1, At, B1); if (wr == 0) PG8_WAIT_V(8); PG8_BAR; PG8_SCHED; } else {
            PG8_WAIT_V(8); PG8_WAIT_L(0); PG8_BAR; PG8_MMA(0, 0, At, B0); PG8_MMA(0, 1, At, B1); PG8_BAR; PG8_SCHED; }
            if constexpr (VAR & 16) {
            PG8_LDA(At, 1, 1); PG8_STAGE(PG8_SB(1, 0), b3, voffB); PG8_STAGE(PG8_SB(1, 1), b3 + hsB, voffB);
            PG8_WAIT_V(6); PG8_WAIT_L(0); PG8_BAR; PG8_MMA(1, 0, At, B0); PG8_SCHED; PG8_STAGE(PG8_SA(1, 0), a3, voffA); PG8_SCHED; PG8_MMA(1, 1, At, B1); PG8_BAR; PG8_SCHED;
            } else {
            if constexpr (VAR & 256) { PG8_STAGE(PG8_SB(1, 0), b3, voffB); PG8_STAGE(PG8_SB(1, 1), b3 + hsB, voffB); PG8_STAGE(PG8_SA(1, 0), a3, voffA); PG8_SCHED; PG8_LDA(At, 1, 1); } else {
            PG8_LDA(At, 1, 1); PG8_STAGE(PG8_SB(1, 0), b3, voffB); PG8_STAGE(PG8_SB(1, 1), b3 + hsB, voffB); PG8_STAGE(PG8_SA(1, 0), a3, voffA); }
            if constexpr ((VAR & 96) == 96) { PG8_WAIT_L(0); PG8_BAR; PG8_MMA(1, 0, At, B0); PG8_MMA(1, 1, At, B1); PG8_WAIT_V(9); PG8_BAR; PG8_SCHED; } else
            if constexpr (VAR & 32) { if (wr == 1) PG8_WAIT_V(8); PG8_WAIT_L(0); PG8_BAR; PG8_MMA(1, 0, At, B0); PG8_MMA(1, 1, At, B1); if (wr == 0) PG8_WAIT_V(8); PG8_BAR; PG8_SCHED; } else {
            PG8_WAIT_V(8); PG8_WAIT_L(0); PG8_BAR; PG8_MMA(1, 0, At, B0); PG8_MMA(1, 1, At, B1); PG8_BAR; PG8_SCHED; }
            }
            } else {
            PG8_LDB(B0, 0, 0); PG8_SCHED; PG8_LDA(At, 0, 0); PG8_STAGE(PG8_SA(1, 1), a1 + hsA, voffA);
            PG8_WAIT_L(8); PG8_BAR; PG8_WAIT_L(0); PG8_MMA(0, 0, At, B0); PG8_BAR; PG8_SCHED;
            PG8_LDB(B1, 0, 1); PG8_STAGE(PG8_SB(0, 0), b2, voffB);
            PG8_BAR; PG8_WAIT_L(0); PG8_MMA(0, 1, At, B1); PG8_BAR;
            PG8_LDA(At, 0, 1); PG8_STAGE(PG8_SA(0, 0), a2, voffA);
            PG8_BAR; PG8_WAIT_L(0); PG8_MMA(1, 0, At, B0); PG8_BAR; PG8_SCHED;
            PG8_STAGE(PG8_SB(0, 1), b2 + hsB, voffB);
            PG8_WAIT_V(6); PG8_BAR; PG8_MMA(1, 1, At, B1); PG8_BAR;
            PG8_LDB(B0, 1, 0); PG8_SCHED; PG8_LDA(At, 1, 0); PG8_STAGE(PG8_SA(0, 1), a2 + hsA, voffA);
            PG8_WAIT_L(8); PG8_BAR; PG8_WAIT_L(0); PG8_MMA(0, 0, At, B0); PG8_BAR; PG8_SCHED;
            PG8_LDB(B1, 1, 1); PG8_STAGE(PG8_SB(1, 0), b3, voffB);
            PG8_BAR; PG8_WAIT_L(0); PG8_MMA(0, 1, At, B1); PG8_BAR;
            PG8_LDA(At, 1, 1); PG8_STAGE(PG8_SA(1, 0), a3, voffA);
            PG8_BAR; PG8_WAIT_L(0); PG8_MMA(1, 0, At, B0); PG8_BAR; PG8_SCHED;
            PG8_STAGE(PG8_SB(1, 1), b3 + hsB, voffB);
            PG8_WAIT_V(6); PG8_BAR; PG8_MMA(1, 1, At, B1); PG8_BAR;
            }
        }
        if constexpr (ALIGN_EPI) { if (wr == 0) PG8_BAR; }
        int pulled = -1;
        if constexpr (Sched::DYNAMIC) { if (has_next && tid == 0) pulled = S.pull(); }
        E(acc, cur, wr, wc, fr, fq); S.done(cur);
        if constexpr (Sched::DYNAMIC) { if (has_next && tid == 0) S.slot[ui & 1] = pulled; }
        if (!has_next) break;
#pragma unroll
        for (int a = 0; a < 2; ++a)
#pragma unroll
            for (int b = 0; b < 2; ++b)
#pragma unroll
                for (int m = 0; m < 4; ++m)
#pragma unroll
                    for (int n = 0; n < 2; ++n) acc[a][b][m][n] = (f32x4){0.f, 0.f, 0.f, 0.f};
        cur = nxt; cA = nA; cB = nB; ++ui;
        if constexpr (ALIGN_EPI) { if (wr == 1) PG8_BAR; }
    }
    if constexpr (VAR & 128) __builtin_amdgcn_s_setprio(0);
    PG8_WAIT_V(0);
    asm volatile("" :: "v"(sink));
    if constexpr (!ALIGN_EPI) { if (wr == 0) PG8_BAR; }
    PG8_BAR;
#undef PG8_TOUCH
#undef PG8_NEXT_PTRS
#undef PG8_SA
#undef PG8_SB
#undef PG8_STAGE
#undef PG8_LDA
#undef PG8_LDB
#undef PG8_MMA
#undef PG8_WAIT_V
#undef PG8_WAIT_L
#undef PG8_BAR
#undef PG8_SCHED
}
}

#ifndef PG8_SP2
#define PG8_SP2 true
#endif
#ifndef PG8_ALIGN
#define PG8_ALIGN true
#endif
#ifndef PG8_VAR
#define PG8_VAR 0
#endif

constexpr int NWAVES = 8;
constexpr int D = 4096, BATCH = 4, SEQ = 4096, CTXL = 256, DFF = 11008, NMOD = 9;
constexpr int ML = BATCH * SEQ;
constexpr int MC = BATCH * CTXL;
constexpr int MA = ML + MC;
constexpr int SW = 1024, SG = 64, SK = 16, SP = 64;
constexpr int PW_ = 2048;
constexpr int DIN = SW + PW_ + 2 * D;
constexpr int CT = 32;
constexpr int NCH = SEQ / CT;
constexpr int A2R = BATCH * NCH;
constexpr int A2K = CT * SK + 4 * SP;
constexpr float RMS_EPS = 1e-6f;

constexpr size_t MiB = 1u << 20;
constexpr size_t WS_CTL = 0, CTL_ZERO_BYTES = 32768;
constexpr size_t WS_MOD = 1 * MiB;
constexpr size_t WS_BBAR = 2 * MiB;
constexpr size_t WS_LAMB = 3 * MiB;
constexpr size_t WS_USC = 4 * MiB;
constexpr size_t WS_S = 6 * MiB;
constexpr size_t WS_A2 = 38 * MiB;
constexpr size_t WS_BTY = 86 * MiB;
constexpr size_t WS_BTS = 134 * MiB;
constexpr size_t WS_W1A = 150 * MiB, WS_W1B = 322 * MiB, WS_W2A = 408 * MiB, WS_W2B = 580 * MiB;
constexpr size_t WS_WIN = 666 * MiB, WS_WGLU = 754 * MiB, WS_WA = 758 * MiB, WS_WPOOL = 766 * MiB, WS_WB = 768 * MiB, WS_WOUT = 784 * MiB;
constexpr size_t WS_U = 816 * MiB;
constexpr size_t WS_MIX = WS_U, WS_YB = WS_U + 64 * MiB;
constexpr size_t WS_H = 952 * MiB;
constexpr size_t WS_UP = WS_H, WS_GT = WS_H + 64 * MiB;
constexpr size_t WS_X = 1318 * MiB;
constexpr size_t WS_Z = 1590 * MiB, WS_GL = 1622 * MiB, WS_T = 1654 * MiB;
constexpr size_t WS_END = 1782 * MiB;
static_assert(WS_H + (size_t)MA * DFF * 2 <= WS_X && WS_GT + (size_t)ML * 2 * D * 2 <= WS_X && WS_U + (size_t)MA * D * 2 <= WS_H && WS_X + (size_t)MA * D * 4 <= WS_Z, "ws map");
constexpr int CW_TMO = 0, CW_QUEUE = 64, CW_DONE = 512  , CW_DYN = 1536  , CW_BAR = 4096;

constexpr int RING_OFF = 0;
constexpr int MISC_OFF = 144000;
constexpr int LDS_BYTES = 147456;

#define GAS __attribute__((address_space(1)))
#define LAS __attribute__((address_space(3)))
typedef unsigned short bf16;
typedef unsigned v4u __attribute__((ext_vector_type(4)));
typedef unsigned v2u __attribute__((ext_vector_type(2)));
typedef float f32x4 __attribute__((ext_vector_type(4)));
typedef GAS unsigned gu32;
#define RLX_AGENT __ATOMIC_RELAXED, __HIP_MEMORY_SCOPE_AGENT
#define LDS_WAIT() asm volatile("s_waitcnt lgkmcnt(0)" ::: "memory")
#define VM_WAIT() asm volatile("s_waitcnt vmcnt(0)" ::: "memory")
using pg8::cvt_pk_bf16; using pg8::sigmoidf_fast; using pg8::bf_lo; using pg8::bf_hi;

#define XB_TMO      128
#define XB_XCNT(j)  (256  + 64 * (j))
#define XB_XSUB(j)  (1280 + 64 * (j))
#define XB_XGEN(j)  (2304 + 64 * (j))
#define XB_TOP      3328
#define XB_TOPGEN   3392
#define XCD_BAR_WORDS 3456
#define XB_SPIN_CAP (1u << 18)
__device__ __forceinline__ unsigned xb_ld(unsigned* p)              { return __hip_atomic_load(p, __ATOMIC_RELAXED, __HIP_MEMORY_SCOPE_AGENT); }
__device__ __forceinline__ unsigned xb_add(unsigned* p, unsigned v) { return __hip_atomic_fetch_add(p, v, __ATOMIC_RELAXED, __HIP_MEMORY_SCOPE_AGENT); }
__device__ __forceinline__ unsigned xb_xcc_id() { return (unsigned)__builtin_amdgcn_s_getreg((3 << 11) | 20) & 0xFu; }
#define XB_SPIN(cond, bar) do { unsigned _sp = 0; while (cond) { __builtin_amdgcn_s_sleep(1); \
    if ((++_sp & 255u) == 0u) { if (xb_ld(&(bar)[XB_TMO])) break; if (_sp > XB_SPIN_CAP) { atomicAdd(&(bar)[XB_TMO], 1u); break; } } } } while (0)
struct XcdBarrier { unsigned* bar; unsigned x; volatile LAS unsigned* st; };
__device__ __forceinline__ XcdBarrier xcd_barrier_post(unsigned* bar, volatile LAS unsigned* st) {
    XcdBarrier b; b.bar = bar; b.x = xb_xcc_id(); b.st = st;
    if (threadIdx.x == 0) (void)xb_add(&bar[XB_XCNT(b.x)], 1u);
    return b;
}
__device__ __forceinline__ void xcd_barrier_complete(unsigned* bar, unsigned x, unsigned& nloc, unsigned& nx) {
    const unsigned G = gridDim.x * gridDim.y * gridDim.z;
    unsigned sum, cnt, mine, sp = 0u;
    for (;;) {
        sum = 0u; cnt = 0u; mine = 0u;
#pragma unroll
        for (unsigned j = 0; j < 16; ++j) { const unsigned c = xb_ld(&bar[XB_XCNT(j)]); sum += c; cnt += (c > 0u) ? 1u : 0u; mine = (j == x) ? c : mine; }
        if (sum == G) break;
        __builtin_amdgcn_s_sleep(1);
        if ((++sp & 255u) == 0u) { if (xb_ld(&bar[XB_TMO])) break; if (sp > XB_SPIN_CAP) { atomicAdd(&bar[XB_TMO], 1u); break; } }
    }
    nloc = mine > 0u ? mine : 1u; nx = cnt > 0u ? cnt : 1u;
}
__device__ __forceinline__ void xcd_barrier(const XcdBarrier& b) {
    asm volatile("s_waitcnt vmcnt(0)" ::: "memory");
    __syncthreads();
    if (threadIdx.x == 0) {
        unsigned* bar = b.bar;
        __builtin_amdgcn_s_waitcnt(0);
        unsigned nloc = b.st[0], nx = b.st[1];
        if (nloc == 0u) { xcd_barrier_complete(bar, b.x, nloc, nx); b.st[0] = nloc; b.st[1] = nx; }
        const unsigned old = xb_add(&bar[XB_XSUB(b.x)], 1u);
        const unsigned gen = old / nloc;
        if (old + 1u == (gen + 1u) * nloc) {
            __builtin_amdgcn_fence(__ATOMIC_RELEASE, "agent");
            asm volatile("s_waitcnt vmcnt(0)" ::: "memory");
            const unsigned og = xb_add(&bar[XB_TOP], 1u);
            const unsigned tg = og / nx;
            if (og + 1u == (tg + 1u) * nx) xb_add(&bar[XB_TOPGEN], 1u);
            else XB_SPIN(xb_ld(&bar[XB_TOPGEN]) == tg, bar);
            __builtin_amdgcn_fence(__ATOMIC_ACQUIRE, "agent");
            xb_add(&bar[XB_XGEN(b.x)], 1u);
            asm volatile("s_waitcnt vmcnt(0)" ::: "memory");
        } else {
            XB_SPIN(xb_ld(&bar[XB_XGEN(b.x)]) == gen, bar);
            __builtin_amdgcn_fence(__ATOMIC_ACQUIRE, "agent");
            asm volatile("s_waitcnt vmcnt(0)" ::: "memory");
        }
    }
    __syncthreads();
}

struct Frame {
    LAS unsigned char* lds;
    int tid, lane, wave, vcu, G;
    const float* in[27];
    float* out; unsigned char* ws;
};
enum { I_X = 0, I_C, I_CTX, I_CCTX, I_WMOD, I_BMOD, I_NORMG, I_FINALG, I_F1IN, I_F1OUT, I_F2IN, I_F2OUT, I_WIN, I_LRE, I_LIM, I_LSTEP, I_BRE, I_BIM, I_CRE, I_CIM, I_SD, I_WGLU, I_WBA, I_POOLW, I_POOLS, I_WBB, I_WOUT };

__device__ __forceinline__ float wave_sum(float v) {
#pragma unroll
    for (int o = 1; o < 64; o <<= 1) v += __shfl_xor(v, o);
    return v;
}

using pg8::Unit; using pg8::BM; using pg8::HALF;
template <int MODE> struct EpiGated {
    static constexpr bool PERM = true;
    bf16* O; int ldo;
    __device__ __forceinline__ void operator()(const f32x4 (&acc)[2][2][4][2], const Unit& u, int wr, int wc, int fr, int fq) const {
        const int row0 = u.pm * BM + wr * 64 + fr, col0 = u.pn * HALF + wc * 32 + 8 * fq;
#pragma unroll
        for (int ai = 0; ai < 2; ++ai)
#pragma unroll
            for (int m = 0; m < 4; ++m) {
                float o[8];
#pragma unroll
                for (int n = 0; n < 2; ++n)
#pragma unroll
                    for (int j = 0; j < 4; ++j) { const float a = acc[ai][0][m][n][j], b = acc[ai][1][m][n][j];
                        o[n * 4 + j] = MODE == 0 ? a * sigmoidf_fast(a) * b : a * sigmoidf_fast(b); }
                v4u w; w.x = cvt_pk_bf16(o[0], o[1]); w.y = cvt_pk_bf16(o[2], o[3]); w.z = cvt_pk_bf16(o[4], o[5]); w.w = cvt_pk_bf16(o[6], o[7]);
                *(v4u*)(O + (size_t)(row0 + ai * HALF + m * 16) * ldo + col0) = w;
            }
    }
};
struct EpiResid {
    static constexpr bool PERM = false;
    const float* in_lat; const float* in_ctx; float* X; const float* mod; int gidx; float coef; float* part;
    __device__ __forceinline__ void operator()(const f32x4 (&acc)[2][2][4][2], const Unit& u, int wr, int wc, int fr, int fq) const {
        const int row0 = u.pm * BM + wr * 64 + fr, col0 = u.pn * BM + wc * 32 + 4 * fq;
        if (u.g != 0) {
#pragma unroll
            for (int ai = 0; ai < 2; ++ai)
#pragma unroll
                for (int m = 0; m < 4; ++m) { float* rowp = part + ((size_t)(u.g - 1) * MC + (size_t)(row0 + ai * HALF + m * 16 - ML)) * D + col0;
#pragma unroll
                    for (int bj = 0; bj < 2; ++bj)
#pragma unroll
                        for (int n = 0; n < 2; ++n) *(f32x4*)(rowp + bj * HALF + n * 16) = acc[ai][bj][m][n]; }
            return;
        }
        const bool isctx = u.pm >= ML / BM; const int mi = isctx ? 4 : (u.pm >> 4);
        const float* gp = mod + (size_t)mi * (NMOD * D) + (size_t)gidx * D + col0;
        f32x4 gv[2][2];
#pragma unroll
        for (int bj = 0; bj < 2; ++bj)
#pragma unroll
            for (int n = 0; n < 2; ++n) gv[bj][n] = *(const f32x4*)(gp + bj * HALF + n * 16) * coef;
        const float* src = isctx ? in_ctx - (size_t)ML * D : in_lat;
#pragma unroll
        for (int ai = 0; ai < 2; ++ai) {
            f32x4 xi[4][2][2];
#pragma unroll
            for (int m = 0; m < 4; ++m) { const size_t off = (size_t)(row0 + ai * HALF + m * 16) * D + col0;
#pragma unroll
                for (int bj = 0; bj < 2; ++bj)
#pragma unroll
                    for (int n = 0; n < 2; ++n) xi[m][bj][n] = *(const f32x4*)(src + off + bj * HALF + n * 16); }
            asm volatile("" ::: "memory");
#pragma unroll
            for (int m = 0; m < 4; ++m) { const size_t off = (size_t)(row0 + ai * HALF + m * 16) * D + col0;
#pragma unroll
                for (int bj = 0; bj < 2; ++bj)
#pragma unroll
                    for (int n = 0; n < 2; ++n) *(f32x4*)(X + off + bj * HALF + n * 16) = xi[m][bj][n] + gv[bj][n] * acc[ai][bj][m][n]; }
            asm volatile("" ::: "memory");
        }
    }
};
struct EpiWin {
    static constexpr bool PERM = true;
    bf16* A2; float* USCP; bf16* UP; bf16* GT;
    __device__ __forceinline__ void operator()(const f32x4 (&acc)[2][2][4][2], const Unit& u, int wr, int wc, int fr, int fq) const {
        const int row0 = u.pm * BM + wr * 64 + fr;
        if (u.g != 0) {
#pragma unroll
            for (int ai = 0; ai < 2; ++ai)
#pragma unroll
                for (int m = 0; m < 4; ++m) { float* rowp = USCP + ((size_t)(u.g - 1) * MC + (size_t)(row0 + ai * HALF + m * 16 - ML)) * SW + u.pn * BM + wc * 32 + 8 * fq;
#pragma unroll
                    for (int bj = 0; bj < 2; ++bj) { *(f32x4*)(rowp + bj * HALF) = acc[ai][bj][m][0]; *(f32x4*)(rowp + bj * HALF + 4) = acc[ai][bj][m][1]; } }
            return;
        }
#pragma unroll
        for (int ai = 0; ai < 2; ++ai)
#pragma unroll
            for (int m = 0; m < 4; ++m) { const int row = row0 + ai * HALF + m * 16;
#pragma unroll
                for (int bj = 0; bj < 2; ++bj) {
                    const int cl = bj * HALF + wc * 32 + 8 * fq;
                    f32x4 v0 = acc[ai][bj][m][0], v1 = acc[ai][bj][m][1];
                    bf16* dst;
                    if (u.pn < 4) {
                        const int c = u.pn * BM + cl;
                        { const int b = row >> 12, t = row & 4095, g = c >> 4, k0 = c & 15;
                               dst = A2 + ((size_t)(g * A2R + b * NCH + (t >> 5)) * A2K + (t & 31) * SK + k0); }
                    } else if (u.pn < 12) {
                        const int ch = (u.pn - 4) * BM + cl, b = row >> 12, t = row & 4095;
                        dst = UP + ((size_t)((b * 256 + (ch >> 3)) * SEQ + t) * 8);
                    } else {
#pragma unroll
                        for (int j = 0; j < 4; ++j) { v0[j] = sigmoidf_fast(v0[j]); v1[j] = sigmoidf_fast(v1[j]); }
                        dst = GT + (size_t)row * (2 * D) + (u.pn - 12) * BM + cl;
                    }
                    v4u w; w.x = cvt_pk_bf16(v0[0], v0[1]); w.y = cvt_pk_bf16(v0[2], v0[3]); w.z = cvt_pk_bf16(v1[0], v1[1]); w.w = cvt_pk_bf16(v1[2], v1[3]);
                    *(v4u*)dst = w; } }
    }
};
struct EpiF32G {
    static constexpr bool PERM = false;
    float* C; int ldc; size_t gs;
    __device__ __forceinline__ void operator()(const f32x4 (&acc)[2][2][4][2], const Unit& u, int wr, int wc, int fr, int fq) const {
        const int row0 = u.pm * BM + wr * 64 + fr, col0 = u.pn * BM + wc * 32 + 4 * fq;
#pragma unroll
        for (int ai = 0; ai < 2; ++ai)
#pragma unroll
            for (int m = 0; m < 4; ++m) { float* rowp = C + (size_t)u.g * gs + (size_t)(row0 + ai * HALF + m * 16) * ldc + col0;
#pragma unroll
                for (int bj = 0; bj < 2; ++bj)
#pragma unroll
                    for (int n = 0; n < 2; ++n) *(f32x4*)(rowp + bj * HALF + n * 16) = acc[ai][bj][m][n]; }
    }
};
__device__ __forceinline__ float gelu_tanh(float x) { const float u2 = 1.5957691216f * (x + 0.044715f * x * x * x); return x * sigmoidf_fast(u2); }
struct EpiY {
    static constexpr bool PERM = true;
    bf16* Z;
    __device__ __forceinline__ void operator()(const f32x4 (&acc)[2][2][4][2], const Unit& u, int wr, int wc, int fr, int fq) const {
        const int row0 = u.pm * BM + wr * 64 + fr;
#pragma unroll
        for (int ai = 0; ai < 2; ++ai)
#pragma unroll
            for (int m = 0; m < 4; ++m) { const int R = row0 + ai * HALF + m * 16, b = R >> 7, cc = R & 127;
#pragma unroll
                for (int bj = 0; bj < 2; ++bj) { const int n_ = u.pn * BM + bj * HALF + wc * 32 + 8 * fq, tl = n_ >> 4, k0 = n_ & 15;
                    float o[8];
#pragma unroll
                    for (int n = 0; n < 2; ++n)
#pragma unroll
                        for (int j = 0; j < 4; ++j) o[n * 4 + j] = gelu_tanh(acc[ai][bj][m][n][j]);
                    v4u w; w.x = cvt_pk_bf16(o[0], o[1]); w.y = cvt_pk_bf16(o[2], o[3]); w.z = cvt_pk_bf16(o[4], o[5]); w.w = cvt_pk_bf16(o[6], o[7]);
                    *(v4u*)(Z + (size_t)(b * SEQ + cc * CT + tl) * SW + u.g * SK + k0) = w; } }
    }
};
struct EpiPool {
    static constexpr bool PERM = true;
    bf16* YB; const float* scale;
    __device__ __forceinline__ void operator()(const f32x4 (&acc)[2][2][4][2], const Unit& u, int wr, int wc, int fr, int fq) const {
        const int row0 = u.pm * BM + wr * 64 + fr, col0 = u.g * 512 + u.pn * BM + wc * 32 + 8 * fq;
        f32x4 sv[2][2];
#pragma unroll
        for (int bj = 0; bj < 2; ++bj)
#pragma unroll
            for (int n = 0; n < 2; ++n) sv[bj][n] = *(const f32x4*)(scale + col0 + bj * HALF + 4 * n);
#pragma unroll
        for (int ai = 0; ai < 2; ++ai)
#pragma unroll
            for (int m = 0; m < 4; ++m) { bf16* rowp = YB + (size_t)(row0 + ai * HALF + m * 16) * PW_ + col0;
#pragma unroll
                for (int bj = 0; bj < 2; ++bj) { const f32x4 v0 = acc[ai][bj][m][0] * sv[bj][0], v1 = acc[ai][bj][m][1] * sv[bj][1];
                    v4u w; w.x = cvt_pk_bf16(v0[0], v0[1]); w.y = cvt_pk_bf16(v0[2], v0[3]); w.z = cvt_pk_bf16(v1[0], v1[1]); w.w = cvt_pk_bf16(v1[2], v1[3]);
                    *(v4u*)(rowp + bj * HALF) = w; } }
    }
};
template <bool ADD> struct EpiBranch {
    static constexpr bool PERM = true;
    bf16* T; const bf16* GT; int goff;
    __device__ __forceinline__ void operator()(const f32x4 (&acc)[2][2][4][2], const Unit& u, int wr, int wc, int fr, int fq) const {
        const int row0 = u.pm * BM + wr * 64 + fr, col0 = u.pn * BM + wc * 32 + 8 * fq;
#pragma unroll
        for (int ai = 0; ai < 2; ++ai) {
            v4u gws[4][2], tws[4][2];
#pragma unroll
            for (int m = 0; m < 4; ++m) { const size_t row = (size_t)(row0 + ai * HALF + m * 16);
#pragma unroll
                for (int bj = 0; bj < 2; ++bj) { gws[m][bj] = *(const v4u*)(GT + row * (2 * D) + goff + col0 + bj * HALF);
                    if (ADD) tws[m][bj] = *(const v4u*)(T + row * D + col0 + bj * HALF); else tws[m][bj] = (v4u){0u, 0u, 0u, 0u}; } }
            asm volatile("" ::: "memory");
#pragma unroll
            for (int m = 0; m < 4; ++m) { const size_t row = (size_t)(row0 + ai * HALF + m * 16);
#pragma unroll
                for (int bj = 0; bj < 2; ++bj) {
                    const v4u gw = gws[m][bj]; const v4u tw = tws[m][bj];
                    bf16* tp = T + row * D + col0 + bj * HALF;
                    float o[8]; const f32x4 v0 = acc[ai][bj][m][0], v1 = acc[ai][bj][m][1];
                    o[0] = bf_lo(gw.x) * v0[0]; o[1] = bf_hi(gw.x) * v0[1]; o[2] = bf_lo(gw.y) * v0[2]; o[3] = bf_hi(gw.y) * v0[3];
                    o[4] = bf_lo(gw.z) * v1[0]; o[5] = bf_hi(gw.z) * v1[1]; o[6] = bf_lo(gw.w) * v1[2]; o[7] = bf_hi(gw.w) * v1[3];
                    if (ADD) { o[0] += bf_lo(tw.x); o[1] += bf_hi(tw.x); o[2] += bf_lo(tw.y); o[3] += bf_hi(tw.y); o[4] += bf_lo(tw.z); o[5] += bf_hi(tw.z); o[6] += bf_lo(tw.w); o[7] += bf_hi(tw.w); }
                    v4u w; w.x = cvt_pk_bf16(o[0], o[1]); w.y = cvt_pk_bf16(o[2], o[3]); w.z = cvt_pk_bf16(o[4], o[5]); w.w = cvt_pk_bf16(o[6], o[7]);
                    *(v4u*)tp = w; } }
            asm volatile("" ::: "memory");
        }
    }
};

__device__ __forceinline__ void p0_mod(Frame& F) {
    LAS float* sc = (LAS float*)(F.lds);
    LAS float* red = (LAS float*)(F.lds + 81920);
    const float* c = F.in[I_C]; const float* cctx = F.in[I_CCTX]; const float* wmod = F.in[I_WMOD]; const float* bmod = F.in[I_BMOD];
    float* mod = (float*)(F.ws + WS_MOD);
    for (int i = F.tid; i < 5 * D; i += NWAVES * 64) { const int v = i >> 12, k = i & (D - 1); const float x = v < 4 ? c[v * D + k] : cctx[k]; sc[i] = x * sigmoidf_fast(x); }
    __syncthreads();
    const int col4 = F.tid % 36, ksub = F.tid / 36;
    for (int chunk = blockIdx.x; chunk < 256; chunk += F.G) {
        float acc[5][4];
#pragma unroll
        for (int v = 0; v < 5; ++v)
#pragma unroll
            for (int e = 0; e < 4; ++e) acc[v][e] = 0.f;
        if (ksub < 14) {
            const float* wp = wmod + (size_t)chunk * 144 + col4 * 4 + (size_t)ksub * (NMOD * D);
            constexpr size_t KSTR = (size_t)14 * NMOD * D;
            int k = ksub;
            for (; k + 15 * 14 < D; k += 16 * 14) {
                f32x4 w[16];
#pragma unroll
                for (int i = 0; i < 16; ++i) { w[i] = __builtin_nontemporal_load((const f32x4*)wp); wp += KSTR; }
#pragma unroll
                for (int i = 0; i < 16; ++i)
#pragma unroll
                    for (int v = 0; v < 5; ++v) { const float sv = sc[v * D + k + 14 * i];
#pragma unroll
                        for (int e = 0; e < 4; ++e) acc[v][e] += sv * w[i][e]; }
            }
            for (; k < D; k += 14) { const f32x4 w = __builtin_nontemporal_load((const f32x4*)wp); wp += KSTR;
#pragma unroll
                for (int v = 0; v < 5; ++v) { const float sv = sc[v * D + k];
#pragma unroll
                    for (int e = 0; e < 4; ++e) acc[v][e] += sv * w[e]; } }
#pragma unroll
            for (int v = 0; v < 5; ++v)
#pragma unroll
                for (int e = 0; e < 4; ++e) red[(ksub * 36 + col4) * 20 + v * 4 + e] = acc[v][e];
        }
        __syncthreads();
        for (int o = F.tid; o < 720; o += NWAVES * 64) { const int v = o / 144, cl = o % 144; float s = bmod[chunk * 144 + cl];
#pragma unroll
            for (int q = 0; q < 14; ++q) s += red[(q * 36 + (cl >> 2)) * 20 + v * 4 + (cl & 3)];
            mod[(size_t)v * (NMOD * D) + chunk * 144 + cl] = s; }
        __syncthreads();
    }
}

__device__ __forceinline__ void p0_transpose_item(const float* W, int N, bf16* WT, int ldt, int dst_row0, LAS float* scr, int k0, int n0, int lane) {
    f32x4 v[16];
    const float* src = W + (size_t)(k0 + (lane >> 4)) * N + n0 + (lane & 15) * 4;
#pragma unroll
    for (int i = 0; i < 16; ++i) v[i] = __builtin_nontemporal_load((const f32x4*)(src + (size_t)(4 * i) * N));
#pragma unroll
    for (int i = 0; i < 16; ++i) { LAS float* d = scr + (4 * i + (lane >> 4)) * 65 + (lane & 15) * 4; d[0] = v[i].x; d[1] = v[i].y; d[2] = v[i].z; d[3] = v[i].w; }
    LDS_WAIT(); asm volatile("" ::: "memory");
    const int c = lane >> 3, nn = lane & 7;
#pragma unroll
    for (int j = 0; j < 8; ++j) { const int n = nn + 8 * j; const LAS float* s = scr + (8 * c) * 65 + n;
        v4u o; o.x = cvt_pk_bf16(s[0 * 65], s[1 * 65]); o.y = cvt_pk_bf16(s[2 * 65], s[3 * 65]); o.z = cvt_pk_bf16(s[4 * 65], s[5 * 65]); o.w = cvt_pk_bf16(s[6 * 65], s[7 * 65]);
        __builtin_nontemporal_store(o, (GAS v4u*)(WT + (size_t)(dst_row0 + n) * ldt + k0 + 8 * c)); }
    LDS_WAIT(); asm volatile("" ::: "memory");
}
constexpr int IT_FA = (D / 64) * (2 * DFF / 64), IT_FB = (DFF / 64) * (D / 64), IT_WIN = (D / 64) * (DIN / 64), IT_GLU = (SW / 64) * (2 * SW / 64), IT_WA = (SW / 64) * (D / 64),
              IT_POOL = 4 * (512 / 64) * (512 / 64), IT_WB = (PW_ / 64) * (D / 64), IT_WOUT = (D / 64) * (D / 64);
constexpr int Q_W1A = IT_FA, Q_W1B = Q_W1A + IT_FB, Q_WIN = Q_W1B + IT_WIN, Q_POOL = Q_WIN + IT_POOL, Q_WB = Q_POOL + IT_WB, Q_GLU = Q_WB + IT_GLU, Q_WA = Q_GLU + IT_WA,
              Q_WOUT = Q_WA + IT_WOUT, Q_W2A = Q_WOUT + IT_FA, Q_W2B = Q_W2A + IT_FB;
constexpr int IT_TOTAL = Q_W2B;
__device__ __forceinline__ int gated_row(int n0, int half) { const int j = n0 < half ? n0 : n0 - half; return (j >> 7) * 256 + (j & 127) + (n0 < half ? 0 : 128); }
__device__ __forceinline__ void p0_one_item(Frame& F, int r, LAS float* scr) {
    unsigned char* ws = F.ws; const int lane = F.lane;
#define TR_PLAIN(W, Kd, Nd, WT) do { const int nblk = (Nd) / 64, kb = r / nblk, nb = r % nblk; p0_transpose_item(W, Nd, (bf16*)(WT), Kd, 64 * nb, scr, 64 * kb, 64 * nb, lane); } while (0)
#define TR_GATED(W, Kd, Nd, WT) do { const int nblk = (Nd) / 64, kb = r / nblk, nb = r % nblk; p0_transpose_item(W, Nd, (bf16*)(WT), Kd, gated_row(64 * nb, (Nd) / 2), scr, 64 * kb, 64 * nb, lane); } while (0)
    if (r < IT_FA) { TR_GATED(F.in[I_F1IN], D, 2 * DFF, ws + WS_W1A); return; } r -= IT_FA;
    if (r < IT_FB) { TR_PLAIN(F.in[I_F1OUT], DFF, D, ws + WS_W1B); return; } r -= IT_FB;
    if (r < IT_WIN) { TR_PLAIN(F.in[I_WIN], D, DIN, ws + WS_WIN); return; } r -= IT_WIN;
    if (r < IT_POOL) { const int gi = r / 64; r %= 64; TR_PLAIN(F.in[I_POOLW] + (size_t)gi * 512 * 512, 512, 512, ws + WS_WPOOL + (size_t)gi * 512 * 512 * 2); return; } r -= IT_POOL;
    if (r < IT_WB) { TR_PLAIN(F.in[I_WBB], PW_, D, ws + WS_WB); return; } r -= IT_WB;
    if (r < IT_GLU) { TR_GATED(F.in[I_WGLU], SW, 2 * SW, ws + WS_WGLU); return; } r -= IT_GLU;
    if (r < IT_WA) { TR_PLAIN(F.in[I_WBA], SW, D, ws + WS_WA); return; } r -= IT_WA;
    if (r < IT_WOUT) { TR_PLAIN(F.in[I_WOUT], D, D, ws + WS_WOUT); return; } r -= IT_WOUT;
    if (r < IT_FA) { TR_GATED(F.in[I_F2IN], D, 2 * DFF, ws + WS_W2A); return; } r -= IT_FA;
    TR_PLAIN(F.in[I_F2OUT], DFF, D, ws + WS_W2B);
#undef TR_PLAIN
#undef TR_GATED
}
__device__ __forceinline__ bool fill_transposes(Frame& F, int mandatory, unsigned* done_ctr) {
    LAS float* scr = (LAS float*)(F.lds + F.wave * 16640);
    volatile LAS int* sh = (volatile LAS int*)(F.lds + MISC_OFF + 64);
    unsigned* q = (unsigned*)(F.ws + WS_CTL) + CW_QUEUE;
    constexpr int PER_WAVE = 2, CHB = PER_WAVE * NWAVES;
    for (;;) {
        if (F.tid == 0) { int base = -1; const int head = (int)__hip_atomic_load(q, __ATOMIC_RELAXED, __HIP_MEMORY_SCOPE_AGENT);
            const bool go = head < mandatory || (head < IT_TOTAL && done_ctr != nullptr && __hip_atomic_load(done_ctr, __ATOMIC_RELAXED, __HIP_MEMORY_SCOPE_AGENT) < (unsigned)F.G);
            if (go) { base = (int)__hip_atomic_fetch_add(q, (unsigned)CHB, __ATOMIC_RELAXED, __HIP_MEMORY_SCOPE_AGENT); if (base >= IT_TOTAL) base = -2; }
            else if (head >= IT_TOTAL) base = -2;
            sh[0] = base; }
        __syncthreads();
        const int base = sh[0];
        __syncthreads();
        if (base < 0) return base == -2;
        const int b0 = base + F.wave * PER_WAVE, end = b0 + PER_WAVE < IT_TOTAL ? b0 + PER_WAVE : IT_TOTAL;
        for (int it = b0; it < end; ++it) p0_one_item(F, it, scr);
    }
}
__device__ __forceinline__ void phase_done(Frame& F, unsigned* done_ctr) {
    __syncthreads();
    if (F.tid == 0) __hip_atomic_fetch_add(done_ctr, 1u, __ATOMIC_RELAXED, __HIP_MEMORY_SCOPE_AGENT);
}

typedef float f32x2 __attribute__((ext_vector_type(2)));
constexpr int KFS = 272;
__device__ __forceinline__ void p0_ssm_part(Frame& F, int g, int part) {
    LAS f32x2* PWR = (LAS f32x2*)(F.lds);
    LAS f32x2* BB = (LAS f32x2*)(F.lds + 33792);
    LAS f32x2* CC = (LAS f32x2*)(F.lds + 33792 + 16384);
    LAS float* KF = (LAS float*)(F.lds + 33792 + 32768);
    const int tid = F.tid;
    if (tid < 128) {
        const int dir = tid >> 6, p = tid & 63, idx = (dir * SG + g) * SP + p;
        const double lr = fmin((double)F.in[I_LRE][idx], -1e-4), li = (double)F.in[I_LIM][idx], st = exp((double)F.in[I_LSTEP][dir * SG + g]);
        const double mag = exp(lr * st), ang = li * st, lbr = mag * cos(ang), lbi = mag * sin(ang);
        const double nr = lbr - 1.0, ni = lbi, den = lr * lr + li * li, fr_ = (nr * lr + ni * li) / den, fi_ = (ni * lr - nr * li) / den;
        double pr = 1.0, pi = 0.0;
        for (int tau = 0; tau <= CT; ++tau) { PWR[(dir * SP + p) * 33 + tau] = (f32x2){(float)pr, (float)pi}; const double t = pr * lbr - pi * lbi; pi = pr * lbi + pi * lbr; pr = t; }
        f32x2* bbar = (f32x2*)(F.ws + WS_BBAR);
        for (int k = 0; k < SK; ++k) { const double br = (double)F.in[I_BRE][idx * SK + k], bi = (double)F.in[I_BIM][idx * SK + k];
            const f32x2 bb = (f32x2){(float)(fr_ * br - fi_ * bi), (float)(fr_ * bi + fi_ * br)}; BB[(dir * SP + p) * SK + k] = bb; if (part == 0) bbar[(size_t)idx * SK + k] = bb; }
        if (part == 0) { f32x2* lamb = (f32x2*)(F.ws + WS_LAMB); f32x2* lamT = (f32x2*)(F.ws + WS_LAMB + 65536);
            lamb[idx] = (f32x2){(float)lbr, (float)lbi}; lamT[idx] = PWR[(dir * SP + p) * 33 + CT]; }
    }
    for (int o = tid; o < 2048; o += NWAVES * 64) { const int dir = o >> 10, k = (o >> 6) & 15, p = o & 63, cidx = ((dir * SG + g) * SK + k) * SP + p; CC[(dir * SP + p) * SK + k] = (f32x2){F.in[I_CRE][cidx], F.in[I_CIM][cidx]}; }
    __syncthreads();
    for (int combo = tid; combo < 1024; combo += NWAVES * 64) { const int dir = combo >> 9, tau = (combo >> 4) & 31, k = combo & 15;
        float a[16];
#pragma unroll
        for (int e = 0; e < 16; ++e) a[e] = 0.f;
        for (int p = 0; p < SP; ++p) { const f32x2 c = CC[(dir * SP + p) * SK + k], w = PWR[(dir * SP + p) * 33 + tau]; const float gr = c.x * w.x - c.y * w.y, gi = c.x * w.y + c.y * w.x;
#pragma unroll
            for (int e = 0; e < 16; ++e) { const f32x2 b = BB[(dir * SP + p) * SK + e]; a[e] += gr * b.x - gi * b.y; } }
#pragma unroll
        for (int e = 0; e < 16; ++e) KF[(dir * CT + tau) * KFS + k * SK + e] = a[e]; }
    __syncthreads();
    bf16* bty = (bf16*)(F.ws + WS_BTY) + (size_t)g * (CT * SK) * A2K;
    const float* dvec = F.in[I_SD] + g * SK;
    for (int ch = tid; ch < 128 * (A2K / 8); ch += NWAVES * 64) { const int n = part * 128 + ch / (A2K / 8), q = ch % (A2K / 8), t = n >> 4, k = n & 15;
        float v[8];
        if (q < 64) { const int s = q >> 1, k0 = (q & 1) * 8;
            f32x4 x0 = (f32x4){0.f, 0.f, 0.f, 0.f}, x1 = x0;
            if (t >= s) { const LAS f32x4* kp = (const LAS f32x4*)(KF + (t - s) * KFS + k * SK + k0); x0 += kp[0]; x1 += kp[1]; }
            if (s >= t) { const LAS f32x4* kp = (const LAS f32x4*)(KF + (CT + (s - t)) * KFS + k * SK + k0); x0 += kp[0]; x1 += kp[1]; }
            v[0] = x0.x; v[1] = x0.y; v[2] = x0.z; v[3] = x0.w; v[4] = x1.x; v[5] = x1.y; v[6] = x1.z; v[7] = x1.w;
            if (t == s && (k >> 3) == (q & 1)) { const float dk = dvec[k];
#pragma unroll
                for (int e = 0; e < 8; ++e) v[e] += ((k & 7) == e) ? dk : 0.f; }
        } else { const int pt = (q - 64) >> 3, p0 = ((q - 64) & 7) * 8, dir = pt >> 1, tau = dir == 0 ? t + 1 : CT - t;
#pragma unroll
            for (int e = 0; e < 8; ++e) { const int p = p0 + e; const f32x2 c = CC[(dir * SP + p) * SK + k], w = PWR[(dir * SP + p) * 33 + tau];
                const float re = c.x * w.x - c.y * w.y, im = c.x * w.y + c.y * w.x; v[e] = (pt & 1) ? -im : re; }
        }
        v4u o; o.x = cvt_pk_bf16(v[0], v[1]); o.y = cvt_pk_bf16(v[2], v[3]); o.z = cvt_pk_bf16(v[4], v[5]); o.w = cvt_pk_bf16(v[6], v[7]);
        *(v4u*)(bty + (size_t)n * A2K + q * 8) = o; }
    bf16* bts = (bf16*)(F.ws + WS_BTS) + (size_t)g * 256 * (CT * SK);
    for (int ch = tid; ch < 64 * 64; ch += NWAVES * 64) { const int p = ch >> 6, q = ch & 63, pt = part, n = pt * 64 + p, dir = pt >> 1, s = q >> 1, k0 = (q & 1) * 8, tau = dir == 0 ? CT - 1 - s : s;
        const f32x2 w = PWR[(dir * SP + p) * 33 + tau]; float v[8];
#pragma unroll
        for (int e = 0; e < 8; ++e) { const f32x2 b = BB[(dir * SP + p) * SK + k0 + e]; const float re = w.x * b.x - w.y * b.y, im = w.x * b.y + w.y * b.x; v[e] = (pt & 1) ? im : re; }
        v4u o; o.x = cvt_pk_bf16(v[0], v[1]); o.y = cvt_pk_bf16(v[2], v[3]); o.z = cvt_pk_bf16(v[4], v[5]); o.w = cvt_pk_bf16(v[6], v[7]);
        *(v4u*)(bts + (size_t)n * (CT * SK) + q * 8) = o; }
    __syncthreads();
}

template <bool FINAL, bool CTXSUM = false>
__device__ __forceinline__ void norm_rows(Frame& F, const float* in_lat, const float* in_ctx, int nrows, const float* gvec, int shift_idx, int scale_idx, bf16* outb, float* outf, const float* part = nullptr) {
    const int gw = F.vcu * NWAVES + F.wave, NGW = F.G * NWAVES;
    const float* mod = (const float*)(F.ws + WS_MOD);
    for (int m = gw; m < nrows; m += NGW) {
        const bool isctx = m >= ML; const int mi = isctx ? 4 : (m >> 12);
        const f32x4* xr = (const f32x4*)(isctx ? in_ctx + (size_t)(m - ML) * D : in_lat + (size_t)m * D) + F.lane;
        f32x4 v[16]; float ss = 0.f;
        if (CTXSUM && isctx) {
            const f32x4* p0 = (const f32x4*)(part + (size_t)(m - ML) * D) + F.lane;
#pragma unroll
            for (int j = 0; j < 16; ++j) v[j] = p0[64 * j];
#pragma unroll
            for (int sp = 1; sp < 4; ++sp) { const f32x4* ps = p0 + (size_t)sp * MC * (D / 4);
#pragma unroll
                for (int j = 0; j < 16; ++j) v[j] += ps[64 * j]; }
            const f32x4* gt = (const f32x4*)(mod + (size_t)4 * (NMOD * D) + (size_t)2 * D) + F.lane;
#pragma unroll
            for (int j = 0; j < 16; ++j) v[j] = xr[64 * j] + (gt[64 * j] * 0.5f) * v[j];
#pragma unroll
            for (int j = 0; j < 16; ++j) ss += (v[j].x * v[j].x + v[j].y * v[j].y) + (v[j].z * v[j].z + v[j].w * v[j].w);
        } else {
#pragma unroll
        for (int j = 0; j < 16; ++j) { v[j] = xr[64 * j]; ss += (v[j].x * v[j].x + v[j].y * v[j].y) + (v[j].z * v[j].z + v[j].w * v[j].w); }
        }
        const float rstd = 1.0f / sqrtf(wave_sum(ss) * (1.0f / D) + RMS_EPS);
        const f32x4* gp = (const f32x4*)gvec + F.lane;
        if constexpr (FINAL) {
            f32x4* op = (f32x4*)(outf + (size_t)m * D) + F.lane;
#pragma unroll
            for (int j = 0; j < 16; ++j) op[64 * j] = v[j] * rstd * gp[64 * j];
        } else {
            const f32x4* shp = (const f32x4*)(mod + (size_t)mi * (NMOD * D) + (size_t)shift_idx * D) + F.lane;
            const f32x4* scp = (const f32x4*)(mod + (size_t)mi * (NMOD * D) + (size_t)scale_idx * D) + F.lane;
            v2u* op = (v2u*)(outb + (size_t)m * D) + F.lane;
#pragma unroll
            for (int j = 0; j < 16; ++j) { const f32x4 o = (v[j] * rstd * gp[64 * j]) * (scp[64 * j] + 1.0f) + shp[64 * j];
                v2u w; w.x = cvt_pk_bf16(o.x, o.y); w.y = cvt_pk_bf16(o.z, o.w); op[64 * j] = w; }
        }
    }
}

template <bool FINAL>
__device__ __forceinline__ void norm_prep(Frame& F, LAS float* LA, LAS float* LB, const float* gvec, const float* mod, int mi, int shift_idx, int scale_idx) {
    for (int c = F.tid; c < D; c += NWAVES * 64) { const float g = gvec[c];
        if (FINAL) { LA[c] = g; LB[c] = 0.f; }
        else { LA[c] = g * (1.0f + mod[(size_t)mi * (NMOD * D) + (size_t)scale_idx * D + c]); LB[c] = mod[(size_t)mi * (NMOD * D) + (size_t)shift_idx * D + c]; } }
}
#define NIDX(j) (((j) >> 1) * 128 + ((j) & 1))
template <bool FINAL>
__device__ __forceinline__ void norm_row_out(Frame& F, const f32x4 (&v)[16], const LAS float* LA, const LAS float* LB, bf16* outb, float* outf, size_t m) {
    float ss = 0.f;
#pragma unroll
    for (int j = 0; j < 16; ++j) ss += (v[j].x * v[j].x + v[j].y * v[j].y) + (v[j].z * v[j].z + v[j].w * v[j].w);
    const float rstd = 1.0f / sqrtf(wave_sum(ss) * (1.0f / D) + RMS_EPS);
    const LAS f32x4* la = (const LAS f32x4*)LA + 2 * F.lane; const LAS f32x4* lb = (const LAS f32x4*)LB + 2 * F.lane;
    if constexpr (FINAL) { f32x4* op = (f32x4*)(outf + m * D) + 2 * F.lane;
#pragma unroll
        for (int j = 0; j < 16; ++j) op[NIDX(j)] = (v[j] * rstd) * la[NIDX(j)];
    } else { v4u* op = (v4u*)(outb + m * D) + F.lane;
#pragma unroll
        for (int jj = 0; jj < 8; ++jj) { const f32x4 o0 = (v[2 * jj] * rstd) * la[128 * jj] + lb[128 * jj], o1 = (v[2 * jj + 1] * rstd) * la[128 * jj + 1] + lb[128 * jj + 1];
            v4u w; w.x = cvt_pk_bf16(o0.x, o0.y); w.y = cvt_pk_bf16(o0.z, o0.w); w.z = cvt_pk_bf16(o1.x, o1.y); w.w = cvt_pk_bf16(o1.z, o1.w); op[64 * jj] = w; } }
}
template <bool FINAL, bool CTXSUM>
__device__ __forceinline__ void norm_phase(Frame& F, const float* in_lat, const float* in_ctx, bool do_ctx, const float* gvec, int shift_idx, int scale_idx, bf16* outb, float* outf, const float* part) {
    LAS float* LA = (LAS float*)F.lds; LAS float* LB = LA + D;
    const float* mod = (const float*)(F.ws + WS_MOD);
    const int nb = F.G / 4, b = (int)blockIdx.x / nb, bi = (int)blockIdx.x % nb;
    norm_prep<FINAL>(F, LA, LB, gvec, mod, b, shift_idx, scale_idx);
    __syncthreads();
    {
        f32x4 va[16], vb[16];
        int k = F.wave;
#define NP_ROW(kk) ((size_t)b * SEQ + bi + (size_t)nb * (kk))
#define NP_VALID(kk) (bi + nb * (kk) < SEQ)
#define NP_LOAD(dst, kk) do { const f32x4* xr_ = (const f32x4*)(in_lat + NP_ROW(kk) * D) + 2 * F.lane; _Pragma("unroll") for (int j = 0; j < 16; ++j) dst[j] = xr_[NIDX(j)]; } while (0)
        if (NP_VALID(k)) {
            NP_LOAD(va, k);
            for (;;) {
                const int k2 = k + NWAVES; const bool has2 = NP_VALID(k2);
                if (has2) NP_LOAD(vb, k2);
                norm_row_out<FINAL>(F, va, LA, LB, outb, outf, NP_ROW(k));
                if (!has2) break;
                const int k3 = k2 + NWAVES; const bool has3 = NP_VALID(k3);
                if (has3) NP_LOAD(va, k3);
                norm_row_out<FINAL>(F, vb, LA, LB, outb, outf, NP_ROW(k2));
                if (!has3) break;
                k = k3;
            }
        }
#undef NP_ROW
#undef NP_VALID
#undef NP_LOAD
    }
    if (do_ctx) {
        __syncthreads();
        norm_prep<FINAL>(F, LA, LB, gvec, mod, 4, shift_idx, scale_idx);
        __syncthreads();
        for (int r = (int)blockIdx.x + F.G * F.wave; r < MC; r += F.G * NWAVES) {
            const f32x4* xr = (const f32x4*)(in_ctx + (size_t)r * D) + 2 * F.lane; f32x4 v[16];
            if constexpr (CTXSUM) {
                const f32x4* ps = (const f32x4*)(part + (size_t)r * D) + 2 * F.lane;
#pragma unroll
                for (int j = 0; j < 16; ++j) v[j] = (f32x4){0.f, 0.f, 0.f, 0.f};
#pragma unroll 1
                for (int sp = 0; sp < 4; ++sp) {
#pragma unroll
                    for (int j = 0; j < 16; ++j) v[j] += ps[NIDX(j)];
                    ps += (size_t)MC * (D / 4); }
                const f32x4* gt = (const f32x4*)(mod + (size_t)4 * (NMOD * D) + (size_t)2 * D) + 2 * F.lane;
#pragma unroll
                for (int j = 0; j < 16; ++j) v[j] = xr[NIDX(j)] + (gt[NIDX(j)] * 0.5f) * v[j];
            } else {
#pragma unroll
                for (int j = 0; j < 16; ++j) v[j] = xr[NIDX(j)];
            }
            norm_row_out<FINAL>(F, v, LA, LB, outb, outf, (size_t)ML + r);
        }
    }
    __syncthreads();
}

__device__ __forceinline__ void ctx_scan(Frame& F) {
    const f32x2* bbar = (const f32x2*)(F.ws + WS_BBAR); const f32x2* lamb = (const f32x2*)(F.ws + WS_LAMB); f32x2* hctx = (f32x2*)(F.ws + WS_LAMB + 131072);
    const float* uscp = (const float*)(F.ws + WS_Z);
    LAS float* LU = (LAS float*)F.lds;
    for (int bg = blockIdx.x; bg < BATCH * SG; bg += F.G) {
        const int b = bg >> 6, g = bg & 63;
        for (int i = F.tid; i < CTXL * 4; i += NWAVES * 64) { const int t = i >> 2, q = i & 3; const float* src = uscp + (size_t)(b * CTXL + t) * SW + g * SK + q * 4;
            f32x4 v = *(const f32x4*)src;
#pragma unroll
            for (int sp = 1; sp < 4; ++sp) v += *(const f32x4*)(src + (size_t)sp * MC * SW);
            *(LAS f32x4*)(LU + t * 16 + q * 4) = v; }
        __syncthreads();
        if (F.wave < 2) {
            const int dir = F.wave, p = F.lane, idx = (dir * SG + g) * SP + p;
            f32x2 bb[16];
#pragma unroll
            for (int k = 0; k < 16; ++k) bb[k] = bbar[(size_t)idx * SK + k];
            const f32x2 lam = lamb[idx]; float hr = 0.f, hi = 0.f;
#pragma unroll 4
            for (int s_ = 0; s_ < CTXL; ++s_) { const int t = dir == 0 ? s_ : CTXL - 1 - s_;
                const LAS f32x4* up = (const LAS f32x4*)(LU + t * 16); float br = 0.f, bi = 0.f;
#pragma unroll
                for (int q = 0; q < 4; ++q) { const f32x4 u4 = up[q];
#pragma unroll
                    for (int e = 0; e < 4; ++e) { br += bb[q * 4 + e].x * u4[e]; bi += bb[q * 4 + e].y * u4[e]; } }
                const float nr = lam.x * hr - lam.y * hi + br, ni = lam.x * hi + lam.y * hr + bi; hr = nr; hi = ni; }
            hctx[((dir * BATCH + b) * SG + g) * SP + p] = (f32x2){hr, hi};
        }
        __syncthreads();
    }
}
__device__ __forceinline__ void chunk_recurrence(Frame& F) {
    const f32x2* lamT = (const f32x2*)(F.ws + WS_LAMB + 65536); const f32x2* hctx = (const f32x2*)(F.ws + WS_LAMB + 131072);
    const float* S = (const float*)(F.ws + WS_S); bf16* A2 = (bf16*)(F.ws + WS_A2);
    LAS float* LS = (LAS float*)F.lds;
    for (int gb = blockIdx.x; gb < SG * BATCH; gb += F.G) {
        const int g = gb >> 2, b = gb & 3; const size_t row0 = (size_t)g * A2R + b * NCH;
        const f32x4* src = (const f32x4*)(S + row0 * 256);
#pragma unroll
        for (int i = 0; i < 16; ++i) { const int o = i * (NWAVES * 64) + F.tid; ((LAS f32x4*)LS)[o] = src[o]; }
        __syncthreads();
        if (F.wave < 2) {
            const int dir = F.wave, p = F.lane;
            const f32x2 lt = lamT[(dir * SG + g) * SP + p]; const f32x2 h0 = hctx[((dir * BATCH + b) * SG + g) * SP + p]; float hr = h0.x, hi = h0.y;
#pragma unroll 4
            for (int s_ = 0; s_ < NCH; ++s_) { const int c = dir == 0 ? s_ : NCH - 1 - s_;
                const float sr = LS[c * 256 + dir * 128 + p], si = LS[c * 256 + dir * 128 + 64 + p];
                bf16* ap = A2 + (row0 + c) * A2K + CT * SK + dir * 128 + p;
                ap[0] = (bf16)(cvt_pk_bf16(hr, 0.f) & 0xffffu); ap[64] = (bf16)(cvt_pk_bf16(hi, 0.f) & 0xffffu);
                const float nr = lt.x * hr - lt.y * hi + sr, ni = lt.x * hi + lt.y * hr + si; hr = nr; hi = ni; }
        }
        __syncthreads();
    }
}
__device__ __forceinline__ void pool_units(Frame& F) {
    LAS float* L = (LAS float*)(F.lds); constexpr int RS = 520;
    const bf16* UP = (const bf16*)(F.ws + WS_UP); bf16* MIX = (bf16*)(F.ws + WS_MIX);
    const int tid = F.tid;
    const bool bal = F.G == 256; const int bx = (int)blockIdx.x, nmine = bal ? (bx < 128 ? 3 : 5) : (BATCH * 256 - bx + F.G - 1) / F.G;
    const int vr = (bx & 7) * 16 + ((bx >> 3) - 16);
    for (int ui = 0; ui < nmine; ++ui) {
        const int unit = !bal ? bx + ui * F.G : (ui < 3 ? F.vcu + ui * 256 : (ui == 3 ? 768 + vr : 896 + vr));
        const int b = unit >> 8, slice = unit & 255, w = 2 << (slice >> 6), hw = w >> 1;
        const v4u* src = (const v4u*)(UP + (size_t)(b * 256 + slice) * SEQ * 8);
        v4u keep[8];
#pragma unroll
        for (int i = 0; i < 8; ++i) { const int tok = i * 512 + tid; keep[i] = src[tok]; }
#pragma unroll
        for (int i = 0; i < 8; ++i) { const int tok = i * 512 + tid, r = tok >> 6, c = tok & 63; LAS f32x4* d = (LAS f32x4*)(L + r * RS + c * 8);
            d[0] = (f32x4){bf_lo(keep[i].x), bf_hi(keep[i].x), bf_lo(keep[i].y), bf_hi(keep[i].y)}; d[1] = (f32x4){bf_lo(keep[i].z), bf_hi(keep[i].z), bf_lo(keep[i].w), bf_hi(keep[i].w)}; }
        __syncthreads();
        { const int r = tid >> 3, ch = tid & 7; LAS float* p = L + r * RS + ch; float run = 0.f;
#pragma unroll 8
          for (int c = 0; c < 64; ++c) { run += p[c * 8]; p[c * 8] = run; } }
        __syncthreads();
        { const int c = tid >> 3, ch = tid & 7; LAS float* p = L + c * 8 + ch; float run = 0.f;
#pragma unroll 8
          for (int r = 0; r < 64; ++r) { run += p[r * RS]; p[r * RS] = run; } }
        __syncthreads();
#pragma unroll
        for (int i = 0; i < 8; ++i) { const int tok = i * 512 + tid, r = tok >> 6, c = tok & 63;
            const int rlo = r - hw < 0 ? 0 : r - hw, rhi = r + hw > 64 ? 64 : r + hw, clo = c - hw < 0 ? 0 : c - hw, chi = c + hw > 64 ? 64 : c + hw;
            const float inv = 1.0f / (float)((rhi - rlo) * (chi - clo));
            f32x4 s0, s1;
            { const LAS f32x4* q = (const LAS f32x4*)(L + (rhi - 1) * RS + (chi - 1) * 8); s0 = q[0]; s1 = q[1]; }
            if (rlo > 0) { const LAS f32x4* q = (const LAS f32x4*)(L + (rlo - 1) * RS + (chi - 1) * 8); s0 -= q[0]; s1 -= q[1]; }
            if (clo > 0) { const LAS f32x4* q = (const LAS f32x4*)(L + (rhi - 1) * RS + (clo - 1) * 8); s0 -= q[0]; s1 -= q[1]; }
            if (rlo > 0 && clo > 0) { const LAS f32x4* q = (const LAS f32x4*)(L + (rlo - 1) * RS + (clo - 1) * 8); s0 += q[0]; s1 += q[1]; }
            const f32x4 v0 = (f32x4){bf_lo(keep[i].x), bf_hi(keep[i].x), bf_lo(keep[i].y), bf_hi(keep[i].y)}, v1 = (f32x4){bf_lo(keep[i].z), bf_hi(keep[i].z), bf_lo(keep[i].w), bf_hi(keep[i].w)};
            const f32x4 o0 = s0 * inv - v0, o1 = s1 * inv - v1;
            v4u wv; wv.x = cvt_pk_bf16(o0.x, o0.y); wv.y = cvt_pk_bf16(o0.z, o0.w); wv.z = cvt_pk_bf16(o1.x, o1.y); wv.w = cvt_pk_bf16(o1.z, o1.w);
            *(v4u*)(MIX + (size_t)(b * SEQ + tok) * PW_ + slice * 8) = wv; }
        __syncthreads();
    }
}

constexpr int NPHASES = 16;
#ifndef WGM_FFN
#define WGM_FFN 8
#endif
#ifndef DUP_MASK
#define DUP_MASK 0
#endif
#ifndef DUP_SUB
#define DUP_SUB 0
#endif
#define REPS(k) _Pragma("unroll") for (int rep_ = 0; rep_ < ((((DUP_MASK) >> (k)) & 1) ? 2 : 1); ++rep_)
#ifndef MK_N_LAUNCHES
#define MK_N_LAUNCHES 1
#endif
struct Args { const float* in[27]; float* out; unsigned char* ws; int ph_lo, ph_hi; };
static_assert(sizeof(Args) == 27 * 8 + 8 + 8 + 8, "Args has no padding");

__global__ void __launch_bounds__(NWAVES * 64, 2) fwd_kernel(Args args) {
    extern __shared__ __attribute__((aligned(16))) unsigned char lds[];
    Frame F;
    F.lds = (LAS unsigned char*)lds;
    F.tid = threadIdx.x; F.lane = F.tid & 63; F.wave = __builtin_amdgcn_readfirstlane(F.tid >> 6);
    F.G = gridDim.x; { const int bx = blockIdx.x; F.vcu = (F.G % 8 == 0) ? (bx % 8) * (F.G / 8) + bx / 8 : bx; }
#pragma unroll
    for (int i = 0; i < 27; ++i) F.in[i] = args.in[i];
    F.out = args.out; F.ws = args.ws;
    volatile LAS unsigned* MISC = (volatile LAS unsigned*)(F.lds + MISC_OFF);
    if (F.tid < 32) MISC[F.tid] = 0u;
    __syncthreads();
    unsigned* ctl = (unsigned*)(F.ws + WS_CTL);
    XcdBarrier bar; bar.bar = ctl + CW_BAR; bar.x = 0; bar.st = nullptr;
    if (MK_N_LAUNCHES == 1) bar = xcd_barrier_post(ctl + CW_BAR, MISC + 8);
#define GRID_BAR() do { if (MK_N_LAUNCHES == 1) xcd_barrier(bar); } while (0)
    const int lo = args.ph_lo, hi = args.ph_hi;
#define IN(k) (lo <= (k) && (k) < hi)
#if defined(EXP_T_LO)
    unsigned long long tA_ = 0ull, tB_ = 0ull;
#define TSTAMP(k) do { if ((k) == EXP_T_LO) tA_ = __builtin_amdgcn_s_memrealtime(); if ((k) == EXP_T_HI) tB_ = __builtin_amdgcn_s_memrealtime(); } while (0)
#else
#define TSTAMP(k) do { } while (0)
#endif
    bool qdone = false;
#define FILL_TAIL(p, mand) do { if (!qdone) { phase_done(F, ctl + CW_DONE + 64 * (p)); qdone = fill_transposes(F, (mand), ctl + CW_DONE + 64 * (p)); } } while (0)
#define FILL_MAND(mand) do { if (!qdone) qdone = fill_transposes(F, (mand), nullptr); } while (0)
#define BOTH(k) (IN(k) && IN((k) + 1))
    unsigned char* ws = F.ws;
    LAS unsigned char* ring = F.lds + RING_OFF;
    volatile LAS int* DSLOT = (volatile LAS int*)(F.lds + MISC_OFF + 96);
    const float* mod = (const float*)(ws + WS_MOD);

    TSTAMP(0);
    if (IN(0)) REPS(0) {
        for (int st = 0; st < 3; ++st) { const int which = ((blockIdx.x & 1) && st < 2) ? 1 - st : st;
            if (which == 0) { for (int w = blockIdx.x; w < SG * 4; w += F.G) p0_ssm_part(F, w >> 2, w & 3); }
            else if (which == 1) p0_mod(F);
            else (void)fill_transposes(F, Q_W1B, nullptr); }
        if (BOTH(0)) GRID_BAR();
    }
    TSTAMP(1);
    if (IN(1)) REPS(1) {
        if (F.G % 4 == 0) norm_phase<false, false>(F, F.in[I_X], F.in[I_CTX], true, F.in[I_NORMG], 0, 1, (bf16*)(ws + WS_U), nullptr, nullptr);
        else norm_rows<false>(F, F.in[I_X], F.in[I_CTX], MA, F.in[I_NORMG], 0, 1, (bf16*)(ws + WS_U), nullptr);
        if (BOTH(1)) GRID_BAR();
#if defined(EXP_BARS)
        for (int eb = 0; eb < EXP_BARS; ++eb) GRID_BAR();
#endif
        }
    TSTAMP(2);
    if (IN(2)) REPS(2) {
        pg8::Gemm g{(const char*)(ws + WS_U), (const char*)(ws + WS_W1A), D, D, D, 0, 0};
        pg8::DynOrder<pg8::StaticOrder> S; S.B.init(MA, 2 * DFF, F.G, (int)blockIdx.x, WGM_FFN); S.ctr = ctl + CW_DYN + 128 * 2; S.slot = DSLOT; S.G = F.G; S.c = (int)blockIdx.x;
        EpiGated<0> E{(bf16*)(ws + WS_H), DFF};
#if defined(EXP_VAR)
        pg8::gemm_phase<EpiGated<0>, pg8::DynOrder<pg8::StaticOrder>, PG8_ALIGN, PG8_SP2, EXP_VAR>(ring, g, S, E); GRID_BAR();
#endif
        pg8::gemm_phase<EpiGated<0>, pg8::DynOrder<pg8::StaticOrder>, PG8_ALIGN, PG8_SP2, PG8_VAR>(ring, g, S, E);
        FILL_TAIL(2, Q_W1B); if (BOTH(2)) GRID_BAR();
    }
    TSTAMP(3);
    if (IN(3)) REPS(3) {
        pg8::Gemm g{(const char*)(ws + WS_H), (const char*)(ws + WS_W1B), DFF, DFF, DFF, 0, 0};
        pg8::DynOrder<pg8::SplitKOrder> S; S.ctr = ctl + CW_DYN + 128 * 3; S.slot = DSLOT; S.G = F.G; S.c = (int)blockIdx.x;
        S.B.S.init(ML, D, F.G, (int)blockIdx.x, 2); S.B.pm0 = ML / BM; S.B.npn = D / BM; S.B.ntiles = (MC / BM) * (D / BM); S.B.kt_a = 44; S.B.kt_b = 42;
        EpiResid E{F.in[I_X], F.in[I_CTX], (float*)(ws + WS_X), mod, 2, 0.5f, (float*)(ws + WS_T)};
#if defined(EXP3_VAR)
        pg8::gemm_phase<EpiResid, pg8::DynOrder<pg8::SplitKOrder>, PG8_ALIGN, PG8_SP2, EXP3_VAR>(ring, g, S, E); GRID_BAR();
#endif
        pg8::gemm_phase<EpiResid, pg8::DynOrder<pg8::SplitKOrder>, PG8_ALIGN, PG8_SP2, PG8_VAR>(ring, g, S, E);
        FILL_TAIL(3, Q_WIN); if (BOTH(3)) GRID_BAR();
    }
    TSTAMP(4);
    if (IN(4)) REPS(4) { const float* X = (const float*)(ws + WS_X);
        if (F.G % 4 == 0) norm_phase<false, true>(F, X, F.in[I_CTX], true, F.in[I_NORMG] + D, 3, 4, (bf16*)(ws + WS_U), nullptr, (const float*)(ws + WS_T));
        else norm_rows<false, true>(F, X, F.in[I_CTX], MA, F.in[I_NORMG] + D, 3, 4, (bf16*)(ws + WS_U), nullptr, (const float*)(ws + WS_T));
        if (BOTH(4)) GRID_BAR(); }
    TSTAMP(5);
    if (IN(5)) REPS(5) {
        pg8::Gemm g{(const char*)(ws + WS_U), (const char*)(ws + WS_WIN), D, D, D, 0, 0};
        pg8::DynOrder<pg8::SplitKOrder> S; S.ctr = ctl + CW_DYN + 128 * 5; S.slot = DSLOT; S.G = F.G; S.c = (int)blockIdx.x;
        S.B.S.init(ML, DIN, F.G, (int)blockIdx.x, WGM_FFN); S.B.pm0 = ML / BM; S.B.npn = SW / BM; S.B.ntiles = (MC / BM) * (SW / BM); S.B.kt_a = 16; S.B.kt_b = 16;
        EpiWin E{(bf16*)(ws + WS_A2), (float*)(ws + WS_Z), (bf16*)(ws + WS_UP), (bf16*)(ws + WS_GT)};
        pg8::gemm_phase<EpiWin, pg8::DynOrder<pg8::SplitKOrder>, PG8_ALIGN, PG8_SP2, PG8_VAR>(ring, g, S, E);
        FILL_TAIL(5, Q_WIN); if (BOTH(5)) GRID_BAR();
    }
    TSTAMP(6);
    if (IN(6)) REPS(6) {
        { pg8::Gemm g{(const char*)(ws + WS_A2), (const char*)(ws + WS_BTS), A2K, CT * SK, CT * SK, (long)A2R * A2K * 2, (long)256 * CT * SK * 2};
          pg8::GroupOrder S{A2R / BM, 1, SG, F.G, (int)blockIdx.x};
          EpiF32G E{(float*)(ws + WS_S), 256, (size_t)A2R * 256};
          pg8::gemm_phase<EpiF32G, pg8::GroupOrder, PG8_ALIGN, PG8_SP2, PG8_VAR>(ring, g, S, E); }
        ctx_scan(F);
        __syncthreads();
        pool_units(F);
        FILL_MAND(Q_POOL); if (BOTH(6)) GRID_BAR();
    }
    TSTAMP(7);
    if (IN(7)) REPS(7) {
        chunk_recurrence(F);
        { pg8::Gemm g{(const char*)(ws + WS_MIX), (const char*)(ws + WS_WPOOL), PW_, 512, 512, (long)512 * 2, (long)512 * 512 * 2};
          pg8::GroupOrder S{ML / BM, 512 / BM, 4, F.G, (int)blockIdx.x};
          EpiPool E{(bf16*)(ws + WS_YB), F.in[I_POOLS]};
          pg8::gemm_phase<EpiPool, pg8::GroupOrder, PG8_ALIGN, PG8_SP2, PG8_VAR>(ring, g, S, E); }
        FILL_MAND(Q_WB); if (BOTH(7)) GRID_BAR();
    }
    TSTAMP(8);
    if (IN(8)) REPS(8) {
        { pg8::Gemm g{(const char*)(ws + WS_A2), (const char*)(ws + WS_BTY), A2K, A2K, A2K, (long)A2R * A2K * 2, (long)(CT * SK) * A2K * 2};
          pg8::GroupOrder S{A2R / BM, (CT * SK) / BM, SG, F.G, F.vcu};
          EpiY E{(bf16*)(ws + WS_Z)};
          pg8::gemm_phase<EpiY, pg8::GroupOrder, PG8_ALIGN, PG8_SP2, PG8_VAR>(ring, g, S, E); }
        { pg8::Gemm g{(const char*)(ws + WS_YB), (const char*)(ws + WS_WB), PW_, PW_, PW_, 0, 0}; pg8::StaticOrder S; S.init(ML, D, F.G, (int)blockIdx.x, 4);
          EpiBranch<false> E{(bf16*)(ws + WS_T), (const bf16*)(ws + WS_GT), D};
          pg8::gemm_phase<EpiBranch<false>, pg8::StaticOrder, PG8_ALIGN, PG8_SP2, PG8_VAR>(ring, g, S, E); }
        FILL_MAND(Q_GLU); if (BOTH(8)) GRID_BAR();
    }
    TSTAMP(9);
    if (IN(9)) REPS(9) {
        pg8::Gemm g{(const char*)(ws + WS_Z), (const char*)(ws + WS_WGLU), SW, SW, SW, 0, 0}; pg8::StaticOrder S; S.init(ML, 2 * SW, F.G, (int)blockIdx.x);
        EpiGated<1> E{(bf16*)(ws + WS_GL), SW};
        pg8::gemm_phase<EpiGated<1>, pg8::StaticOrder, PG8_ALIGN, PG8_SP2, PG8_VAR>(ring, g, S, E);
        FILL_MAND(Q_WA); if (BOTH(9)) GRID_BAR();
    }
    TSTAMP(10);
    if (IN(10)) {
        pg8::Gemm g{(const char*)(ws + WS_GL), (const char*)(ws + WS_WA), SW, SW, SW, 0, 0}; pg8::StaticOrder S; S.init(ML, D, F.G, (int)blockIdx.x);
        EpiBranch<true> E{(bf16*)(ws + WS_T), (const bf16*)(ws + WS_GT), 0};
        pg8::gemm_phase<EpiBranch<true>, pg8::StaticOrder, PG8_ALIGN, PG8_SP2, PG8_VAR>(ring, g, S, E);
        FILL_MAND(Q_WOUT); if (BOTH(10)) GRID_BAR();
    }
    TSTAMP(11);
    if (IN(11)) {
        pg8::Gemm g{(const char*)(ws + WS_T), (const char*)(ws + WS_WOUT), D, D, D, 0, 0}; pg8::StaticOrder S; S.init(ML, D, F.G, (int)blockIdx.x, 4);
        EpiResid E{(const float*)(ws + WS_X), (const float*)(ws + WS_X) + (size_t)ML * D, (float*)(ws + WS_X), mod, 5, 1.0f, nullptr};
        pg8::gemm_phase<EpiResid, pg8::StaticOrder, PG8_ALIGN, PG8_SP2, PG8_VAR>(ring, g, S, E);
        FILL_MAND(Q_W2A); if (BOTH(11)) GRID_BAR();
    }
    TSTAMP(12);
    if (IN(12)) REPS(12) { const float* X = (const float*)(ws + WS_X);
        if (F.G % 4 == 0) norm_phase<false, false>(F, X, nullptr, false, F.in[I_NORMG] + 2 * D, 6, 7, (bf16*)(ws + WS_U), nullptr, nullptr);
        else norm_rows<false>(F, X, X + (size_t)ML * D, ML, F.in[I_NORMG] + 2 * D, 6, 7, (bf16*)(ws + WS_U), nullptr);
        if (BOTH(12)) GRID_BAR(); }
    TSTAMP(13);
    if (IN(13)) REPS(13) {
        pg8::Gemm g{(const char*)(ws + WS_U), (const char*)(ws + WS_W2A), D, D, D, 0, 0};
        pg8::DynOrder<pg8::StaticOrder> S; S.B.init(ML, 2 * DFF, F.G, (int)blockIdx.x, WGM_FFN); S.ctr = ctl + CW_DYN + 128 * 13; S.slot = DSLOT; S.G = F.G; S.c = (int)blockIdx.x;
        EpiGated<0> E{(bf16*)(ws + WS_H), DFF};
        pg8::gemm_phase<EpiGated<0>, pg8::DynOrder<pg8::StaticOrder>, PG8_ALIGN, PG8_SP2, PG8_VAR>(ring, g, S, E);
        FILL_TAIL(13, Q_W2B); if (BOTH(13)) GRID_BAR();
    }
    TSTAMP(14);
    if (IN(14)) {
        pg8::Gemm g{(const char*)(ws + WS_H), (const char*)(ws + WS_W2B), DFF, DFF, DFF, 0, 0}; pg8::StaticOrder S; S.init(ML, D, F.G, (int)blockIdx.x, 2);
        EpiResid E{(const float*)(ws + WS_X), (const float*)(ws + WS_X) + (size_t)ML * D, (float*)(ws + WS_X), mod, 8, 0.5f, nullptr};
        pg8::gemm_phase<EpiResid, pg8::StaticOrder, PG8_ALIGN, PG8_SP2, PG8_VAR>(ring, g, S, E);
        if (BOTH(14)) GRID_BAR();
    }
    TSTAMP(15);
    if (IN(15)) REPS(15) { const float* X = (const float*)(ws + WS_X);
        if (F.G % 4 == 0) norm_phase<true, false>(F, X, nullptr, false, F.in[I_FINALG], 0, 0, nullptr, F.out, nullptr);
        else norm_rows<true>(F, X, X, ML, F.in[I_FINALG], 0, 0, nullptr, F.out); }
    TSTAMP(16);
#if defined(EXP_T_LO)
    if (blockIdx.x == 0) { const unsigned long long t0_ = __builtin_amdgcn_s_memrealtime(), w_ = (tB_ - tA_) * EXP_T_MUL; while (__builtin_amdgcn_s_memrealtime() - t0_ < w_) __builtin_amdgcn_s_sleep(8); }
#endif
#undef IN
#undef BOTH
#undef GRID_BAR
}

extern "C" void kernel_launch(void* const* d_in, const int* in_sizes, int n_in, void* d_out, int out_size, void* d_ws, size_t ws_size, hipStream_t stream) {
    static int grid = 0;
    if (grid == 0) {
        if (n_in != 27 || in_sizes[0] != ML * D || out_size != ML * D || ws_size < WS_END) { fprintf(stderr, "kernel_launch: unexpected shapes (n_in %d, in0 %d, out %d, ws %zu < %zu); nothing launched\n", n_in, n_in > 0 ? in_sizes[0] : -1, out_size, ws_size, (size_t)WS_END); grid = -1; return; }
        int dev = 0, cus = 0, per_cu = 0;
        if (hipGetDevice(&dev) != hipSuccess || hipDeviceGetAttribute(&cus, hipDeviceAttributeMultiprocessorCount, dev) != hipSuccess) { fprintf(stderr, "kernel_launch: device query failed\n"); grid = -1; return; }
        if (hipFuncSetAttribute((const void*)fwd_kernel, hipFuncAttributeMaxDynamicSharedMemorySize, LDS_BYTES) != hipSuccess) { fprintf(stderr, "kernel_launch: hipFuncSetAttribute failed\n"); grid = -1; return; }
        if (hipOccupancyMaxActiveBlocksPerMultiprocessor(&per_cu, (const void*)fwd_kernel, NWAVES * 64, LDS_BYTES) != hipSuccess || per_cu < 1) fprintf(stderr, "kernel_launch: note: occupancy query reports %d workgroups per CU\n", per_cu);
        (void)hipGetLastError();
        grid = cus;
    }
    if (grid < 0) return;
    if (hipMemsetAsync((char*)d_ws + WS_CTL, 0, CTL_ZERO_BYTES, stream) != hipSuccess) { fprintf(stderr, "kernel_launch: memset failed\n"); return; }
    Args a{};
    for (int i = 0; i < 27; ++i) a.in[i] = (const float*)d_in[i];
    a.out = (float*)d_out; a.ws = (unsigned char*)d_ws;
    for (int li = 0; li < MK_N_LAUNCHES; ++li) {
        a.ph_lo = (MK_N_LAUNCHES == 1) ? 0 : li; a.ph_hi = (MK_N_LAUNCHES == 1) ? NPHASES : li + 1;
        hipLaunchKernelGGL(fwd_kernel, dim3(grid), dim3(NWAVES * 64), LDS_BYTES, stream, a);
        const hipError_t le = hipPeekAtLastError();
        if (le != hipSuccess) { fprintf(stderr, "kernel_launch: launch %d failed: %s\n", li, hipGetErrorName(le)); break; }
    }
}
```

```cpp
#include <hip/hip_runtime.h>
#include <cstdio>
#include <cstdint>

namespace pg8 {
#define PG8_LAS __attribute__((address_space(3)))
typedef unsigned short bf16_t;
typedef short bf16x8 __attribute__((ext_vector_type(8)));
typedef float f32x4 __attribute__((ext_vector_type(4)));
typedef unsigned u32x4 __attribute__((ext_vector_type(4)));
constexpr int BM = 256, BK = 64, HALF = 128, HTB = HALF * BK * 2  , STAGE_BYTES = 8 * HTB, NXCD = 8, WGM = 8;

__host__ __device__ __forceinline__ int lds_byte(int r, int c) { const int st = (r >> 4) * 2 + (c >> 5), rr = r & 15, cc = c & 31, ob = rr * 64 + cc * 2; return st * 1024 + (ob ^ (((ob >> 9) & 1) << 5)); }
__host__ __device__ __forceinline__ void stage_rc(int b, int& R, int& C) { const int st = b / 1024, sb = b % 1024, swz = sb ^ (((sb >> 9) & 1) << 5); R = (st >> 1) * 16 + swz / 64; C = (st & 1) * 32 + (swz % 64) / 2; }
__host__ __device__ __forceinline__ int perm32(int rho) { const int n = rho >> 4, i = rho & 15; return 8 * (i >> 2) + 4 * n + (i & 3); }

struct Unit { int pm, pn, g, kt0, nkt; };
struct Gemm { const char* A; const char* Bt; int lda, ldb, K; long gsa, gsb; };

struct StaticOrder {
    int nM, nN, nwg, G, c, wgm;
    __host__ __device__ void init(int M, int N, int G_, int c_, int wgm_ = WGM) { nM = M / BM; nN = N / BM; nwg = nM * nN; G = G_; c = c_; wgm = wgm_; }
    static constexpr bool DYNAMIC = false;
    __host__ __device__ int total() const { return nwg; }
    __host__ __device__ bool next(int i, Unit& u) const { return at((long)i * G + c, u); }
    __host__ __device__ bool at(long L, Unit& u) const {
        if (L >= nwg) return false;
        int wgid = (int)L; { const int q = nwg / NXCD, r = nwg % NXCD, xcd = wgid % NXCD, off = wgid / NXCD; wgid = (xcd < r ? xcd * (q + 1) : r * (q + 1) + (xcd - r) * q) + off; }
        const int nig = wgm * nN, gid = wgid / nig, fm = gid * wgm, gsz = (nM - fm) < wgm ? (nM - fm) : wgm;
        u.pm = fm + ((wgid % nig) % gsz); u.pn = (wgid % nig) / gsz; u.g = 0; u.kt0 = 0; u.nkt = 0; return true;
    }
    __device__ __forceinline__ void a_ready(const Unit&) const {}
    __device__ __forceinline__ void done(const Unit&) const {}
};
struct GroupOrder {
    static constexpr bool DYNAMIC = false;
    int nM, nN, ng, G, c;
    __device__ bool next(int i, Unit& u) const {
        const long L = (long)i * G + c; const int per = nM * nN; if (L >= (long)ng * per) return false;
        u.g = (int)(L / per); const int r = (int)(L % per); u.pm = r % nM; u.pn = r / nM; u.kt0 = 0; u.nkt = 0; return true;
    }
    __device__ __forceinline__ void a_ready(const Unit&) const {}
    __device__ __forceinline__ void done(const Unit&) const {}
};

struct SplitKOrder {
    StaticOrder S; int pm0, npn, ntiles, kt_a, kt_b;
    static constexpr bool DYNAMIC = false;
    __device__ int total() const { return S.nwg + 4 * ntiles; }
    __device__ bool next(int i, Unit& u) const { return at((long)i * S.G + S.c, u); }
    __device__ bool at(long L, Unit& u) const {
        if (L < S.nwg) return S.at(L, u);
        const int j = (int)(L - S.nwg); if (j >= 4 * ntiles) return false;
        const int split = j & 3, tile = j >> 2;
        u.pm = pm0 + tile / npn; u.pn = tile % npn; u.g = split + 1; u.kt0 = split < 2 ? split * kt_a : 2 * kt_a + (split - 2) * kt_b; u.nkt = split < 2 ? kt_a : kt_b; return true;
    }
    __device__ __forceinline__ void a_ready(const Unit&) const {}
    __device__ __forceinline__ void done(const Unit&) const {}
};

template <class Base> struct DynOrder {
    static constexpr bool DYNAMIC = true;
    Base B; unsigned* ctr; volatile PG8_LAS int* slot; int G, c;
    __device__ int total() const { return B.total(); }
    __device__ bool at(long L, Unit& u) const { return B.at(L, u); }
    __device__ int pull() const {
        const int x = c & 7, tot = B.total();
        for (int s_ = 0; s_ < 8; ++s_) { const int y = (x + s_) & 7, n0 = (G - y + 7) >> 3;
            const unsigned k = (unsigned)n0 + __hip_atomic_fetch_add(ctr + 16 * y, 1u, __ATOMIC_RELAXED, __HIP_MEMORY_SCOPE_AGENT);
            const long L = 8l * (long)k + y; if (L < tot) return (int)L; }
        return -1;
    }
    __device__ __forceinline__ void a_ready(const Unit&) const {}
    __device__ __forceinline__ void done(const Unit&) const {}
};

__device__ __forceinline__ unsigned cvt_pk_bf16(float lo, float hi) { unsigned r; asm volatile("v_cvt_pk_bf16_f32 %0, %1, %2" : "=v"(r) : "v"(lo), "v"(hi)); return r; }
__device__ __forceinline__ float sigmoidf_fast(float x) { return __builtin_amdgcn_rcpf(1.0f + __expf(-x)); }
__device__ __forceinline__ float bf_lo(unsigned w) { return __uint_as_float(w << 16); }
__device__ __forceinline__ float bf_hi(unsigned w) { return __uint_as_float(w & 0xffff0000u); }

template <class Epi, class Sched, bool ALIGN_EPI = false, bool SP2 = false, int VAR = 0>
__device__ __forceinline__ void gemm_phase(PG8_LAS unsigned char* lds, const Gemm g, const Sched& S, const Epi& E) {
    const int tid = threadIdx.x, wid = __builtin_amdgcn_readfirstlane(tid >> 6), lane = tid & 63, wr = wid >> 2, wc = wid & 3, fr = lane & 15, fq = lane >> 4;
    const int K = g.K, nt = K / BK;
    unsigned voffA[2], voffB[2];
#pragma unroll
    for (int i = 0; i < 2; ++i) { int R, C; stage_rc(tid * 16 + i * 8192, R, C); const int Rb = Epi::PERM ? ((R & ~31) + perm32(R & 31)) : R;
        voffA[i] = (unsigned)(R * g.lda + C) * 2u; voffB[i] = (unsigned)(Rb * g.ldb + C) * 2u; }
    const size_t kstep = (size_t)(BK * 2);
    const size_t hsA = (size_t)HALF * g.lda * 2, hsB = (size_t)HALF * g.ldb * 2;
    const size_t tsA = 2 * hsA, tsB = 2 * hsB;
    const unsigned ldsw = (unsigned)wid * 1024u;
    const int aoff = lds_byte(wr * 64 + fr, fq * 8), boff = lds_byte(wc * 32 + fr, fq * 8);
#define PG8_SA(b, h) (((b) * 2 + (h)) * HTB)
#define PG8_SB(b, h) ((4 + (b) * 2 + (h)) * HTB)
#define PG8_STAGE(bufoff, gbase, voff) do { if (!(VAR & 1)) _Pragma("unroll") for (int _i = 0; _i < 2; ++_i) \
        __builtin_amdgcn_global_load_lds((const unsigned*)((const char*)(gbase) + (voff)[_i]), (PG8_LAS unsigned*)(lds + (bufoff) + ldsw + _i * 8192), 16, 0, 0); } while (0)
#define PG8_LDA(dst, b, h) do { if (!(VAR & 2)) _Pragma("unroll") for (int m = 0; m < 4; ++m) _Pragma("unroll") for (int k = 0; k < 2; ++k) dst[m][k] = *(const PG8_LAS bf16x8*)(lds + PG8_SA(b, h) + aoff + m * 2048 + k * 1024); } while (0)
#define PG8_LDB(dst, b, h) do { if (!(VAR & 2)) _Pragma("unroll") for (int n = 0; n < 2; ++n) _Pragma("unroll") for (int k = 0; k < 2; ++k) dst[n][k] = *(const PG8_LAS bf16x8*)(lds + PG8_SB(b, h) + boff + n * 2048 + k * 1024); } while (0)
#define PG8_MMA(ai, bj, At, Bt) do { if (!(VAR & 128)) __builtin_amdgcn_s_setprio(1); if (!(VAR & 4)) _Pragma("unroll") for (int m = 0; m < 4; ++m) _Pragma("unroll") for (int n = 0; n < 2; ++n) _Pragma("unroll") for (int k = 0; k < 2; ++k) \
        acc[ai][bj][m][n] = __builtin_amdgcn_mfma_f32_16x16x32_bf16(Bt[n][k], At[m][k], acc[ai][bj][m][n], 0, 0, 0); if (!(VAR & 128)) __builtin_amdgcn_s_setprio(0); } while (0)
#define PG8_WAIT_V(n) asm volatile("s_waitcnt vmcnt(" #n ")" ::: "memory")
#define PG8_WAIT_L(n) asm volatile("s_waitcnt lgkmcnt(" #n ")" ::: "memory")
#define PG8_BAR __builtin_amdgcn_s_barrier()
#define PG8_SCHED __builtin_amdgcn_sched_barrier(0)
    Unit cur, nxt; int ui = 0;
    if constexpr (Sched::DYNAMIC) {
        if (!S.at(S.c, cur)) return;
        if (tid == 0) S.slot[1] = S.pull();
        __syncthreads();
    } else { if (!S.next(0, cur)) return; }
    if constexpr (VAR & 128) { if (wr == 1) __builtin_amdgcn_s_setprio(1); }
    f32x4 acc[2][2][4][2];
#pragma unroll
    for (int a = 0; a < 2; ++a)
#pragma unroll
        for (int b = 0; b < 2; ++b)
#pragma unroll
            for (int m = 0; m < 4; ++m)
#pragma unroll
                for (int n = 0; n < 2; ++n) acc[a][b][m][n] = (f32x4){0.f, 0.f, 0.f, 0.f};
    bf16x8 At[4][2], B0[2][2], B1[2][2];
    if (VAR & 2) {
#pragma unroll
        for (int m = 0; m < 4; ++m)
#pragma unroll
            for (int k = 0; k < 2; ++k) { At[m][k] = (bf16x8){0, 0, 0, 0, 0, 0, 0, 0}; asm volatile("" : "+v"(At[m][k])); }
#pragma unroll
        for (int n = 0; n < 2; ++n)
#pragma unroll
            for (int k = 0; k < 2; ++k) { B0[n][k] = (bf16x8){0, 0, 0, 0, 0, 0, 0, 0}; B1[n][k] = B0[n][k]; asm volatile("" : "+v"(B0[n][k])); asm volatile("" : "+v"(B1[n][k])); }
    }
    const bool grouped = g.gsa != 0 || g.gsb != 0;
    const char* cA = g.A + (grouped ? (size_t)cur.g * g.gsa : 0) + (size_t)((VAR & 8) ? 0 : cur.pm) * tsA + (size_t)cur.kt0 * kstep; const char* cB = g.Bt + (grouped ? (size_t)cur.g * g.gsb : 0) + (size_t)((VAR & 8) ? 0 : cur.pn) * tsB + (size_t)cur.kt0 * kstep;
    S.a_ready(cur);
    if constexpr (SP2) {
        PG8_STAGE(PG8_SB(0, 0), cB, voffB); PG8_STAGE(PG8_SB(0, 1), cB + hsB, voffB); PG8_STAGE(PG8_SA(0, 0), cA, voffA); PG8_STAGE(PG8_SA(0, 1), cA + hsA, voffA);
        if (wr == 1) PG8_BAR;
        PG8_WAIT_V(2); PG8_BAR;
        PG8_STAGE(PG8_SB(1, 0), cB + kstep, voffB); PG8_STAGE(PG8_SA(1, 0), cA + kstep, voffA); PG8_STAGE(PG8_SB(1, 1), cB + hsB + kstep, voffB);
        PG8_WAIT_V(6); PG8_BAR;
    } else {
        PG8_STAGE(PG8_SB(0, 0), cB, voffB); PG8_STAGE(PG8_SA(0, 0), cA, voffA); PG8_STAGE(PG8_SB(0, 1), cB + hsB, voffB); PG8_STAGE(PG8_SA(0, 1), cA + hsA, voffA);
        if (wr == 1) PG8_BAR;
        PG8_WAIT_V(4); PG8_BAR;
        PG8_STAGE(PG8_SB(1, 0), cB + kstep, voffB); PG8_STAGE(PG8_SA(1, 0), cA + kstep, voffA); PG8_STAGE(PG8_SB(1, 1), cB + hsB + kstep, voffB);
        PG8_WAIT_V(6); PG8_BAR;
    }
    unsigned sink = 0u; const int tidx = wid * 12 + lane; const bool t_isA = tidx < 64; constexpr int PD = 4;
    for (;;) {
        bool has_next = false; const char* nA = cA; const char* nB = cB;
#define PG8_NEXT_PTRS() do { nA = has_next ? g.A + (grouped ? (size_t)nxt.g * g.gsa : 0) + (size_t)((VAR & 8) ? 0 : nxt.pm) * tsA + (size_t)nxt.kt0 * kstep : cA; \
                             nB = has_next ? g.Bt + (grouped ? (size_t)nxt.g * g.gsb : 0) + (size_t)((VAR & 8) ? 0 : nxt.pn) * tsB + (size_t)nxt.kt0 * kstep : cB; } while (0)
        if constexpr (!Sched::DYNAMIC) { has_next = S.next(ui + 1, nxt); PG8_NEXT_PTRS(); }
        const int ntu = cur.nkt ? cur.nkt : nt;
        const unsigned toff = t_isA ? (unsigned)(((cur.pn & 3) * 64 + tidx) * g.lda) * 2u : (unsigned)(((cur.pm & 7) * 32 + (tidx - 64)) * g.ldb) * 2u;
#define PG8_TOUCH(tt) do { if constexpr (VAR & 64) { const int tp_ = (tt) + PD; const char* ta_ = tp_ < ntu ? cA + (size_t)tp_ * kstep : nA + (size_t)(tp_ - ntu) * kstep; \
            const char* tb_ = tp_ < ntu ? cB + (size_t)tp_ * kstep : nB + (size_t)(tp_ - ntu) * kstep; const char* tpp_ = (t_isA ? ta_ : tb_) + toff; \
            if (lane < 12) asm volatile("global_load_dword %0, %1, off" : "+v"(sink) : "v"(tpp_) : "memory"); } } while (0)
        for (int t = 0; t < ntu; t += 2) {
            const bool last = (t == ntu - 2);
            if constexpr (Sched::DYNAMIC) { if (last) {
                const int nL = __builtin_amdgcn_readfirstlane(S.slot[(ui + 1) & 1]); has_next = nL >= 0; if (has_next) has_next = S.at(nL, nxt); PG8_NEXT_PTRS(); } }
            const char* a1 = cA + (size_t)(t + 1) * kstep;
            const char* a2 = last ? nA : cA + (size_t)(t + 2) * kstep; const char* b2 = last ? nB : cB + (size_t)(t + 2) * kstep;
            const char* a3 = a2 + kstep; const char* b3 = b2 + kstep;
            if (last && has_next) S.a_ready(nxt);
            if constexpr (SP2) {
            if constexpr (VAR & 256) { PG8_STAGE(PG8_SA(1, 1), a1 + hsA, voffA); PG8_SCHED; PG8_LDB(B0, 0, 0); PG8_LDB(B1, 0, 1); PG8_SCHED; PG8_LDA(At, 0, 0); } else {
            PG8_LDB(B0, 0, 0); PG8_LDB(B1, 0, 1); PG8_SCHED; PG8_LDA(At, 0, 0); PG8_STAGE(PG8_SA(1, 1), a1 + hsA, voffA); } PG8_TOUCH(t);
            if constexpr ((VAR & 96) == 96) { PG8_WAIT_L(0); PG8_BAR; PG8_MMA(0, 0, At, B0); PG8_MMA(0, 1, At, B1); PG8_WAIT_V(10); PG8_BAR; PG8_SCHED; } else
            if constexpr (VAR & 32) { if (wr == 1) PG8_WAIT_V(8); PG8_WAIT_L(0); PG8_BAR; PG8_MMA(0, 0, At, B0); PG8_MMA(0, 1, At, B1); if (wr == 0) PG8_WAIT_V(8); PG8_BAR; PG8_SCHED; } else {
            PG8_WAIT_V(8); PG8_WAIT_L(0); PG8_BAR; PG8_MMA(0, 0, At, B0); PG8_MMA(0, 1, At, B1); PG8_BAR; PG8_SCHED; }
            if constexpr (VAR & 16) {
            PG8_LDA(At, 0, 1); PG8_STAGE(PG8_SB(0, 0), b2, voffB); PG8_STAGE(PG8_SB(0, 1), b2 + hsB, voffB);
            PG8_WAIT_V(6); PG8_WAIT_L(0); PG8_BAR; PG8_MMA(1, 0, At, B0); PG8_SCHED; PG8_STAGE(PG8_SA(0, 0), a2, voffA); PG8_SCHED; PG8_MMA(1, 1, At, B1); PG8_BAR; PG8_SCHED;
            } else {
            if constexpr (VAR & 256) { PG8_STAGE(PG8_SB(0, 0), b2, voffB); PG8_STAGE(PG8_SB(0, 1), b2 + hsB, voffB); PG8_STAGE(PG8_SA(0, 0), a2, voffA); PG8_SCHED; PG8_LDA(At, 0, 1); } else {
            PG8_LDA(At, 0, 1); PG8_STAGE(PG8_SB(0, 0), b2, voffB); PG8_STAGE(PG8_SB(0, 1), b2 + hsB, voffB); PG8_STAGE(PG8_SA(0, 0), a2, voffA); }
            if constexpr ((VAR & 96) == 96) { PG8_WAIT_L(0); PG8_BAR; PG8_MMA(1, 0, At, B0); PG8_MMA(1, 1, At, B1); PG8_WAIT_V(9); PG8_BAR; PG8_SCHED; } else
            if constexpr (VAR & 32) { if (wr == 1) PG8_WAIT_V(8); PG8_WAIT_L(0); PG8_BAR; PG8_MMA(1, 0, At, B0); PG8_MMA(1, 1, At, B1); if (wr == 0) PG8_WAIT_V(8); PG8_BAR; PG8_SCHED; } else {
            PG8_WAIT_V(8); PG8_WAIT_L(0); PG8_BAR; PG8_MMA(1, 0, At, B0); PG8_MMA(1, 1, At, B1); PG8_BAR; PG8_SCHED; }
            }
            if constexpr (VAR & 256) { PG8_STAGE(PG8_SA(0, 1), a2 + hsA, voffA); PG8_SCHED; PG8_LDB(B0, 1, 0); PG8_LDB(B1, 1, 1); PG8_SCHED; PG8_LDA(At, 1, 0); } else {
            PG8_LDB(B0, 1, 0); PG8_LDB(B1, 1, 1); PG8_SCHED; PG8_LDA(At, 1, 0); PG8_STAGE(PG8_SA(0, 1), a2 + hsA, voffA); } PG8_TOUCH(t + 1);
            if constexpr ((VAR & 96) == 96) { PG8_WAIT_L(0); PG8_BAR; PG8_MMA(0, 0, At, B0); PG8_MMA(0, 1, At, B1); PG8_WAIT_V(10); PG8_BAR; PG8_SCHED; } else
            if constexpr (VAR & 32) { if (wr == 1) PG8_WAIT_V(8); PG8_WAIT_L(0); PG8_BAR; PG8_MMA(0, 0, At, B0); PG8_MMA(0, 1, At, B1); if (wr == 0) PG8_WAIT_V(8); PG8_BAR; PG8_SCHED; } else {
            PG8_WAIT_V(8); PG8_WAIT_L(0); PG8_BAR; PG8_MMA(0, 0, At, B0); PG8_MMA(0, 1, At, B1); PG8_BAR; PG8_SCHED; }
            if constexpr (VAR & 16) {
            PG8_LDA(At, 1, 1); PG8_STAGE(PG8_SB(1, 0), b3, voffB); PG8_STAGE(PG8_SB(1, 1), b3 + hsB, voffB);
            PG8_WAIT_V(6); PG8_WAIT_L(0); PG8_BAR; PG8_MMA(1, 0, At, B0); PG8_SCHED; PG8_STAGE(PG8_SA(1, 0), a3, voffA); PG8_SCHED; PG8_MMA(1, 1, At, B1); PG8_BAR; PG8_SCHED;
            } else {
            if constexpr (VAR & 256) { PG8_STAGE(PG8_SB(1, 0), b3, voffB); PG8_STAGE(PG8_SB(1, 1), b3 + hsB, voffB); PG8_STAGE(PG8_SA(1, 0), a3, voffA); PG8_SCHED; PG8_LDA(At, 1, 1); } else {
            PG8_LDA(At, 1, 1); PG8_STAGE(PG8_SB(1, 0), b3, voffB); PG8_STAGE(PG8_SB(1, 1), b3 + hsB, voffB); PG8_STAGE(PG8_SA(1, 0), a3, voffA); }
            if constexpr ((VAR & 96) == 96) { PG8_WAIT_L(0); PG8_BAR; PG8_MMA(1, 0, At, B0); PG8_MMA(1, 1, At, B1); PG8_WAIT_V(9); PG8_BAR; PG8_SCHED; } else
            if constexpr (VAR & 32) { if (wr == 1) PG8_WAIT_V(8); PG8_WAIT_L(0); PG8_BAR; PG8_MMA(1, 0, At, B0); PG8_MMA(1, 1, At, B1); if (wr == 0) PG8_WAIT_V(8); PG8_BAR; PG8_SCHED; } else {
            PG8_WAIT_V(8); PG8_WAIT_L(0); PG8_BAR; PG8_MMA(1, 0, At, B0); PG8_MMA(1, 1, At, B1); PG8_BAR; PG8_SCHED; }
            }
            } else {
            PG8_LDB(B0, 0, 0); PG8_SCHED; PG8_LDA(At, 0, 0); PG8_STAGE(PG8_SA(1, 1), a1 + hsA, voffA);
            PG8_WAIT_L(8); PG8_BAR; PG8_WAIT_L(0); PG8_MMA(0, 0, At, B0); PG8_BAR; PG8_SCHED;
            PG8_LDB(B1, 0, 1); PG8_STAGE(PG8_SB(0, 0), b2, voffB);
            PG8_BAR; PG8_WAIT_L(0); PG8_MMA(0, 1, At, B1); PG8_BAR;
            PG8_LDA(At, 0, 1); PG8_STAGE(PG8_SA(0, 0), a2, voffA);
            PG8_BAR; PG8_WAIT_L(0); PG8_MMA(1, 0, At, B0); PG8_BAR; PG8_SCHED;
            PG8_STAGE(PG8_SB(0, 1), b2 + hsB, voffB);
            PG8_WAIT_V(6); PG8_BAR; PG8_MMA(1, 1, At, B1); PG8_BAR;
            PG8_LDB(B0, 1, 0); PG8_SCHED; PG8_LDA(At, 1, 0); PG8_STAGE(PG8_SA(0, 1), a2 + hsA, voffA);
            PG8_WAIT_L(8); PG8_BAR; PG8_WAIT_L(0); PG8_MMA(0, 0, At, B0); PG8_BAR; PG8_SCHED;
            PG8_LDB(B1, 1, 1); PG8_STAGE(PG8_SB(1, 0), b3, voffB);
            PG8_BAR; PG8_WAIT_L(0); PG8_MMA(0, 1, At, B1); PG8_BAR;
            PG8_LDA(At, 1, 1); PG8_STAGE(PG8_SA(1, 0), a3, voffA);
            PG8_BAR; PG8_WAIT_L(0); PG8_MMA(1, 0, At, B0); PG8_BAR; PG8_SCHED;
            PG8_STAGE(PG8_SB(1, 1), b3 + hsB, voffB);
            PG8_WAIT_V(6); PG8_BAR; PG8_MMA(1, 1, At, B1); PG8_BAR;
            }
        }
        if constexpr (ALIGN_EPI) { if (wr == 0) PG8_BAR; }
        int pulled = -1;
        if constexpr (Sched::DYNAMIC) { if (has_next && tid == 0) pulled = S.pull(); }
        E(acc, cur, wr, wc, fr, fq); S.done(cur);
        if constexpr (Sched::DYNAMIC) { if (has_next && tid == 0) S.slot[ui & 1] = pulled; }
        if (!has_next) break;
#pragma unroll
        for (int a = 0; a < 2; ++a)
#pragma unroll
            for (int b = 0; b < 2; ++b)
#pragma unroll
                for (int m = 0; m < 4; ++m)
#pragma unroll
                    for (int n = 0; n < 2; ++n) acc[a][b][m][n] = (f32x4){0.f, 0.f, 0.f, 0.f};
        cur = nxt; cA = nA; cB = nB; ++ui;
        if constexpr (ALIGN_EPI) { if (wr == 1) PG8_BAR; }
    }
    if constexpr (VAR & 128) __builtin_amdgcn_s_setprio(0);
    PG8_WAIT_V(0);
    asm volatile("" :: "v"(sink));
    if constexpr (!ALIGN_EPI) { if (wr == 0) PG8_BAR; }
    PG8_BAR;
#undef PG8_TOUCH
#undef PG8_NEXT_PTRS
#undef PG8_SA
#undef PG8_SB
#undef PG8_STAGE
#undef PG8_LDA
#undef PG8_LDB
#undef PG8_MMA
#undef PG8_WAIT_V
#undef PG8_WAIT_L
#undef PG8_BAR
#undef PG8_SCHED
}
}

#ifndef PG8_SP2
#define PG8_SP2 true
#endif
#ifndef PG8_ALIGN
#define PG8_ALIGN true
#endif
#ifndef PG8_VAR
#define PG8_VAR 0
#endif

constexpr int NWAVES = 8;
constexpr int D = 4096, BATCH = 4, SEQ = 4096, CTXL = 256, DFF = 11008, NMOD = 9;
constexpr int ML = BATCH * SEQ;
constexpr int MC = BATCH * CTXL;
constexpr int MA = ML + MC;
constexpr int SW = 1024, SG = 64, SK = 16, SP = 64;
constexpr int PW_ = 2048;
constexpr int DIN = SW + PW_ + 2 * D;
constexpr int CT = 32;
constexpr int NCH = SEQ / CT;
constexpr int A2R = BATCH * NCH;
constexpr int A2K = CT * SK + 4 * SP;
constexpr float RMS_EPS = 1e-6f;

constexpr size_t MiB = 1u << 20;
constexpr size_t WS_CTL = 0, CTL_ZERO_BYTES = 32768;
constexpr size_t WS_MOD = 1 * MiB;
constexpr size_t WS_BBAR = 2 * MiB;
constexpr size_t WS_LAMB = 3 * MiB;
constexpr size_t WS_USC = 4 * MiB;
constexpr size_t WS_S = 6 * MiB;
constexpr size_t WS_A2 = 38 * MiB;
constexpr size_t WS_BTY = 86 * MiB;
constexpr size_t WS_BTS = 134 * MiB;
constexpr size_t WS_W1A = 150 * MiB, WS_W1B = 322 * MiB, WS_W2A = 408 * MiB, WS_W2B = 580 * MiB;
constexpr size_t WS_WIN = 666 * MiB, WS_WGLU = 754 * MiB, WS_WA = 758 * MiB, WS_WPOOL = 766 * MiB, WS_WB = 768 * MiB, WS_WOUT = 784 * MiB;
constexpr size_t WS_U = 816 * MiB;
constexpr size_t WS_MIX = WS_U, WS_YB = WS_U + 64 * MiB;
constexpr size_t WS_H = 952 * MiB;
constexpr size_t WS_UP = WS_H, WS_GT = WS_H + 64 * MiB;
constexpr size_t WS_X = 1318 * MiB;
constexpr size_t WS_Z = 1590 * MiB, WS_GL = 1622 * MiB, WS_T = 1654 * MiB;
constexpr size_t WS_XB = 1782 * MiB;
constexpr size_t WS_END = 1918 * MiB;
static_assert(WS_H + (size_t)MA * DFF * 2 <= WS_X && WS_GT + (size_t)ML * 2 * D * 2 <= WS_X && WS_U + (size_t)MA * D * 2 <= WS_H && WS_X + (size_t)MA * D * 4 <= WS_Z, "ws map");
constexpr int CW_TMO = 0, CW_QUEUE = 64, CW_DONE = 512  , CW_DYN = 1536  , CW_BAR = 4096;

constexpr int RING_OFF = 0;
constexpr int MISC_OFF = 144000;
constexpr int LDS_BYTES = 147456;

#define GAS __attribute__((address_space(1)))
#define LAS __attribute__((address_space(3)))
typedef unsigned short bf16;
typedef unsigned v4u __attribute__((ext_vector_type(4)));
typedef unsigned v2u __attribute__((ext_vector_type(2)));
typedef float f32x4 __attribute__((ext_vector_type(4)));
typedef GAS unsigned gu32;
#define RLX_AGENT __ATOMIC_RELAXED, __HIP_MEMORY_SCOPE_AGENT
#define LDS_WAIT() asm volatile("s_waitcnt lgkmcnt(0)" ::: "memory")
#define VM_WAIT() asm volatile("s_waitcnt vmcnt(0)" ::: "memory")
using pg8::cvt_pk_bf16; using pg8::sigmoidf_fast; using pg8::bf_lo; using pg8::bf_hi;

#define XB_TMO      128
#define XB_XCNT(j)  (256  + 64 * (j))
#define XB_XSUB(j)  (1280 + 64 * (j))
#define XB_XGEN(j)  (2304 + 64 * (j))
#define XB_TOP      3328
#define XB_TOPGEN   3392
#define XCD_BAR_WORDS 3456
#define XB_SPIN_CAP (1u << 18)
__device__ __forceinline__ unsigned xb_ld(unsigned* p)              { return __hip_atomic_load(p, __ATOMIC_RELAXED, __HIP_MEMORY_SCOPE_AGENT); }
__device__ __forceinline__ unsigned xb_add(unsigned* p, unsigned v) { return __hip_atomic_fetch_add(p, v, __ATOMIC_RELAXED, __HIP_MEMORY_SCOPE_AGENT); }
__device__ __forceinline__ unsigned xb_xcc_id() { return (unsigned)__builtin_amdgcn_s_getreg((3 << 11) | 20) & 0xFu; }
#define XB_SPIN(cond, bar) do { unsigned _sp = 0; while (cond) { __builtin_amdgcn_s_sleep(1); \
    if ((++_sp & 255u) == 0u) { if (xb_ld(&(bar)[XB_TMO])) break; if (_sp > XB_SPIN_CAP) { atomicAdd(&(bar)[XB_TMO], 1u); break; } } } } while (0)
struct XcdBarrier { unsigned* bar; unsigned x; volatile LAS unsigned* st; };
__device__ __forceinline__ XcdBarrier xcd_barrier_post(unsigned* bar, volatile LAS unsigned* st) {
    XcdBarrier b; b.bar = bar; b.x = xb_xcc_id(); b.st = st;
    if (threadIdx.x == 0) (void)xb_add(&bar[XB_XCNT(b.x)], 1u);
    return b;
}
__device__ __forceinline__ void xcd_barrier_complete(unsigned* bar, unsigned x, unsigned& nloc, unsigned& nx) {
    const unsigned G = gridDim.x * gridDim.y * gridDim.z;
    unsigned sum, cnt, mine, sp = 0u;
    for (;;) {
        sum = 0u; cnt = 0u; mine = 0u;
#pragma unroll
        for (unsigned j = 0; j < 16; ++j) { const unsigned c = xb_ld(&bar[XB_XCNT(j)]); sum += c; cnt += (c > 0u) ? 1u : 0u; mine = (j == x) ? c : mine; }
        if (sum == G) break;
        __builtin_amdgcn_s_sleep(1);
        if ((++sp & 255u) == 0u) { if (xb_ld(&bar[XB_TMO])) break; if (sp > XB_SPIN_CAP) { atomicAdd(&bar[XB_TMO], 1u); break; } }
    }
    nloc = mine > 0u ? mine : 1u; nx = cnt > 0u ? cnt : 1u;
}
__device__ __forceinline__ void xcd_barrier(const XcdBarrier& b) {
    asm volatile("s_waitcnt vmcnt(0)" ::: "memory");
    __syncthreads();
    if (threadIdx.x == 0) {
        unsigned* bar = b.bar;
        __builtin_amdgcn_s_waitcnt(0);
        unsigned nloc = b.st[0], nx = b.st[1];
        if (nloc == 0u) { xcd_barrier_complete(bar, b.x, nloc, nx); b.st[0] = nloc; b.st[1] = nx; }
        const unsigned old = xb_add(&bar[XB_XSUB(b.x)], 1u);
        const unsigned gen = old / nloc;
        if (old + 1u == (gen + 1u) * nloc) {
            __builtin_amdgcn_fence(__ATOMIC_RELEASE, "agent");
            asm volatile("s_waitcnt vmcnt(0)" ::: "memory");
            const unsigned og = xb_add(&bar[XB_TOP], 1u);
            const unsigned tg = og / nx;
            if (og + 1u == (tg + 1u) * nx) xb_add(&bar[XB_TOPGEN], 1u);
            else XB_SPIN(xb_ld(&bar[XB_TOPGEN]) == tg, bar);
            __builtin_amdgcn_fence(__ATOMIC_ACQUIRE, "agent");
            xb_add(&bar[XB_XGEN(b.x)], 1u);
            asm volatile("s_waitcnt vmcnt(0)" ::: "memory");
        } else {
            XB_SPIN(xb_ld(&bar[XB_XGEN(b.x)]) == gen, bar);
            __builtin_amdgcn_fence(__ATOMIC_ACQUIRE, "agent");
            asm volatile("s_waitcnt vmcnt(0)" ::: "memory");
        }
    }
    __syncthreads();
}

struct Frame {
    LAS unsigned char* lds;
    int tid, lane, wave, vcu, G;
    const float* in[27];
    float* out; unsigned char* ws;
};
enum { I_X = 0, I_C, I_CTX, I_CCTX, I_WMOD, I_BMOD, I_NORMG, I_FINALG, I_F1IN, I_F1OUT, I_F2IN, I_F2OUT, I_WIN, I_LRE, I_LIM, I_LSTEP, I_BRE, I_BIM, I_CRE, I_CIM, I_SD, I_WGLU, I_WBA, I_POOLW, I_POOLS, I_WBB, I_WOUT };

__device__ __forceinline__ float wave_sum(float v) {
#pragma unroll
    for (int o = 1; o < 64; o <<= 1) v += __shfl_xor(v, o);
    return v;
}

using pg8::Unit; using pg8::BM; using pg8::HALF;
template <int MODE> struct EpiGated {
    static constexpr bool PERM = true;
    bf16* O; int ldo;
    __device__ __forceinline__ void operator()(const f32x4 (&acc)[2][2][4][2], const Unit& u, int wr, int wc, int fr, int fq) const {
        const int row0 = u.pm * BM + wr * 64 + fr, col0 = u.pn * HALF + wc * 32 + 8 * fq;
#pragma unroll
        for (int ai = 0; ai < 2; ++ai)
#pragma unroll
            for (int m = 0; m < 4; ++m) {
                float o[8];
#pragma unroll
                for (int n = 0; n < 2; ++n)
#pragma unroll
                    for (int j = 0; j < 4; ++j) { const float a = acc[ai][0][m][n][j], b = acc[ai][1][m][n][j];
                        o[n * 4 + j] = MODE == 0 ? a * sigmoidf_fast(a) * b : a * sigmoidf_fast(b); }
                v4u w; w.x = cvt_pk_bf16(o[0], o[1]); w.y = cvt_pk_bf16(o[2], o[3]); w.z = cvt_pk_bf16(o[4], o[5]); w.w = cvt_pk_bf16(o[6], o[7]);
                *(v4u*)(O + (size_t)(row0 + ai * HALF + m * 16) * ldo + col0) = w;
            }
    }
};
template <bool IN_BF16, bool OUT_BF16> struct EpiResid {
    static constexpr bool PERM = true;
    const void* in_lat; const float* in_ctx; void* X; const float* mod; int gidx; float coef; float* part;
    __device__ __forceinline__ void operator()(const f32x4 (&acc)[2][2][4][2], const Unit& u, int wr, int wc, int fr, int fq) const {
        const int row0 = u.pm * BM + wr * 64 + fr, col0 = u.pn * BM + wc * 32 + 8 * fq;
        if (u.g != 0) {
#pragma unroll
            for (int ai = 0; ai < 2; ++ai)
#pragma unroll
                for (int m = 0; m < 4; ++m) { float* rowp = part + ((size_t)(u.g - 1) * MC + (size_t)(row0 + ai * HALF + m * 16 - ML)) * D + col0;
#pragma unroll
                    for (int bj = 0; bj < 2; ++bj) { *(f32x4*)(rowp + bj * HALF) = acc[ai][bj][m][0]; *(f32x4*)(rowp + bj * HALF + 4) = acc[ai][bj][m][1]; } }
            return;
        }
        const bool isctx = u.pm >= ML / BM; const int mi = isctx ? 4 : (u.pm >> 4);
        const float* gp = mod + (size_t)mi * (NMOD * D) + (size_t)gidx * D + col0;
        f32x4 gv[2][2];
#pragma unroll
        for (int bj = 0; bj < 2; ++bj)
#pragma unroll
            for (int n = 0; n < 2; ++n) gv[bj][n] = *(const f32x4*)(gp + bj * HALF + 4 * n) * coef;
        const float* srcf = isctx ? in_ctx - (size_t)ML * D : (const float*)in_lat; const bf16* srcb = (const bf16*)in_lat;
#pragma unroll
        for (int ai = 0; ai < 2; ++ai) {
            f32x4 xi[4][2][2]; v4u xb[4][2];
#pragma unroll
            for (int m = 0; m < 4; ++m) { const size_t off = (size_t)(row0 + ai * HALF + m * 16) * D + col0;
#pragma unroll
                for (int bj = 0; bj < 2; ++bj) {
                    if constexpr (IN_BF16) xb[m][bj] = *(const v4u*)(srcb + off + bj * HALF);
                    else { xi[m][bj][0] = *(const f32x4*)(srcf + off + bj * HALF); xi[m][bj][1] = *(const f32x4*)(srcf + off + bj * HALF + 4); } } }
            asm volatile("" ::: "memory");
#pragma unroll
            for (int m = 0; m < 4; ++m) { const size_t off = (size_t)(row0 + ai * HALF + m * 16) * D + col0;
#pragma unroll
                for (int bj = 0; bj < 2; ++bj) {
                    f32x4 x0, x1;
                    if constexpr (IN_BF16) { const v4u w = xb[m][bj]; x0 = (f32x4){bf_lo(w.x), bf_hi(w.x), bf_lo(w.y), bf_hi(w.y)}; x1 = (f32x4){bf_lo(w.z), bf_hi(w.z), bf_lo(w.w), bf_hi(w.w)}; }
                    else { x0 = xi[m][bj][0]; x1 = xi[m][bj][1]; }
                    const f32x4 o0 = x0 + gv[bj][0] * acc[ai][bj][m][0], o1 = x1 + gv[bj][1] * acc[ai][bj][m][1];
                    if constexpr (OUT_BF16) { v4u w; w.x = cvt_pk_bf16(o0.x, o0.y); w.y = cvt_pk_bf16(o0.z, o0.w); w.z = cvt_pk_bf16(o1.x, o1.y); w.w = cvt_pk_bf16(o1.z, o1.w);
                        *(v4u*)((bf16*)X + off + bj * HALF) = w; }
                    else { *(f32x4*)((float*)X + off + bj * HALF) = o0; *(f32x4*)((float*)X + off + bj * HALF + 4) = o1; } } }
            asm volatile("" ::: "memory");
        }
    }
};
struct EpiWin {
    static constexpr bool PERM = true;
    bf16* A2; float* USCP; bf16* UP; bf16* GT;
    __device__ __forceinline__ void operator()(const f32x4 (&acc)[2][2][4][2], const Unit& u, int wr, int wc, int fr, int fq) const {
        const int row0 = u.pm * BM + wr * 64 + fr;
        if (u.g != 0) {
#pragma unroll
            for (int ai = 0; ai < 2; ++ai)
#pragma unroll
                for (int m = 0; m < 4; ++m) { float* rowp = USCP + ((size_t)(u.g - 1) * MC + (size_t)(row0 + ai * HALF + m * 16 - ML)) * SW + u.pn * BM + wc * 32 + 8 * fq;
#pragma unroll
                    for (int bj = 0; bj < 2; ++bj) { *(f32x4*)(rowp + bj * HALF) = acc[ai][bj][m][0]; *(f32x4*)(rowp + bj * HALF + 4) = acc[ai][bj][m][1]; } }
            return;
        }
#pragma unroll
        for (int ai = 0; ai < 2; ++ai)
#pragma unroll
            for (int m = 0; m < 4; ++m) { const int row = row0 + ai * HALF + m * 16;
#pragma unroll
                for (int bj = 0; bj < 2; ++bj) {
                    const int cl = bj * HALF + wc * 32 + 8 * fq;
                    f32x4 v0 = acc[ai][bj][m][0], v1 = acc[ai][bj][m][1];
                    bf16* dst;
                    if (u.pn < 4) {
                        const int c = u.pn * BM + cl;
                        { const int b = row >> 12, t = row & 4095, g = c >> 4, k0 = c & 15;
                               dst = A2 + ((size_t)(g * A2R + b * NCH + (t >> 5)) * A2K + (t & 31) * SK + k0); }
                    } else if (u.pn < 12) {
                        const int ch = (u.pn - 4) * BM + cl, b = row >> 12, t = row & 4095;
                        dst = UP + ((size_t)((b * 256 + (ch >> 3)) * SEQ + t) * 8);
                    } else {
#pragma unroll
                        for (int j = 0; j < 4; ++j) { v0[j] = sigmoidf_fast(v0[j]); v1[j] = sigmoidf_fast(v1[j]); }
                        dst = GT + (size_t)row * (2 * D) + (u.pn - 12) * BM + cl;
                    }
                    v4u w; w.x = cvt_pk_bf16(v0[0], v0[1]); w.y = cvt_pk_bf16(v0[2], v0[3]); w.z = cvt_pk_bf16(v1[0], v1[1]); w.w = cvt_pk_bf16(v1[2], v1[3]);
                    *(v4u*)dst = w; } }
    }
};
struct EpiF32G {
    static constexpr bool PERM = false;
    float* C; int ldc; size_t gs;
    __device__ __forceinline__ void operator()(const f32x4 (&acc)[2][2][4][2], const Unit& u, int wr, int wc, int fr, int fq) const {
        const int row0 = u.pm * BM + wr * 64 + fr, col0 = u.pn * BM + wc * 32 + 4 * fq;
#pragma unroll
        for (int ai = 0; ai < 2; ++ai)
#pragma unroll
            for (int m = 0; m < 4; ++m) { float* rowp = C + (size_t)u.g * gs + (size_t)(row0 + ai * HALF + m * 16) * ldc + col0;
#pragma unroll
                for (int bj = 0; bj < 2; ++bj)
#pragma unroll
                    for (int n = 0; n < 2; ++n) *(f32x4*)(rowp + bj * HALF + n * 16) = acc[ai][bj][m][n]; }
    }
};
__device__ __forceinline__ float gelu_tanh(float x) { const float u2 = 1.5957691216f * (x + 0.044715f * x * x * x); return x * sigmoidf_fast(u2); }
struct EpiY {
    static constexpr bool PERM = true;
    bf16* Z;
    __device__ __forceinline__ void operator()(const f32x4 (&acc)[2][2][4][2], const Unit& u, int wr, int wc, int fr, int fq) const {
        const int row0 = u.pm * BM + wr * 64 + fr;
#pragma unroll
        for (int ai = 0; ai < 2; ++ai)
#pragma unroll
            for (int m = 0; m < 4; ++m) { const int R = row0 + ai * HALF + m * 16, b = R >> 7, cc = R & 127;
#pragma unroll
                for (int bj = 0; bj < 2; ++bj) { const int n_ = u.pn * BM + bj * HALF + wc * 32 + 8 * fq, tl = n_ >> 4, k0 = n_ & 15;
                    float o[8];
#pragma unroll
                    for (int n = 0; n < 2; ++n)
#pragma unroll
                        for (int j = 0; j < 4; ++j) o[n * 4 + j] = gelu_tanh(acc[ai][bj][m][n][j]);
                    v4u w; w.x = cvt_pk_bf16(o[0], o[1]); w.y = cvt_pk_bf16(o[2], o[3]); w.z = cvt_pk_bf16(o[4], o[5]); w.w = cvt_pk_bf16(o[6], o[7]);
                    *(v4u*)(Z + (size_t)(b * SEQ + cc * CT + tl) * SW + u.g * SK + k0) = w; } }
    }
};
struct EpiPool {
    static constexpr bool PERM = true;
    bf16* YB; const float* scale;
    __device__ __forceinline__ void operator()(const f32x4 (&acc)[2][2][4][2], const Unit& u, int wr, int wc, int fr, int fq) const {
        const int row0 = u.pm * BM + wr * 64 + fr, col0 = u.g * 512 + u.pn * BM + wc * 32 + 8 * fq;
        f32x4 sv[2][2];
#pragma unroll
        for (int bj = 0; bj < 2; ++bj)
#pragma unroll
            for (int n = 0; n < 2; ++n) sv[bj][n] = *(const f32x4*)(scale + col0 + bj * HALF + 4 * n);
#pragma unroll
        for (int ai = 0; ai < 2; ++ai)
#pragma unroll
            for (int m = 0; m < 4; ++m) { bf16* rowp = YB + (size_t)(row0 + ai * HALF + m * 16) * PW_ + col0;
#pragma unroll
                for (int bj = 0; bj < 2; ++bj) { const f32x4 v0 = acc[ai][bj][m][0] * sv[bj][0], v1 = acc[ai][bj][m][1] * sv[bj][1];
                    v4u w; w.x = cvt_pk_bf16(v0[0], v0[1]); w.y = cvt_pk_bf16(v0[2], v0[3]); w.z = cvt_pk_bf16(v1[0], v1[1]); w.w = cvt_pk_bf16(v1[2], v1[3]);
                    *(v4u*)(rowp + bj * HALF) = w; } }
    }
};
template <bool ADD> struct EpiBranch {
    static constexpr bool PERM = true;
    bf16* T; const bf16* GT; int goff;
    __device__ __forceinline__ void operator()(const f32x4 (&acc)[2][2][4][2], const Unit& u, int wr, int wc, int fr, int fq) const {
        const int row0 = u.pm * BM + wr * 64 + fr, col0 = u.pn * BM + wc * 32 + 8 * fq;
#pragma unroll
        for (int ai = 0; ai < 2; ++ai) {
            v4u gws[4][2], tws[4][2];
#pragma unroll
            for (int m = 0; m < 4; ++m) { const size_t row = (size_t)(row0 + ai * HALF + m * 16);
#pragma unroll
                for (int bj = 0; bj < 2; ++bj) { gws[m][bj] = *(const v4u*)(GT + row * (2 * D) + goff + col0 + bj * HALF);
                    if (ADD) tws[m][bj] = *(const v4u*)(T + row * D + col0 + bj * HALF); else tws[m][bj] = (v4u){0u, 0u, 0u, 0u}; } }
            asm volatile("" ::: "memory");
#pragma unroll
            for (int m = 0; m < 4; ++m) { const size_t row = (size_t)(row0 + ai * HALF + m * 16);
#pragma unroll
                for (int bj = 0; bj < 2; ++bj) {
                    const v4u gw = gws[m][bj]; const v4u tw = tws[m][bj];
                    bf16* tp = T + row * D + col0 + bj * HALF;
                    float o[8]; const f32x4 v0 = acc[ai][bj][m][0], v1 = acc[ai][bj][m][1];
                    o[0] = bf_lo(gw.x) * v0[0]; o[1] = bf_hi(gw.x) * v0[1]; o[2] = bf_lo(gw.y) * v0[2]; o[3] = bf_hi(gw.y) * v0[3];
                    o[4] = bf_lo(gw.z) * v1[0]; o[5] = bf_hi(gw.z) * v1[1]; o[6] = bf_lo(gw.w) * v1[2]; o[7] = bf_hi(gw.w) * v1[3];
                    if (ADD) { o[0] += bf_lo(tw.x); o[1] += bf_hi(tw.x); o[2] += bf_lo(tw.y); o[3] += bf_hi(tw.y); o[4] += bf_lo(tw.z); o[5] += bf_hi(tw.z); o[6] += bf_lo(tw.w); o[7] += bf_hi(tw.w); }
                    v4u w; w.x = cvt_pk_bf16(o[0], o[1]); w.y = cvt_pk_bf16(o[2], o[3]); w.z = cvt_pk_bf16(o[4], o[5]); w.w = cvt_pk_bf16(o[6], o[7]);
                    *(v4u*)tp = w; } }
            asm volatile("" ::: "memory");
        }
    }
};

__device__ __forceinline__ void p0_mod(Frame& F) {
    LAS float* sc = (LAS float*)(F.lds);
    LAS float* red = (LAS float*)(F.lds + 81920);
    const float* c = F.in[I_C]; const float* cctx = F.in[I_CCTX]; const float* wmod = F.in[I_WMOD]; const float* bmod = F.in[I_BMOD];
    float* mod = (float*)(F.ws + WS_MOD);
    for (int i = F.tid; i < 5 * D; i += NWAVES * 64) { const int v = i >> 12, k = i & (D - 1); const float x = v < 4 ? c[v * D + k] : cctx[k]; sc[i] = x * sigmoidf_fast(x); }
    __syncthreads();
    const int col4 = F.tid % 36, ksub = F.tid / 36;
    for (int chunk = blockIdx.x; chunk < 256; chunk += F.G) {
        float acc[5][4];
#pragma unroll
        for (int v = 0; v < 5; ++v)
#pragma unroll
            for (int e = 0; e < 4; ++e) acc[v][e] = 0.f;
        if (ksub < 14) {
            const float* wp = wmod + (size_t)chunk * 144 + col4 * 4 + (size_t)ksub * (NMOD * D);
            constexpr size_t KSTR = (size_t)14 * NMOD * D;
            int k = ksub;
            for (; k + 15 * 14 < D; k += 16 * 14) {
                f32x4 w[16];
#pragma unroll
                for (int i = 0; i < 16; ++i) { w[i] = __builtin_nontemporal_load((const f32x4*)wp); wp += KSTR; }
#pragma unroll
                for (int i = 0; i < 16; ++i)
#pragma unroll
                    for (int v = 0; v < 5; ++v) { const float sv = sc[v * D + k + 14 * i];
#pragma unroll
                        for (int e = 0; e < 4; ++e) acc[v][e] += sv * w[i][e]; }
            }
            for (; k < D; k += 14) { const f32x4 w = __builtin_nontemporal_load((const f32x4*)wp); wp += KSTR;
#pragma unroll
                for (int v = 0; v < 5; ++v) { const float sv = sc[v * D + k];
#pragma unroll
                    for (int e = 0; e < 4; ++e) acc[v][e] += sv * w[e]; } }
#pragma unroll
            for (int v = 0; v < 5; ++v)
#pragma unroll
                for (int e = 0; e < 4; ++e) red[(ksub * 36 + col4) * 20 + v * 4 + e] = acc[v][e];
        }
        __syncthreads();
        for (int o = F.tid; o < 720; o += NWAVES * 64) { const int v = o / 144, cl = o % 144; float s = bmod[chunk * 144 + cl];
#pragma unroll
            for (int q = 0; q < 14; ++q) s += red[(q * 36 + (cl >> 2)) * 20 + v * 4 + (cl & 3)];
            mod[(size_t)v * (NMOD * D) + chunk * 144 + cl] = s; }
        __syncthreads();
    }
}

__device__ __forceinline__ void p0_transpose_item(const float* W, int N, bf16* WT, int ldt, int dst_row0, LAS float* scr, int k0, int n0, int lane) {
    f32x4 v[16];
    const float* src = W + (size_t)(k0 + (lane >> 4)) * N + n0 + (lane & 15) * 4;
#pragma unroll
    for (int i = 0; i < 16; ++i) v[i] = __builtin_nontemporal_load((const f32x4*)(src + (size_t)(4 * i) * N));
#pragma unroll
    for (int i = 0; i < 16; ++i) { LAS float* d = scr + (4 * i + (lane >> 4)) * 65 + (lane & 15) * 4; d[0] = v[i].x; d[1] = v[i].y; d[2] = v[i].z; d[3] = v[i].w; }
    LDS_WAIT(); asm volatile("" ::: "memory");
    const int c = lane >> 3, nn = lane & 7;
#pragma unroll
    for (int j = 0; j < 8; ++j) { const int n = nn + 8 * j; const LAS float* s = scr + (8 * c) * 65 + n;
        v4u o; o.x = cvt_pk_bf16(s[0 * 65], s[1 * 65]); o.y = cvt_pk_bf16(s[2 * 65], s[3 * 65]); o.z = cvt_pk_bf16(s[4 * 65], s[5 * 65]); o.w = cvt_pk_bf16(s[6 * 65], s[7 * 65]);
        __builtin_nontemporal_store(o, (GAS v4u*)(WT + (size_t)(dst_row0 + n) * ldt + k0 + 8 * c)); }
    LDS_WAIT(); asm volatile("" ::: "memory");
}
constexpr int IT_FA = (D / 64) * (2 * DFF / 64), IT_FB = (DFF / 64) * (D / 64), IT_WIN = (D / 64) * (DIN / 64), IT_GLU = (SW / 64) * (2 * SW / 64), IT_WA = (SW / 64) * (D / 64),
              IT_POOL = 4 * (512 / 64) * (512 / 64), IT_WB = (PW_ / 64) * (D / 64), IT_WOUT = (D / 64) * (D / 64);
constexpr int Q_W1A = IT_FA, Q_W1B = Q_W1A + IT_FB, Q_WIN = Q_W1B + IT_WIN, Q_POOL = Q_WIN + IT_POOL, Q_WB = Q_POOL + IT_WB, Q_GLU = Q_WB + IT_GLU, Q_WA = Q_GLU + IT_WA,
              Q_WOUT = Q_WA + IT_WOUT, Q_W2A = Q_WOUT + IT_FA, Q_W2B = Q_W2A + IT_FB;
constexpr int IT_TOTAL = Q_W2B;
__device__ __forceinline__ int gated_row(int n0, int half) { const int j = n0 < half ? n0 : n0 - half; return (j >> 7) * 256 + (j & 127) + (n0 < half ? 0 : 128); }
__device__ __forceinline__ void p0_one_item(Frame& F, int r, LAS float* scr) {
    unsigned char* ws = F.ws; const int lane = F.lane;
#define TR_PLAIN(W, Kd, Nd, WT) do { const int nblk = (Nd) / 64, kb = r / nblk, nb = r % nblk; p0_transpose_item(W, Nd, (bf16*)(WT), Kd, 64 * nb, scr, 64 * kb, 64 * nb, lane); } while (0)
#define TR_GATED(W, Kd, Nd, WT) do { const int nblk = (Nd) / 64, kb = r / nblk, nb = r % nblk; p0_transpose_item(W, Nd, (bf16*)(WT), Kd, gated_row(64 * nb, (Nd) / 2), scr, 64 * kb, 64 * nb, lane); } while (0)
    if (r < IT_FA) { TR_GATED(F.in[I_F1IN], D, 2 * DFF, ws + WS_W1A); return; } r -= IT_FA;
    if (r < IT_FB) { TR_PLAIN(F.in[I_F1OUT], DFF, D, ws + WS_W1B); return; } r -= IT_FB;
    if (r < IT_WIN) { TR_PLAIN(F.in[I_WIN], D, DIN, ws + WS_WIN); return; } r -= IT_WIN;
    if (r < IT_POOL) { const int gi = r / 64; r %= 64; TR_PLAIN(F.in[I_POOLW] + (size_t)gi * 512 * 512, 512, 512, ws + WS_WPOOL + (size_t)gi * 512 * 512 * 2); return; } r -= IT_POOL;
    if (r < IT_WB) { TR_PLAIN(F.in[I_WBB], PW_, D, ws + WS_WB); return; } r -= IT_WB;
    if (r < IT_GLU) { TR_GATED(F.in[I_WGLU], SW, 2 * SW, ws + WS_WGLU); return; } r -= IT_GLU;
    if (r < IT_WA) { TR_PLAIN(F.in[I_WBA], SW, D, ws + WS_WA); return; } r -= IT_WA;
    if (r < IT_WOUT) { TR_PLAIN(F.in[I_WOUT], D, D, ws + WS_WOUT); return; } r -= IT_WOUT;
    if (r < IT_FA) { TR_GATED(F.in[I_F2IN], D, 2 * DFF, ws + WS_W2A); return; } r -= IT_FA;
    TR_PLAIN(F.in[I_F2OUT], DFF, D, ws + WS_W2B);
#undef TR_PLAIN
#undef TR_GATED
}
__device__ __forceinline__ bool fill_transposes(Frame& F, int mandatory, unsigned* done_ctr) {
    LAS float* scr = (LAS float*)(F.lds + F.wave * 16640);
    volatile LAS int* sh = (volatile LAS int*)(F.lds + MISC_OFF + 64);
    unsigned* q = (unsigned*)(F.ws + WS_CTL) + CW_QUEUE;
    constexpr int PER_WAVE = 2, CHB = PER_WAVE * NWAVES;
    for (;;) {
        if (F.tid == 0) { int base = -1; const int head = (int)__hip_atomic_load(q, __ATOMIC_RELAXED, __HIP_MEMORY_SCOPE_AGENT);
            const bool go = head < mandatory || (head < IT_TOTAL && done_ctr != nullptr && __hip_atomic_load(done_ctr, __ATOMIC_RELAXED, __HIP_MEMORY_SCOPE_AGENT) < (unsigned)F.G);
            if (go) { base = (int)__hip_atomic_fetch_add(q, (unsigned)CHB, __ATOMIC_RELAXED, __HIP_MEMORY_SCOPE_AGENT); if (base >= IT_TOTAL) base = -2; }
            else if (head >= IT_TOTAL) base = -2;
            sh[0] = base; }
        __syncthreads();
        const int base = sh[0];
        __syncthreads();
        if (base < 0) return base == -2;
        const int b0 = base + F.wave * PER_WAVE, end = b0 + PER_WAVE < IT_TOTAL ? b0 + PER_WAVE : IT_TOTAL;
        for (int it = b0; it < end; ++it) p0_one_item(F, it, scr);
    }
}
__device__ __forceinline__ void phase_done(Frame& F, unsigned* done_ctr) {
    __syncthreads();
    if (F.tid == 0) __hip_atomic_fetch_add(done_ctr, 1u, __ATOMIC_RELAXED, __HIP_MEMORY_SCOPE_AGENT);
}

typedef float f32x2 __attribute__((ext_vector_type(2)));
constexpr int KFS = 272;
__device__ __forceinline__ void p0_ssm_part(Frame& F, int g, int part) {
    LAS f32x2* PWR = (LAS f32x2*)(F.lds);
    LAS f32x2* BB = (LAS f32x2*)(F.lds + 33792);
    LAS f32x2* CC = (LAS f32x2*)(F.lds + 33792 + 16384);
    LAS float* KF = (LAS float*)(F.lds + 33792 + 32768);
    const int tid = F.tid;
    if (tid < 128) {
        const int dir = tid >> 6, p = tid & 63, idx = (dir * SG + g) * SP + p;
        const double lr = fmin((double)F.in[I_LRE][idx], -1e-4), li = (double)F.in[I_LIM][idx], st = exp((double)F.in[I_LSTEP][dir * SG + g]);
        const double mag = exp(lr * st), ang = li * st, lbr = mag * cos(ang), lbi = mag * sin(ang);
        const double nr = lbr - 1.0, ni = lbi, den = lr * lr + li * li, fr_ = (nr * lr + ni * li) / den, fi_ = (ni * lr - nr * li) / den;
        double pr = 1.0, pi = 0.0;
        for (int tau = 0; tau <= CT; ++tau) { PWR[(dir * SP + p) * 33 + tau] = (f32x2){(float)pr, (float)pi}; const double t = pr * lbr - pi * lbi; pi = pr * lbi + pi * lbr; pr = t; }
        f32x2* bbar = (f32x2*)(F.ws + WS_BBAR);
        for (int k = 0; k < SK; ++k) { const double br = (double)F.in[I_BRE][idx * SK + k], bi = (double)F.in[I_BIM][idx * SK + k];
            const f32x2 bb = (f32x2){(float)(fr_ * br - fi_ * bi), (float)(fr_ * bi + fi_ * br)}; BB[(dir * SP + p) * SK + k] = bb; if (part == 0) bbar[(size_t)idx * SK + k] = bb; }
        if (part == 0) { f32x2* lamb = (f32x2*)(F.ws + WS_LAMB); f32x2* lamT = (f32x2*)(F.ws + WS_LAMB + 65536);
            lamb[idx] = (f32x2){(float)lbr, (float)lbi}; lamT[idx] = PWR[(dir * SP + p) * 33 + CT]; }
    }
    for (int o = tid; o < 2048; o += NWAVES * 64) { const int dir = o >> 10, k = (o >> 6) & 15, p = o & 63, cidx = ((dir * SG + g) * SK + k) * SP + p; CC[(dir * SP + p) * SK + k] = (f32x2){F.in[I_CRE][cidx], F.in[I_CIM][cidx]}; }
    __syncthreads();
    for (int combo = tid; combo < 1024; combo += NWAVES * 64) { const int dir = combo >> 9, tau = (combo >> 4) & 31, k = combo & 15;
        float a[16];
#pragma unroll
        for (int e = 0; e < 16; ++e) a[e] = 0.f;
        for (int p = 0; p < SP; ++p) { const f32x2 c = CC[(dir * SP + p) * SK + k], w = PWR[(dir * SP + p) * 33 + tau]; const float gr = c.x * w.x - c.y * w.y, gi = c.x * w.y + c.y * w.x;
#pragma unroll
            for (int e = 0; e < 16; ++e) { const f32x2 b = BB[(dir * SP + p) * SK + e]; a[e] += gr * b.x - gi * b.y; } }
#pragma unroll
        for (int e = 0; e < 16; ++e) KF[(dir * CT + tau) * KFS + k * SK + e] = a[e]; }
    __syncthreads();
    bf16* bty = (bf16*)(F.ws + WS_BTY) + (size_t)g * (CT * SK) * A2K;
    const float* dvec = F.in[I_SD] + g * SK;
    for (int ch = tid; ch < 128 * (A2K / 8); ch += NWAVES * 64) { const int n = part * 128 + ch / (A2K / 8), q = ch % (A2K / 8), t = n >> 4, k = n & 15;
        float v[8];
        if (q < 64) { const int s = q >> 1, k0 = (q & 1) * 8;
            f32x4 x0 = (f32x4){0.f, 0.f, 0.f, 0.f}, x1 = x0;
            if (t >= s) { const LAS f32x4* kp = (const LAS f32x4*)(KF + (t - s) * KFS + k * SK + k0); x0 += kp[0]; x1 += kp[1]; }
            if (s >= t) { const LAS f32x4* kp = (const LAS f32x4*)(KF + (CT + (s - t)) * KFS + k * SK + k0); x0 += kp[0]; x1 += kp[1]; }
            v[0] = x0.x; v[1] = x0.y; v[2] = x0.z; v[3] = x0.w; v[4] = x1.x; v[5] = x1.y; v[6] = x1.z; v[7] = x1.w;
            if (t == s && (k >> 3) == (q & 1)) { const float dk = dvec[k];
#pragma unroll
                for (int e = 0; e < 8; ++e) v[e] += ((k & 7) == e) ? dk : 0.f; }
        } else { const int pt = (q - 64) >> 3, p0 = ((q - 64) & 7) * 8, dir = pt >> 1, tau = dir == 0 ? t + 1 : CT - t;
#pragma unroll
            for (int e = 0; e < 8; ++e) { const int p = p0 + e; const f32x2 c = CC[(dir * SP + p) * SK + k], w = PWR[(dir * SP + p) * 33 + tau];
                const float re = c.x * w.x - c.y * w.y, im = c.x * w.y + c.y * w.x; v[e] = (pt & 1) ? -im : re; }
        }
        v4u o; o.x = cvt_pk_bf16(v[0], v[1]); o.y = cvt_pk_bf16(v[2], v[3]); o.z = cvt_pk_bf16(v[4], v[5]); o.w = cvt_pk_bf16(v[6], v[7]);
        *(v4u*)(bty + (size_t)n * A2K + q * 8) = o; }
    bf16* bts = (bf16*)(F.ws + WS_BTS) + (size_t)g * 256 * (CT * SK);
    for (int ch = tid; ch < 64 * 64; ch += NWAVES * 64) { const int p = ch >> 6, q = ch & 63, pt = part, n = pt * 64 + p, dir = pt >> 1, s = q >> 1, k0 = (q & 1) * 8, tau = dir == 0 ? CT - 1 - s : s;
        const f32x2 w = PWR[(dir * SP + p) * 33 + tau]; float v[8];
#pragma unroll
        for (int e = 0; e < 8; ++e) { const f32x2 b = BB[(dir * SP + p) * SK + k0 + e]; const float re = w.x * b.x - w.y * b.y, im = w.x * b.y + w.y * b.x; v[e] = (pt & 1) ? im : re; }
        v4u o; o.x = cvt_pk_bf16(v[0], v[1]); o.y = cvt_pk_bf16(v[2], v[3]); o.z = cvt_pk_bf16(v[4], v[5]); o.w = cvt_pk_bf16(v[6], v[7]);
        *(v4u*)(bts + (size_t)n * (CT * SK) + q * 8) = o; }
    __syncthreads();
}

template <bool FINAL, bool CTXSUM = false>
__device__ __forceinline__ void norm_rows(Frame& F, const float* in_lat, const float* in_ctx, int nrows, const float* gvec, int shift_idx, int scale_idx, bf16* outb, float* outf, const float* part = nullptr) {
    const int gw = F.vcu * NWAVES + F.wave, NGW = F.G * NWAVES;
    const float* mod = (const float*)(F.ws + WS_MOD);
    for (int m = gw; m < nrows; m += NGW) {
        const bool isctx = m >= ML; const int mi = isctx ? 4 : (m >> 12);
        const f32x4* xr = (const f32x4*)(isctx ? in_ctx + (size_t)(m - ML) * D : in_lat + (size_t)m * D) + F.lane;
        f32x4 v[16]; float ss = 0.f;
        if (CTXSUM && isctx) {
            const f32x4* p0 = (const f32x4*)(part + (size_t)(m - ML) * D) + F.lane;
#pragma unroll
            for (int j = 0; j < 16; ++j) v[j] = p0[64 * j];
#pragma unroll
            for (int sp = 1; sp < 4; ++sp) { const f32x4* ps = p0 + (size_t)sp * MC * (D / 4);
#pragma unroll
                for (int j = 0; j < 16; ++j) v[j] += ps[64 * j]; }
            const f32x4* gt = (const f32x4*)(mod + (size_t)4 * (NMOD * D) + (size_t)2 * D) + F.lane;
#pragma unroll
            for (int j = 0; j < 16; ++j) v[j] = xr[64 * j] + (gt[64 * j] * 0.5f) * v[j];
#pragma unroll
            for (int j = 0; j < 16; ++j) ss += (v[j].x * v[j].x + v[j].y * v[j].y) + (v[j].z * v[j].z + v[j].w * v[j].w);
        } else {
#pragma unroll
        for (int j = 0; j < 16; ++j) { v[j] = xr[64 * j]; ss += (v[j].x * v[j].x + v[j].y * v[j].y) + (v[j].z * v[j].z + v[j].w * v[j].w); }
        }
        const float rstd = 1.0f / sqrtf(wave_sum(ss) * (1.0f / D) + RMS_EPS);
        const f32x4* gp = (const f32x4*)gvec + F.lane;
        if constexpr (FINAL) {
            f32x4* op = (f32x4*)(outf + (size_t)m * D) + F.lane;
#pragma unroll
            for (int j = 0; j < 16; ++j) op[64 * j] = v[j] * rstd * gp[64 * j];
        } else {
            const f32x4* shp = (const f32x4*)(mod + (size_t)mi * (NMOD * D) + (size_t)shift_idx * D) + F.lane;
            const f32x4* scp = (const f32x4*)(mod + (size_t)mi * (NMOD * D) + (size_t)scale_idx * D) + F.lane;
            v2u* op = (v2u*)(outb + (size_t)m * D) + F.lane;
#pragma unroll
            for (int j = 0; j < 16; ++j) { const f32x4 o = (v[j] * rstd * gp[64 * j]) * (scp[64 * j] + 1.0f) + shp[64 * j];
                v2u w; w.x = cvt_pk_bf16(o.x, o.y); w.y = cvt_pk_bf16(o.z, o.w); op[64 * j] = w; }
        }
    }
}

template <bool FINAL>
__device__ __forceinline__ void norm_prep(Frame& F, LAS float* LA, LAS float* LB, const float* gvec, const float* mod, int mi, int shift_idx, int scale_idx) {
    for (int c = F.tid; c < D; c += NWAVES * 64) { const float g = gvec[c];
        if (FINAL) { LA[c] = g; LB[c] = 0.f; }
        else { LA[c] = g * (1.0f + mod[(size_t)mi * (NMOD * D) + (size_t)scale_idx * D + c]); LB[c] = mod[(size_t)mi * (NMOD * D) + (size_t)shift_idx * D + c]; } }
}
#define NIDX(j) (((j) >> 1) * 128 + ((j) & 1))
template <bool FINAL>
__device__ __forceinline__ void norm_row_out(Frame& F, const f32x4 (&v)[16], const LAS float* LA, const LAS float* LB, bf16* outb, float* outf, size_t m) {
    float ss = 0.f;
#pragma unroll
    for (int j = 0; j < 16; ++j) ss += (v[j].x * v[j].x + v[j].y * v[j].y) + (v[j].z * v[j].z + v[j].w * v[j].w);
    const float rstd = 1.0f / sqrtf(wave_sum(ss) * (1.0f / D) + RMS_EPS);
    const LAS f32x4* la = (const LAS f32x4*)LA + 2 * F.lane; const LAS f32x4* lb = (const LAS f32x4*)LB + 2 * F.lane;
    if constexpr (FINAL) { f32x4* op = (f32x4*)(outf + m * D) + 2 * F.lane;
#pragma unroll
        for (int j = 0; j < 16; ++j) op[NIDX(j)] = (v[j] * rstd) * la[NIDX(j)];
    } else { v4u* op = (v4u*)(outb + m * D) + F.lane;
#pragma unroll
        for (int jj = 0; jj < 8; ++jj) { const f32x4 o0 = (v[2 * jj] * rstd) * la[128 * jj] + lb[128 * jj], o1 = (v[2 * jj + 1] * rstd) * la[128 * jj + 1] + lb[128 * jj + 1];
            v4u w; w.x = cvt_pk_bf16(o0.x, o0.y); w.y = cvt_pk_bf16(o0.z, o0.w); w.z = cvt_pk_bf16(o1.x, o1.y); w.w = cvt_pk_bf16(o1.z, o1.w); op[64 * jj] = w; } }
}
template <bool FINAL, bool CTXSUM, bool IN_BF16 = false>
__device__ __forceinline__ void norm_phase(Frame& F, const void* in_lat_, const float* in_ctx, bool do_ctx, const float* gvec, int shift_idx, int scale_idx, bf16* outb, float* outf, const float* part) {
    LAS float* LA = (LAS float*)F.lds; LAS float* LB = LA + D;
    const float* mod = (const float*)(F.ws + WS_MOD);
    const int nb = F.G / 4, b = (int)blockIdx.x / nb, bi = (int)blockIdx.x % nb;
    norm_prep<FINAL>(F, LA, LB, gvec, mod, b, shift_idx, scale_idx);
    __syncthreads();
    {
        f32x4 va[16], vb[16];
        int k = F.wave;
#define NP_ROW(kk) ((size_t)b * SEQ + bi + (size_t)nb * (kk))
#define NP_VALID(kk) (bi + nb * (kk) < SEQ)
#define NP_LOAD(dst, kk) do { if constexpr (IN_BF16) { const v4u* xb_ = (const v4u*)((const bf16*)in_lat_ + NP_ROW(kk) * D) + F.lane; \
            _Pragma("unroll") for (int jj = 0; jj < 8; ++jj) { const v4u w_ = xb_[64 * jj]; dst[2 * jj] = (f32x4){bf_lo(w_.x), bf_hi(w_.x), bf_lo(w_.y), bf_hi(w_.y)}; dst[2 * jj + 1] = (f32x4){bf_lo(w_.z), bf_hi(w_.z), bf_lo(w_.w), bf_hi(w_.w)}; } } \
        else { const f32x4* xr_ = (const f32x4*)((const float*)in_lat_ + NP_ROW(kk) * D) + 2 * F.lane; _Pragma("unroll") for (int j = 0; j < 16; ++j) dst[j] = xr_[NIDX(j)]; } } while (0)
        if (NP_VALID(k)) {
            NP_LOAD(va, k);
            for (;;) {
                const int k2 = k + NWAVES; const bool has2 = NP_VALID(k2);
                if (has2) NP_LOAD(vb, k2);
                norm_row_out<FINAL>(F, va, LA, LB, outb, outf, NP_ROW(k));
                if (!has2) break;
                const int k3 = k2 + NWAVES; const bool has3 = NP_VALID(k3);
                if (has3) NP_LOAD(va, k3);
                norm_row_out<FINAL>(F, vb, LA, LB, outb, outf, NP_ROW(k2));
                if (!has3) break;
                k = k3;
            }
        }
#undef NP_ROW
#undef NP_VALID
#undef NP_LOAD
    }
    if (do_ctx) {
        __syncthreads();
        norm_prep<FINAL>(F, LA, LB, gvec, mod, 4, shift_idx, scale_idx);
        __syncthreads();
        for (int r = (int)blockIdx.x + F.G * F.wave; r < MC; r += F.G * NWAVES) {
            const f32x4* xr = (const f32x4*)(in_ctx + (size_t)r * D) + 2 * F.lane; f32x4 v[16];
            if constexpr (CTXSUM) {
                const f32x4* ps = (const f32x4*)(part + (size_t)r * D) + 2 * F.lane;
#pragma unroll
                for (int j = 0; j < 16; ++j) v[j] = (f32x4){0.f, 0.f, 0.f, 0.f};
#pragma unroll 1
                for (int sp = 0; sp < 4; ++sp) {
#pragma unroll
                    for (int j = 0; j < 16; ++j) v[j] += ps[NIDX(j)];
                    ps += (size_t)MC * (D / 4); }
                const f32x4* gt = (const f32x4*)(mod + (size_t)4 * (NMOD * D) + (size_t)2 * D) + 2 * F.lane;
#pragma unroll
                for (int j = 0; j < 16; ++j) v[j] = xr[NIDX(j)] + (gt[NIDX(j)] * 0.5f) * v[j];
            } else {
#pragma unroll
                for (int j = 0; j < 16; ++j) v[j] = xr[NIDX(j)];
            }
            norm_row_out<FINAL>(F, v, LA, LB, outb, outf, (size_t)ML + r);
        }
    }
    __syncthreads();
}

__device__ __forceinline__ void ctx_scan(Frame& F) {
    const f32x2* bbar = (const f32x2*)(F.ws + WS_BBAR); const f32x2* lamb = (const f32x2*)(F.ws + WS_LAMB); f32x2* hctx = (f32x2*)(F.ws + WS_LAMB + 131072);
    const float* uscp = (const float*)(F.ws + WS_Z);
    LAS float* LU = (LAS float*)F.lds;
    for (int bg = blockIdx.x; bg < BATCH * SG; bg += F.G) {
        const int b = bg >> 6, g = bg & 63;
        for (int i = F.tid; i < CTXL * 4; i += NWAVES * 64) { const int t = i >> 2, q = i & 3; const float* src = uscp + (size_t)(b * CTXL + t) * SW + g * SK + q * 4;
            f32x4 v = *(const f32x4*)src;
#pragma unroll
            for (int sp = 1; sp < 4; ++sp) v += *(const f32x4*)(src + (size_t)sp * MC * SW);
            *(LAS f32x4*)(LU + t * 16 + q * 4) = v; }
        __syncthreads();
        if (F.wave < 2) {
            const int dir = F.wave, p = F.lane, idx = (dir * SG + g) * SP + p;
            f32x2 bb[16];
#pragma unroll
            for (int k = 0; k < 16; ++k) bb[k] = bbar[(size_t)idx * SK + k];
            const f32x2 lam = lamb[idx]; float hr = 0.f, hi = 0.f;
#pragma unroll 4
            for (int s_ = 0; s_ < CTXL; ++s_) { const int t = dir == 0 ? s_ : CTXL - 1 - s_;
                const LAS f32x4* up = (const LAS f32x4*)(LU + t * 16); float br = 0.f, bi = 0.f;
#pragma unroll
                for (int q = 0; q < 4; ++q) { const f32x4 u4 = up[q];
#pragma unroll
                    for (int e = 0; e < 4; ++e) { br += bb[q * 4 + e].x * u4[e]; bi += bb[q * 4 + e].y * u4[e]; } }
                const float nr = lam.x * hr - lam.y * hi + br, ni = lam.x * hi + lam.y * hr + bi; hr = nr; hi = ni; }
            hctx[((dir * BATCH + b) * SG + g) * SP + p] = (f32x2){hr, hi};
        }
        __syncthreads();
    }
}
__device__ __forceinline__ void chunk_recurrence(Frame& F) {
    const f32x2* lamT = (const f32x2*)(F.ws + WS_LAMB + 65536); const f32x2* hctx = (const f32x2*)(F.ws + WS_LAMB + 131072);
    const float* S = (const float*)(F.ws + WS_S); bf16* A2 = (bf16*)(F.ws + WS_A2);
    LAS float* LS = (LAS float*)F.lds;
    for (int gb = blockIdx.x; gb < SG * BATCH; gb += F.G) {
        const int g = gb >> 2, b = gb & 3; const size_t row0 = (size_t)g * A2R + b * NCH;
        const f32x4* src = (const f32x4*)(S + row0 * 256);
#pragma unroll
        for (int i = 0; i < 16; ++i) { const int o = i * (NWAVES * 64) + F.tid; ((LAS f32x4*)LS)[o] = src[o]; }
        __syncthreads();
        if (F.wave < 2) {
            const int dir = F.wave, p = F.lane;
            const f32x2 lt = lamT[(dir * SG + g) * SP + p]; const f32x2 h0 = hctx[((dir * BATCH + b) * SG + g) * SP + p]; float hr = h0.x, hi = h0.y;
#pragma unroll 4
            for (int s_ = 0; s_ < NCH; ++s_) { const int c = dir == 0 ? s_ : NCH - 1 - s_;
                const float sr = LS[c * 256 + dir * 128 + p], si = LS[c * 256 + dir * 128 + 64 + p];
                bf16* ap = A2 + (row0 + c) * A2K + CT * SK + dir * 128 + p;
                ap[0] = (bf16)(cvt_pk_bf16(hr, 0.f) & 0xffffu); ap[64] = (bf16)(cvt_pk_bf16(hi, 0.f) & 0xffffu);
                const float nr = lt.x * hr - lt.y * hi + sr, ni = lt.x * hi + lt.y * hr + si; hr = nr; hi = ni; }
        }
        __syncthreads();
    }
}
__device__ __forceinline__ void pool_units(Frame& F) {
    LAS float* L = (LAS float*)(F.lds); constexpr int RS = 520;
    const bf16* UP = (const bf16*)(F.ws + WS_UP); bf16* MIX = (bf16*)(F.ws + WS_MIX);
    const int tid = F.tid;
    const bool bal = F.G == 256; const int bx = (int)blockIdx.x, nmine = bal ? (bx < 128 ? 3 : 5) : (BATCH * 256 - bx + F.G - 1) / F.G;
    const int vr = (bx & 7) * 16 + ((bx >> 3) - 16);
    for (int ui = 0; ui < nmine; ++ui) {
        const int unit = !bal ? bx + ui * F.G : (ui < 3 ? F.vcu + ui * 256 : (ui == 3 ? 768 + vr : 896 + vr));
        const int b = unit >> 8, slice = unit & 255, w = 2 << (slice >> 6), hw = w >> 1;
        const v4u* src = (const v4u*)(UP + (size_t)(b * 256 + slice) * SEQ * 8);
        v4u keep[8];
#pragma unroll
        for (int i = 0; i < 8; ++i) { const int tok = i * 512 + tid; keep[i] = src[tok]; }
#pragma unroll
        for (int i = 0; i < 8; ++i) { const int tok = i * 512 + tid, r = tok >> 6, c = tok & 63; LAS f32x4* d = (LAS f32x4*)(L + r * RS + c * 8);
            d[0] = (f32x4){bf_lo(keep[i].x), bf_hi(keep[i].x), bf_lo(keep[i].y), bf_hi(keep[i].y)}; d[1] = (f32x4){bf_lo(keep[i].z), bf_hi(keep[i].z), bf_lo(keep[i].w), bf_hi(keep[i].w)}; }
        __syncthreads();
        { const int r = tid >> 3, ch = tid & 7; LAS float* p = L + r * RS + ch; float run = 0.f;
#pragma unroll 8
          for (int c = 0; c < 64; ++c) { run += p[c * 8]; p[c * 8] = run; } }
        __syncthreads();
        { const int c = tid >> 3, ch = tid & 7; LAS float* p = L + c * 8 + ch; float run = 0.f;
#pragma unroll 8
          for (int r = 0; r < 64; ++r) { run += p[r * RS]; p[r * RS] = run; } }
        __syncthreads();
#pragma unroll
        for (int i = 0; i < 8; ++i) { const int tok = i * 512 + tid, r = tok >> 6, c = tok & 63;
            const int rlo = r - hw < 0 ? 0 : r - hw, rhi = r + hw > 64 ? 64 : r + hw, clo = c - hw < 0 ? 0 : c - hw, chi = c + hw > 64 ? 64 : c + hw;
            const float inv = 1.0f / (float)((rhi - rlo) * (chi - clo));
            f32x4 s0, s1;
            { const LAS f32x4* q = (const LAS f32x4*)(L + (rhi - 1) * RS + (chi - 1) * 8); s0 = q[0]; s1 = q[1]; }
            if (rlo > 0) { const LAS f32x4* q = (const LAS f32x4*)(L + (rlo - 1) * RS + (chi - 1) * 8); s0 -= q[0]; s1 -= q[1]; }
            if (clo > 0) { const LAS f32x4* q = (const LAS f32x4*)(L + (rhi - 1) * RS + (clo - 1) * 8); s0 -= q[0]; s1 -= q[1]; }
            if (rlo > 0 && clo > 0) { const LAS f32x4* q = (const LAS f32x4*)(L + (rlo - 1) * RS + (clo - 1) * 8); s0 += q[0]; s1 += q[1]; }
            const f32x4 v0 = (f32x4){bf_lo(keep[i].x), bf_hi(keep[i].x), bf_lo(keep[i].y), bf_hi(keep[i].y)}, v1 = (f32x4){bf_lo(keep[i].z), bf_hi(keep[i].z), bf_lo(keep[i].w), bf_hi(keep[i].w)};
            const f32x4 o0 = s0 * inv - v0, o1 = s1 * inv - v1;
            v4u wv; wv.x = cvt_pk_bf16(o0.x, o0.y); wv.y = cvt_pk_bf16(o0.z, o0.w); wv.z = cvt_pk_bf16(o1.x, o1.y); wv.w = cvt_pk_bf16(o1.z, o1.w);
            *(v4u*)(MIX + (size_t)(b * SEQ + tok) * PW_ + slice * 8) = wv; }
        __syncthreads();
    }
}

constexpr int NPHASES = 16;
#ifndef WGM_FFN
#define WGM_FFN 8
#endif
#ifndef DUP_MASK
#define DUP_MASK 0
#endif
#ifndef DUP_SUB
#define DUP_SUB 0
#endif
#define REPS(k) _Pragma("unroll") for (int rep_ = 0; rep_ < ((((DUP_MASK) >> (k)) & 1) ? 2 : 1); ++rep_)
#ifndef MK_N_LAUNCHES
#define MK_N_LAUNCHES 1
#endif
struct Args { const float* in[27]; float* out; unsigned char* ws; int ph_lo, ph_hi; };
static_assert(sizeof(Args) == 27 * 8 + 8 + 8 + 8, "Args has no padding");

__global__ void __launch_bounds__(NWAVES * 64, 2) fwd_kernel(Args args) {
    extern __shared__ __attribute__((aligned(16))) unsigned char lds[];
    Frame F;
    F.lds = (LAS unsigned char*)lds;
    F.tid = threadIdx.x; F.lane = F.tid & 63; F.wave = __builtin_amdgcn_readfirstlane(F.tid >> 6);
    F.G = gridDim.x; { const int bx = blockIdx.x; F.vcu = (F.G % 8 == 0) ? (bx % 8) * (F.G / 8) + bx / 8 : bx; }
#pragma unroll
    for (int i = 0; i < 27; ++i) F.in[i] = args.in[i];
    F.out = args.out; F.ws = args.ws;
    volatile LAS unsigned* MISC = (volatile LAS unsigned*)(F.lds + MISC_OFF);
    if (F.tid < 32) MISC[F.tid] = 0u;
    __syncthreads();
    unsigned* ctl = (unsigned*)(F.ws + WS_CTL);
    XcdBarrier bar; bar.bar = ctl + CW_BAR; bar.x = 0; bar.st = nullptr;
    if (MK_N_LAUNCHES == 1) bar = xcd_barrier_post(ctl + CW_BAR, MISC + 8);
#define GRID_BAR() do { if (MK_N_LAUNCHES == 1) xcd_barrier(bar); } while (0)
    const int lo = args.ph_lo, hi = args.ph_hi;
#define IN(k) (lo <= (k) && (k) < hi)
#if defined(EXP_T_LO)
    unsigned long long tA_ = 0ull, tB_ = 0ull;
#define TSTAMP(k) do { if ((k) == EXP_T_LO) tA_ = __builtin_amdgcn_s_memrealtime(); if ((k) == EXP_T_HI) tB_ = __builtin_amdgcn_s_memrealtime(); } while (0)
#else
#define TSTAMP(k) do { } while (0)
#endif
    bool qdone = false;
#define FILL_TAIL(p, mand) do { if (!qdone) { phase_done(F, ctl + CW_DONE + 64 * (p)); qdone = fill_transposes(F, (mand), ctl + CW_DONE + 64 * (p)); } } while (0)
#define FILL_MAND(mand) do { if (!qdone) qdone = fill_transposes(F, (mand), nullptr); } while (0)
#define BOTH(k) (IN(k) && IN((k) + 1))
    unsigned char* ws = F.ws;
    LAS unsigned char* ring = F.lds + RING_OFF;
    volatile LAS int* DSLOT = (volatile LAS int*)(F.lds + MISC_OFF + 96);
    const float* mod = (const float*)(ws + WS_MOD);

    TSTAMP(0);
    if (IN(0)) REPS(0) {
        for (int st = 0; st < 3; ++st) { const int which = ((blockIdx.x & 1) && st < 2) ? 1 - st : st;
            if (which == 0) { for (int w = blockIdx.x; w < SG * 4; w += F.G) p0_ssm_part(F, w >> 2, w & 3); }
            else if (which == 1) p0_mod(F);
            else (void)fill_transposes(F, Q_W1B, nullptr); }
        if (BOTH(0)) GRID_BAR();
    }
    TSTAMP(1);
    if (IN(1)) REPS(1) {
        if (F.G % 4 == 0) norm_phase<false, false>(F, F.in[I_X], F.in[I_CTX], true, F.in[I_NORMG], 0, 1, (bf16*)(ws + WS_U), nullptr, nullptr);
        else norm_rows<false>(F, F.in[I_X], F.in[I_CTX], MA, F.in[I_NORMG], 0, 1, (bf16*)(ws + WS_U), nullptr);
        if (BOTH(1)) GRID_BAR();
#if defined(EXP_BARS)
        for (int eb = 0; eb < EXP_BARS; ++eb) GRID_BAR();
#endif
        }
    TSTAMP(2);
    if (IN(2)) REPS(2) {
        pg8::Gemm g{(const char*)(ws + WS_U), (const char*)(ws + WS_W1A), D, D, D, 0, 0};
        pg8::DynOrder<pg8::StaticOrder> S; S.B.init(MA, 2 * DFF, F.G, (int)blockIdx.x, WGM_FFN); S.ctr = ctl + CW_DYN + 128 * 2; S.slot = DSLOT; S.G = F.G; S.c = (int)blockIdx.x;
        EpiGated<0> E{(bf16*)(ws + WS_H), DFF};
#if defined(EXP_VAR)
        pg8::gemm_phase<EpiGated<0>, pg8::DynOrder<pg8::StaticOrder>, PG8_ALIGN, PG8_SP2, EXP_VAR>(ring, g, S, E); GRID_BAR();
#endif
        pg8::gemm_phase<EpiGated<0>, pg8::DynOrder<pg8::StaticOrder>, PG8_ALIGN, PG8_SP2, PG8_VAR>(ring, g, S, E);
        FILL_TAIL(2, Q_W1B); if (BOTH(2)) GRID_BAR();
    }
    TSTAMP(3);
    if (IN(3)) REPS(3) {
        pg8::Gemm g{(const char*)(ws + WS_H), (const char*)(ws + WS_W1B), DFF, DFF, DFF, 0, 0};
        pg8::DynOrder<pg8::SplitKOrder> S; S.ctr = ctl + CW_DYN + 128 * 3; S.slot = DSLOT; S.G = F.G; S.c = (int)blockIdx.x;
        S.B.S.init(ML, D, F.G, (int)blockIdx.x, 2); S.B.pm0 = ML / BM; S.B.npn = D / BM; S.B.ntiles = (MC / BM) * (D / BM); S.B.kt_a = 44; S.B.kt_b = 42;
        EpiResid<false, true> E{F.in[I_X], F.in[I_CTX], (void*)(ws + WS_XB), mod, 2, 0.5f, (float*)(ws + WS_T)};
#if defined(EXP3_VAR)
        pg8::gemm_phase<EpiResid<false, true>, pg8::DynOrder<pg8::SplitKOrder>, PG8_ALIGN, PG8_SP2, EXP3_VAR>(ring, g, S, E); GRID_BAR();
#endif
        pg8::gemm_phase<EpiResid<false, true>, pg8::DynOrder<pg8::SplitKOrder>, PG8_ALIGN, PG8_SP2, PG8_VAR>(ring, g, S, E);
        FILL_TAIL(3, Q_WIN); if (BOTH(3)) GRID_BAR();
    }
    TSTAMP(4);
    if (IN(4)) REPS(4) { const float* X = (const float*)(ws + WS_X);
        norm_phase<false, true, true>(F, (const void*)(ws + WS_XB), F.in[I_CTX], true, F.in[I_NORMG] + D, 3, 4, (bf16*)(ws + WS_U), nullptr, (const float*)(ws + WS_T));
        if (BOTH(4)) GRID_BAR(); }
    TSTAMP(5);
    if (IN(5)) REPS(5) {
        pg8::Gemm g{(const char*)(ws + WS_U), (const char*)(ws + WS_WIN), D, D, D, 0, 0};
        pg8::DynOrder<pg8::SplitKOrder> S; S.ctr = ctl + CW_DYN + 128 * 5; S.slot = DSLOT; S.G = F.G; S.c = (int)blockIdx.x;
        S.B.S.init(ML, DIN, F.G, (int)blockIdx.x, WGM_FFN); S.B.pm0 = ML / BM; S.B.npn = SW / BM; S.B.ntiles = (MC / BM) * (SW / BM); S.B.kt_a = 16; S.B.kt_b = 16;
        EpiWin E{(bf16*)(ws + WS_A2), (float*)(ws + WS_Z), (bf16*)(ws + WS_UP), (bf16*)(ws + WS_GT)};
        pg8::gemm_phase<EpiWin, pg8::DynOrder<pg8::SplitKOrder>, PG8_ALIGN, PG8_SP2, PG8_VAR>(ring, g, S, E);
        FILL_TAIL(5, Q_WIN); if (BOTH(5)) GRID_BAR();
    }
    TSTAMP(6);
    if (IN(6)) REPS(6) {
        { pg8::Gemm g{(const char*)(ws + WS_A2), (const char*)(ws + WS_BTS), A2K, CT * SK, CT * SK, (long)A2R * A2K * 2, (long)256 * CT * SK * 2};
          pg8::GroupOrder S{A2R / BM, 1, SG, F.G, (int)blockIdx.x};
          EpiF32G E{(float*)(ws + WS_S), 256, (size_t)A2R * 256};
          pg8::gemm_phase<EpiF32G, pg8::GroupOrder, PG8_ALIGN, PG8_SP2, PG8_VAR>(ring, g, S, E); }
        ctx_scan(F);
        __syncthreads();
        pool_units(F);
        FILL_MAND(Q_POOL); if (BOTH(6)) GRID_BAR();
    }
    TSTAMP(7);
    if (IN(7)) REPS(7) {
        chunk_recurrence(F);
        { pg8::Gemm g{(const char*)(ws + WS_MIX), (const char*)(ws + WS_WPOOL), PW_, 512, 512, (long)512 * 2, (long)512 * 512 * 2};
          pg8::GroupOrder S{ML / BM, 512 / BM, 4, F.G, (int)blockIdx.x};
          EpiPool E{(bf16*)(ws + WS_YB), F.in[I_POOLS]};
          pg8::gemm_phase<EpiPool, pg8::GroupOrder, PG8_ALIGN, PG8_SP2, PG8_VAR>(ring, g, S, E); }
        FILL_MAND(Q_WB); if (BOTH(7)) GRID_BAR();
    }
    TSTAMP(8);
    if (IN(8)) REPS(8) {
        { pg8::Gemm g{(const char*)(ws + WS_A2), (const char*)(ws + WS_BTY), A2K, A2K, A2K, (long)A2R * A2K * 2, (long)(CT * SK) * A2K * 2};
          pg8::GroupOrder S{A2R / BM, (CT * SK) / BM, SG, F.G, F.vcu};
          EpiY E{(bf16*)(ws + WS_Z)};
          pg8::gemm_phase<EpiY, pg8::GroupOrder, PG8_ALIGN, PG8_SP2, PG8_VAR>(ring, g, S, E); }
        { pg8::Gemm g{(const char*)(ws + WS_YB), (const char*)(ws + WS_WB), PW_, PW_, PW_, 0, 0}; pg8::StaticOrder S; S.init(ML, D, F.G, (int)blockIdx.x, 4);
          EpiBranch<false> E{(bf16*)(ws + WS_T), (const bf16*)(ws + WS_GT), D};
          pg8::gemm_phase<EpiBranch<false>, pg8::StaticOrder, PG8_ALIGN, PG8_SP2, PG8_VAR>(ring, g, S, E); }
        FILL_MAND(Q_GLU); if (BOTH(8)) GRID_BAR();
    }
    TSTAMP(9);
    if (IN(9)) REPS(9) {
        pg8::Gemm g{(const char*)(ws + WS_Z), (const char*)(ws + WS_WGLU), SW, SW, SW, 0, 0}; pg8::StaticOrder S; S.init(ML, 2 * SW, F.G, (int)blockIdx.x);
        EpiGated<1> E{(bf16*)(ws + WS_GL), SW};
        pg8::gemm_phase<EpiGated<1>, pg8::StaticOrder, PG8_ALIGN, PG8_SP2, PG8_VAR>(ring, g, S, E);
        FILL_MAND(Q_WA); if (BOTH(9)) GRID_BAR();
    }
    TSTAMP(10);
    if (IN(10)) {
        pg8::Gemm g{(const char*)(ws + WS_GL), (const char*)(ws + WS_WA), SW, SW, SW, 0, 0}; pg8::StaticOrder S; S.init(ML, D, F.G, (int)blockIdx.x);
        EpiBranch<true> E{(bf16*)(ws + WS_T), (const bf16*)(ws + WS_GT), 0};
        pg8::gemm_phase<EpiBranch<true>, pg8::StaticOrder, PG8_ALIGN, PG8_SP2, PG8_VAR>(ring, g, S, E);
        FILL_MAND(Q_WOUT); if (BOTH(10)) GRID_BAR();
    }
    TSTAMP(11);
    if (IN(11)) {
        pg8::Gemm g{(const char*)(ws + WS_T), (const char*)(ws + WS_WOUT), D, D, D, 0, 0}; pg8::StaticOrder S; S.init(ML, D, F.G, (int)blockIdx.x, 4);
        EpiResid<true, true> E{(const void*)(ws + WS_XB), nullptr, (void*)(ws + WS_XB), mod, 5, 1.0f, nullptr};
        pg8::gemm_phase<EpiResid<true, true>, pg8::StaticOrder, PG8_ALIGN, PG8_SP2, PG8_VAR>(ring, g, S, E);
        FILL_MAND(Q_W2A); if (BOTH(11)) GRID_BAR();
    }
    TSTAMP(12);
    if (IN(12)) REPS(12) { const float* X = (const float*)(ws + WS_X);
        norm_phase<false, false, true>(F, (const void*)(ws + WS_XB), nullptr, false, F.in[I_NORMG] + 2 * D, 6, 7, (bf16*)(ws + WS_U), nullptr, nullptr);
        if (BOTH(12)) GRID_BAR(); }
    TSTAMP(13);
    if (IN(13)) REPS(13) {
        pg8::Gemm g{(const char*)(ws + WS_U), (const char*)(ws + WS_W2A), D, D, D, 0, 0};
        pg8::DynOrder<pg8::StaticOrder> S; S.B.init(ML, 2 * DFF, F.G, (int)blockIdx.x, WGM_FFN); S.ctr = ctl + CW_DYN + 128 * 13; S.slot = DSLOT; S.G = F.G; S.c = (int)blockIdx.x;
        EpiGated<0> E{(bf16*)(ws + WS_H), DFF};
        pg8::gemm_phase<EpiGated<0>, pg8::DynOrder<pg8::StaticOrder>, PG8_ALIGN, PG8_SP2, PG8_VAR>(ring, g, S, E);
        FILL_TAIL(13, Q_W2B); if (BOTH(13)) GRID_BAR();
    }
    TSTAMP(14);
    if (IN(14)) {
        pg8::Gemm g{(const char*)(ws + WS_H), (const char*)(ws + WS_W2B), DFF, DFF, DFF, 0, 0}; pg8::StaticOrder S; S.init(ML, D, F.G, (int)blockIdx.x, 2);
        EpiResid<true, false> E{(const void*)(ws + WS_XB), nullptr, (void*)(ws + WS_X), mod, 8, 0.5f, nullptr};
        pg8::gemm_phase<EpiResid<true, false>, pg8::StaticOrder, PG8_ALIGN, PG8_SP2, PG8_VAR>(ring, g, S, E);
        if (BOTH(14)) GRID_BAR();
    }
    TSTAMP(15);
    if (IN(15)) REPS(15) { const float* X = (const float*)(ws + WS_X);
        if (F.G % 4 == 0) norm_phase<true, false>(F, X, nullptr, false, F.in[I_FINALG], 0, 0, nullptr, F.out, nullptr);
        else norm_rows<true>(F, X, X, ML, F.in[I_FINALG], 0, 0, nullptr, F.out); }
    TSTAMP(16);
#if defined(EXP_T_LO)
    if (blockIdx.x == 0) { const unsigned long long t0_ = __builtin_amdgcn_s_memrealtime(), w_ = (tB_ - tA_) * EXP_T_MUL; while (__builtin_amdgcn_s_memrealtime() - t0_ < w_) __builtin_amdgcn_s_sleep(8); }
#endif
#undef IN
#undef BOTH
#undef GRID_BAR
}

extern "C" void kernel_launch(void* const* d_in, const int* in_sizes, int n_in, void* d_out, int out_size, void* d_ws, size_t ws_size, hipStream_t stream) {
    static int grid = 0;
    if (grid == 0) {
        if (n_in != 27 || in_sizes[0] != ML * D || out_size != ML * D || ws_size < WS_END) { fprintf(stderr, "kernel_launch: unexpected shapes (n_in %d, in0 %d, out %d, ws %zu < %zu); nothing launched\n", n_in, n_in > 0 ? in_sizes[0] : -1, out_size, ws_size, (size_t)WS_END); grid = -1; return; }
        int dev = 0, cus = 0, per_cu = 0;
        if (hipGetDevice(&dev) != hipSuccess || hipDeviceGetAttribute(&cus, hipDeviceAttributeMultiprocessorCount, dev) != hipSuccess) { fprintf(stderr, "kernel_launch: device query failed\n"); grid = -1; return; }
        if (hipFuncSetAttribute((const void*)fwd_kernel, hipFuncAttributeMaxDynamicSharedMemorySize, LDS_BYTES) != hipSuccess) { fprintf(stderr, "kernel_launch: hipFuncSetAttribute failed\n"); grid = -1; return; }
        if (hipOccupancyMaxActiveBlocksPerMultiprocessor(&per_cu, (const void*)fwd_kernel, NWAVES * 64, LDS_BYTES) != hipSuccess || per_cu < 1) fprintf(stderr, "kernel_launch: note: occupancy query reports %d workgroups per CU\n", per_cu);
        (void)hipGetLastError();
        grid = cus - cus % 4;
    }
    if (grid < 0) return;
    if (hipMemsetAsync((char*)d_ws + WS_CTL, 0, CTL_ZERO_BYTES, stream) != hipSuccess) { fprintf(stderr, "kernel_launch: memset failed\n"); return; }
    Args a{};
    for (int i = 0; i < 27; ++i) a.in[i] = (const float*)d_in[i];
    a.out = (float*)d_out; a.ws = (unsigned char*)d_ws;
    for (int li = 0; li < MK_N_LAUNCHES; ++li) {
        a.ph_lo = (MK_N_LAUNCHES == 1) ? 0 : li; a.ph_hi = (MK_N_LAUNCHES == 1) ? NPHASES : li + 1;
        hipLaunchKernelGGL(fwd_kernel, dim3(grid), dim3(NWAVES * 64), LDS_BYTES, stream, a);
        const hipError_t le = hipPeekAtLastError();
        if (le != hipSuccess) { fprintf(stderr, "kernel_launch: launch %d failed: %s\n", li, hipGetErrorName(le)); break; }
    }
}
```

```cpp
#include <hip/hip_runtime.h>
#include <cstdio>
#include <cstdint>

namespace pg8 {
#define PG8_LAS __attribute__((address_space(3)))
typedef unsigned short bf16_t;
typedef short bf16x8 __attribute__((ext_vector_type(8)));
typedef float f32x4 __attribute__((ext_vector_type(4)));
typedef unsigned u32x4 __attribute__((ext_vector_type(4)));
constexpr int BM = 256, BK = 64, HALF = 128, HTB = HALF * BK * 2  , STAGE_BYTES = 8 * HTB, NXCD = 8, WGM = 8;

__host__ __device__ __forceinline__ int lds_byte(int r, int c) { const int st = (r >> 4) * 2 + (c >> 5), rr = r & 15, cc = c & 31, ob = rr * 64 + cc * 2; return st * 1024 + (ob ^ (((ob >> 9) & 1) << 5)); }
__host__ __device__ __forceinline__ void stage_rc(int b, int& R, int& C) { const int st = b / 1024, sb = b % 1024, swz = sb ^ (((sb >> 9) & 1) << 5); R = (st >> 1) * 16 + swz / 64; C = (st & 1) * 32 + (swz % 64) / 2; }
__host__ __device__ __forceinline__ int perm32(int rho) { const int n = rho >> 4, i = rho & 15; return 8 * (i >> 2) + 4 * n + (i & 3); }

struct Unit { int pm, pn, g, kt0, nkt; };
struct Gemm { const char* A; const char* Bt; int lda, ldb, K; long gsa, gsb; };

struct StaticOrder {
    int nM, nN, nwg, G, c, wgm;
    __host__ __device__ void init(int M, int N, int G_, int c_, int wgm_ = WGM) { nM = M / BM; nN = N / BM; nwg = nM * nN; G = G_; c = c_; wgm = wgm_; }
    static constexpr bool DYNAMIC = false;
    __host__ __device__ int total() const { return nwg; }
    __host__ __device__ bool next(int i, Unit& u) const { return at((long)i * G + c, u); }
    __host__ __device__ bool at(long L, Unit& u) const {
        if (L >= nwg) return false;
        int wgid = (int)L; { const int q = nwg / NXCD, r = nwg % NXCD, xcd = wgid % NXCD, off = wgid / NXCD; wgid = (xcd < r ? xcd * (q + 1) : r * (q + 1) + (xcd - r) * q) + off; }
        const int nig = wgm * nN, gid = wgid / nig, fm = gid * wgm, gsz = (nM - fm) < wgm ? (nM - fm) : wgm;
        u.pm = fm + ((wgid % nig) % gsz); u.pn = (wgid % nig) / gsz; u.g = 0; u.kt0 = 0; u.nkt = 0; return true;
    }
    __device__ __forceinline__ void a_ready(const Unit&) const {}
    __device__ __forceinline__ void done(const Unit&) const {}
};
struct GroupOrder {
    static constexpr bool DYNAMIC = false;
    int nM, nN, ng, G, c;
    __device__ bool next(int i, Unit& u) const {
        const long L = (long)i * G + c; const int per = nM * nN; if (L >= (long)ng * per) return false;
        u.g = (int)(L / per); const int r = (int)(L % per); u.pm = r % nM; u.pn = r / nM; u.kt0 = 0; u.nkt = 0; return true;
    }
    __device__ __forceinline__ void a_ready(const Unit&) const {}
    __device__ __forceinline__ void done(const Unit&) const {}
};

struct SplitKOrder {
    StaticOrder S; int pm0, npn, ntiles, kt_a, kt_b;
    static constexpr bool DYNAMIC = false;
    __device__ int total() const { return S.nwg + 4 * ntiles; }
    __device__ bool next(int i, Unit& u) const { return at((long)i * S.G + S.c, u); }
    __device__ bool at(long L, Unit& u) const {
        if (L < S.nwg) return S.at(L, u);
        const int j = (int)(L - S.nwg); if (j >= 4 * ntiles) return false;
        const int split = j & 3, tile = j >> 2;
        u.pm = pm0 + tile / npn; u.pn = tile % npn; u.g = split + 1; u.kt0 = split < 2 ? split * kt_a : 2 * kt_a + (split - 2) * kt_b; u.nkt = split < 2 ? kt_a : kt_b; return true;
    }
    __device__ __forceinline__ void a_ready(const Unit&) const {}
    __device__ __forceinline__ void done(const Unit&) const {}
};

template <class Base> struct DynOrder {
    static constexpr bool DYNAMIC = true;
    Base B; unsigned* ctr; volatile PG8_LAS int* slot; int G, c;
    __device__ int total() const { return B.total(); }
    __device__ bool at(long L, Unit& u) const { return B.at(L, u); }
    __device__ int pull() const {
        const int x = c & 7, tot = B.total();
        for (int s_ = 0; s_ < 8; ++s_) { const int y = (x + s_) & 7, n0 = (G - y + 7) >> 3;
            const unsigned k = (unsigned)n0 + __hip_atomic_fetch_add(ctr + 16 * y, 1u, __ATOMIC_RELAXED, __HIP_MEMORY_SCOPE_AGENT);
            const long L = 8l * (long)k + y; if (L < tot) return (int)L; }
        return -1;
    }
    __device__ __forceinline__ void a_ready(const Unit&) const {}
    __device__ __forceinline__ void done(const Unit&) const {}
};

__device__ __forceinline__ unsigned cvt_pk_bf16(float lo, float hi) { unsigned r; asm volatile("v_cvt_pk_bf16_f32 %0, %1, %2" : "=v"(r) : "v"(lo), "v"(hi)); return r; }
__device__ __forceinline__ float sigmoidf_fast(float x) { return __builtin_amdgcn_rcpf(1.0f + __expf(-x)); }
__device__ __forceinline__ float bf_lo(unsigned w) { return __uint_as_float(w << 16); }
__device__ __forceinline__ float bf_hi(unsigned w) { return __uint_as_float(w & 0xffff0000u); }

template <class Epi, class Sched, bool ALIGN_EPI = false, bool SP2 = false, int VAR = 0>
__device__ __forceinline__ void gemm_phase(PG8_LAS unsigned char* lds, const Gemm g, const Sched& S, const Epi& E) {
    const int tid = threadIdx.x, wid = __builtin_amdgcn_readfirstlane(tid >> 6), lane = tid & 63, wr = wid >> 2, wc = wid & 3, fr = lane & 15, fq = lane >> 4;
    const int K = g.K, nt = K / BK;
    unsigned voffA[2], voffB[2];
#pragma unroll
    for (int i = 0; i < 2; ++i) { int R, C; stage_rc(tid * 16 + i * 8192, R, C); const int Rb = Epi::PERM ? ((R & ~31) + perm32(R & 31)) : R;
        voffA[i] = (unsigned)(R * g.lda + C) * 2u; voffB[i] = (unsigned)(Rb * g.ldb + C) * 2u; }
    const size_t kstep = (size_t)(BK * 2);
    const size_t hsA = (size_t)HALF * g.lda * 2, hsB = (size_t)HALF * g.ldb * 2;
    const size_t tsA = 2 * hsA, tsB = 2 * hsB;
    const unsigned ldsw = (unsigned)wid * 1024u;
    const int aoff = lds_byte(wr * 64 + fr, fq * 8), boff = lds_byte(wc * 32 + fr, fq * 8);
#define PG8_SA(b, h) (((b) * 2 + (h)) * HTB)
#define PG8_SB(b, h) ((4 + (b) * 2 + (h)) * HTB)
#define PG8_STAGE(bufoff, gbase, voff) do { if (!(VAR & 1)) _Pragma("unroll") for (int _i = 0; _i < 2; ++_i) \
        __builtin_amdgcn_global_load_lds((const unsigned*)((const char*)(gbase) + (voff)[_i]), (PG8_LAS unsigned*)(lds + (bufoff) + ldsw + _i * 8192), 16, 0, 0); } while (0)
#define PG8_LDA(dst, b, h) do { if (!(VAR & 2)) _Pragma("unroll") for (int m = 0; m < 4; ++m) _Pragma("unroll") for (int k = 0; k < 2; ++k) dst[m][k] = *(const PG8_LAS bf16x8*)(lds + PG8_SA(b, h) + aoff + m * 2048 + k * 1024); } while (0)
#define PG8_LDB(dst, b, h) do { if (!(VAR & 2)) _Pragma("unroll") for (int n = 0; n < 2; ++n) _Pragma("unroll") for (int k = 0; k < 2; ++k) dst[n][k] = *(const PG8_LAS bf16x8*)(lds + PG8_SB(b, h) + boff + n * 2048 + k * 1024); } while (0)
#define PG8_MMA(ai, bj, At, Bt) do { if (!(VAR & 128)) __builtin_amdgcn_s_setprio(1); if (!(VAR & 4)) _Pragma("unroll") for (int m = 0; m < 4; ++m) _Pragma("unroll") for (int n = 0; n < 2; ++n) _Pragma("unroll") for (int k = 0; k < 2; ++k) \
        acc[ai][bj][m][n] = __builtin_amdgcn_mfma_f32_16x16x32_bf16(Bt[n][k], At[m][k], acc[ai][bj][m][n], 0, 0, 0); if (!(VAR & 128)) __builtin_amdgcn_s_setprio(0); } while (0)
#define PG8_WAIT_V(n) asm volatile("s_waitcnt vmcnt(" #n ")" ::: "memory")
#define PG8_WAIT_L(n) asm volatile("s_waitcnt lgkmcnt(" #n ")" ::: "memory")
#define PG8_BAR __builtin_amdgcn_s_barrier()
#define PG8_SCHED __builtin_amdgcn_sched_barrier(0)
    Unit cur, nxt; int ui = 0;
    if constexpr (Sched::DYNAMIC) {
        if (!S.at(S.c, cur)) return;
        if (tid == 0) S.slot[1] = S.pull();
        __syncthreads();
    } else { if (!S.next(0, cur)) return; }
    if constexpr (VAR & 128) { if (wr == 1) __builtin_amdgcn_s_setprio(1); }
    f32x4 acc[2][2][4][2];
#pragma unroll
    for (int a = 0; a < 2; ++a)
#pragma unroll
        for (int b = 0; b < 2; ++b)
#pragma unroll
            for (int m = 0; m < 4; ++m)
#pragma unroll
                for (int n = 0; n < 2; ++n) acc[a][b][m][n] = (f32x4){0.f, 0.f, 0.f, 0.f};
    bf16x8 At[4][2], B0[2][2], B1[2][2];
    if (VAR & 2) {
#pragma unroll
        for (int m = 0; m < 4; ++m)
#pragma unroll
            for (int k = 0; k < 2; ++k) { At[m][k] = (bf16x8){0, 0, 0, 0, 0, 0, 0, 0}; asm volatile("" : "+v"(At[m][k])); }
#pragma unroll
        for (int n = 0; n < 2; ++n)
#pragma unroll
            for (int k = 0; k < 2; ++k) { B0[n][k] = (bf16x8){0, 0, 0, 0, 0, 0, 0, 0}; B1[n][k] = B0[n][k]; asm volatile("" : "+v"(B0[n][k])); asm volatile("" : "+v"(B1[n][k])); }
    }
    const bool grouped = g.gsa != 0 || g.gsb != 0;
    const char* cA = g.A + (grouped ? (size_t)cur.g * g.gsa : 0) + (size_t)((VAR & 8) ? 0 : cur.pm) * tsA + (size_t)cur.kt0 * kstep; const char* cB = g.Bt + (grouped ? (size_t)cur.g * g.gsb : 0) + (size_t)((VAR & 8) ? 0 : cur.pn) * tsB + (size_t)cur.kt0 * kstep;
    S.a_ready(cur);
    if constexpr (SP2) {
        PG8_STAGE(PG8_SB(0, 0), cB, voffB); PG8_STAGE(PG8_SB(0, 1), cB + hsB, voffB); PG8_STAGE(PG8_SA(0, 0), cA, voffA); PG8_STAGE(PG8_SA(0, 1), cA + hsA, voffA);
        if (wr == 1) PG8_BAR;
        PG8_WAIT_V(2); PG8_BAR;
        PG8_STAGE(PG8_SB(1, 0), cB + kstep, voffB); PG8_STAGE(PG8_SA(1, 0), cA + kstep, voffA); PG8_STAGE(PG8_SB(1, 1), cB + hsB + kstep, voffB);
        PG8_WAIT_V(6); PG8_BAR;
    } else {
        PG8_STAGE(PG8_SB(0, 0), cB, voffB); PG8_STAGE(PG8_SA(0, 0), cA, voffA); PG8_STAGE(PG8_SB(0, 1), cB + hsB, voffB); PG8_STAGE(PG8_SA(0, 1), cA + hsA, voffA);
        if (wr == 1) PG8_BAR;
        PG8_WAIT_V(4); PG8_BAR;
        PG8_STAGE(PG8_SB(1, 0), cB + kstep, voffB); PG8_STAGE(PG8_SA(1, 0), cA + kstep, voffA); PG8_STAGE(PG8_SB(1, 1), cB + hsB + kstep, voffB);
        PG8_WAIT_V(6); PG8_BAR;
    }
    unsigned sink = 0u; const int tidx = wid * 12 + lane; const bool t_isA = tidx < 64; constexpr int PD = 4;
    for (;;) {
        bool has_next = false; const char* nA = cA; const char* nB = cB;
#define PG8_NEXT_PTRS() do { nA = has_next ? g.A + (grouped ? (size_t)nxt.g * g.gsa : 0) + (size_t)((VAR & 8) ? 0 : nxt.pm) * tsA + (size_t)nxt.kt0 * kstep : cA; \
                             nB = has_next ? g.Bt + (grouped ? (size_t)nxt.g * g.gsb : 0) + (size_t)((VAR & 8) ? 0 : nxt.pn) * tsB + (size_t)nxt.kt0 * kstep : cB; } while (0)
        if constexpr (!Sched::DYNAMIC) { has_next = S.next(ui + 1, nxt); PG8_NEXT_PTRS(); }
        const int ntu = cur.nkt ? cur.nkt : nt;
        const unsigned toff = t_isA ? (unsigned)(((cur.pn & 3) * 64 + tidx) * g.lda) * 2u : (unsigned)(((cur.pm & 7) * 32 + (tidx - 64)) * g.ldb) * 2u;
#define PG8_TOUCH(tt) do { if constexpr (VAR & 64) { const int tp_ = (tt) + PD; const char* ta_ = tp_ < ntu ? cA + (size_t)tp_ * kstep : nA + (size_t)(tp_ - ntu) * kstep; \
            const char* tb_ = tp_ < ntu ? cB + (size_t)tp_ * kstep : nB + (size_t)(tp_ - ntu) * kstep; const char* tpp_ = (t_isA ? ta_ : tb_) + toff; \
            if (lane < 12) asm volatile("global_load_dword %0, %1, off" : "+v"(sink) : "v"(tpp_) : "memory"); } } while (0)
        for (int t = 0; t < ntu; t += 2) {
            const bool last = (t == ntu - 2);
            if constexpr (Sched::DYNAMIC) { if (last) {
                const int nL = __builtin_amdgcn_readfirstlane(S.slot[(ui + 1) & 1]); has_next = nL >= 0; if (has_next) has_next = S.at(nL, nxt); PG8_NEXT_PTRS(); } }
            const char* a1 = cA + (size_t)(t + 1) * kstep;
            const char* a2 = last ? nA : cA + (size_t)(t + 2) * kstep; const char* b2 = last ? nB : cB + (size_t)(t + 2) * kstep;
            const char* a3 = a2 + kstep; const char* b3 = b2 + kstep;
            if (last && has_next) S.a_ready(nxt);
            if constexpr (SP2) {
            if constexpr (VAR & 256) { PG8_STAGE(PG8_SA(1, 1), a1 + hsA, voffA); PG8_SCHED; PG8_LDB(B0, 0, 0); PG8_LDB(B1, 0, 1); PG8_SCHED; PG8_LDA(At, 0, 0); } else {
            PG8_LDB(B0, 0, 0); PG8_LDB(B1, 0, 1); PG8_SCHED; PG8_LDA(At, 0, 0); PG8_STAGE(PG8_SA(1, 1), a1 + hsA, voffA); } PG8_TOUCH(t);
            if constexpr ((VAR & 96) == 96) { PG8_WAIT_L(0); PG8_BAR; PG8_MMA(0, 0, At, B0); PG8_MMA(0, 1, At, B1); PG8_WAIT_V(10); PG8_BAR; PG8_SCHED; } else
            if constexpr (VAR & 32) { if (wr == 1) PG8_WAIT_V(8); PG8_WAIT_L(0); PG8_BAR; PG8_MMA(0, 0, At, B0); PG8_MMA(0, 1, At, B1); if (wr == 0) PG8_WAIT_V(8); PG8_BAR; PG8_SCHED; } else {
            PG8_WAIT_V(8); PG8_WAIT_L(0); PG8_BAR; PG8_MMA(0, 0, At, B0); PG8_MMA(0, 1, At, B1); PG8_BAR; PG8_SCHED; }
            if constexpr (VAR & 16) {
            PG8_LDA(At, 0, 1); PG8_STAGE(PG8_SB(0, 0), b2, voffB); PG8_STAGE(PG8_SB(0, 1), b2 + hsB, voffB);
            PG8_WAIT_V(6); PG8_WAIT_L(0); PG8_BAR; PG8_MMA(1, 0, At, B0); PG8_SCHED; PG8_STAGE(PG8_SA(0, 0), a2, voffA); PG8_SCHED; PG8_MMA(1, 1, At, B1); PG8_BAR; PG8_SCHED;
            } else {
            if constexpr (VAR & 256) { PG8_STAGE(PG8_SB(0, 0), b2, voffB); PG8_STAGE(PG8_SB(0, 1), b2 + hsB, voffB); PG8_STAGE(PG8_SA(0, 0), a2, voffA); PG8_SCHED; PG8_LDA(At, 0, 1); } else {
            PG8_LDA(At, 0, 1); PG8_STAGE(PG8_SB(0, 0), b2, voffB); PG8_STAGE(PG8_SB(0, 1), b2 + hsB, voffB); PG8_STAGE(PG8_SA(0, 0), a2, voffA); }
            if constexpr ((VAR & 96) == 96) { PG8_WAIT_L(0); PG8_BAR; PG8_MMA(1, 0, At, B0); PG8_MMA(1, 1, At, B1); PG8_WAIT_V(9); PG8_BAR; PG8_SCHED; } else
            if constexpr (VAR & 32) { if (wr == 1) PG8_WAIT_V(8); PG8_WAIT_L(0); PG8_BAR; PG8_MMA(1, 0, At, B0); PG8_MMA(1, 1, At, B1); if (wr == 0) PG8_WAIT_V(8); PG8_BAR; PG8_SCHED; } else {
            PG8_WAIT_V(8); PG8_WAIT_L(0); PG8_BAR; PG8_MMA(1, 0, At, B0); PG8_MMA(1, 1, At, B1); PG8_BAR; PG8_SCHED; }
            }
            if constexpr (VAR & 256) { PG8_STAGE(PG8_SA(0, 1), a2 + hsA, voffA); PG8_SCHED; PG8_LDB(B0, 1, 0); PG8_LDB(B1, 1, 1); PG8_SCHED; PG8_LDA(At, 1, 0); } else {
            PG8_LDB(B0, 1, 0); PG8_LDB(B1, 1, 1); PG8_SCHED; PG8_LDA(At, 1, 0); PG8_STAGE(PG8_SA(0, 1), a2 + hsA, voffA); } PG8_TOUCH(t + 1);
            if constexpr ((VAR & 96) == 96) { PG8_WAIT_L(0); PG8_BAR; PG8_MMA(0, 0, At, B0); PG8_MMA(0, 1, At, B1); PG8_WAIT_V(10); PG8_BAR; PG8_SCHED; } else
            if constexpr (VAR & 32) { if (wr == 1) PG8_WAIT_V(8); PG8_WAIT_L(0); PG8_BAR; PG8_MMA(0, 0, At, B0); PG8_MMA(0, 1, At, B1); if (wr == 0) PG8_WAIT_V(8); PG8_BAR; PG8_SCHED; } else {
            PG8_WAIT_V(8); PG8_WAIT_L(0); PG8_BAR; PG8_MMA(0, 0, At, B0); PG8_MMA(0, 1, At, B1); PG8_BAR; PG8_SCHED; }
            if constexpr (VAR & 16) {
            PG8_LDA(At, 1, 1); PG8_STAGE(PG8_SB(1, 0), b3, voffB); PG8_STAGE(PG8_SB(1, 1), b3 + hsB, voffB);
            PG8_WAIT_V(6); PG8_WAIT_L(0); PG8_BAR; PG8_MMA(1, 0, At, B0); PG8_SCHED; PG8_STAGE(PG8_SA(1, 0), a3, voffA); PG8_SCHED; PG8_MMA(1, 1, At, B1); PG8_BAR; PG8_SCHED;
            } else {
            if constexpr (VAR & 256) { PG8_STAGE(PG8_SB(1, 0), b3, voffB); PG8_STAGE(PG8_SB(1, 1), b3 + hsB, voffB); PG8_STAGE(PG8_SA(1, 0), a3, voffA); PG8_SCHED; PG8_LDA(At, 1, 1); } else {
            PG8_LDA(At, 1, 1); PG8_STAGE(PG8_SB(1, 0), b3, voffB); PG8_STAGE(PG8_SB(1, 1), b3 + hsB, voffB); PG8_STAGE(PG8_SA(1, 0), a3, voffA); }
            if constexpr ((VAR & 96) == 96) { PG8_WAIT_L(0); PG8_BAR; PG8_MMA(1, 0, At, B0); PG8_MMA(1, 1, At, B1); PG8_WAIT_V(9); PG8_BAR; PG8_SCHED; } else
            if constexpr (VAR & 32) { if (wr == 1) PG8_WAIT_V(8); PG8_WAIT_L(0); PG8_BAR; PG8_MMA(1, 0, At, B0); PG8_MMA(1, 1, At, B1); if (wr == 0) PG8_WAIT_V(8); PG8_BAR; PG8_SCHED; } else {
            PG8_WAIT_V(8); PG8_WAIT_L(0); PG8_BAR; PG8_MMA(1, 0, At, B0); PG8_MMA(1, 1, At, B1); PG8_BAR; PG8_SCHED; }
            }
            } else {
            PG8_LDB(B0, 0, 0); PG8_SCHED; PG8_LDA(At, 0, 0); PG8_STAGE(PG8_SA(1, 1), a1 + hsA, voffA);
            PG8_WAIT_L(8); PG8_BAR; PG8_WAIT_L(0); PG8_MMA(0, 0, At, B0); PG8_BAR; PG8_SCHED;
            PG8_LDB(B1, 0, 1); PG8_STAGE(PG8_SB(0, 0), b2, voffB);
            PG8_BAR; PG8_WAIT_L(0); PG8_MMA(0, 1, At, B1); PG8_BAR;
            PG8_LDA(At, 0, 1); PG8_STAGE(PG8_SA(0, 0), a2, voffA);
            PG8_BAR; PG8_WAIT_L(0); PG8_MMA(1, 0, At, B0); PG8_BAR; PG8_SCHED;
            PG8_STAGE(PG8_SB(0, 1), b2 + hsB, voffB);
            PG8_WAIT_V(6); PG8_BAR; PG8_MMA(1, 1, At, B1); PG8_BAR;
            PG8_LDB(B0, 1, 0); PG8_SCHED; PG8_LDA(At, 1, 0); PG8_STAGE(PG8_SA(0, 1), a2 + hsA, voffA);
            PG8_WAIT_L(8); PG8_BAR; PG8_WAIT_L(0); PG8_MMA(0, 0, At, B0); PG8_BAR; PG8_SCHED;
            PG8_LDB(B1, 1, 1); PG8_STAGE(PG8_SB(1, 0), b3, voffB);
            PG8_BAR; PG8_WAIT_L(0); PG8_MMA(0, 1, At, B1); PG8_BAR;
            PG8_LDA(At, 1, 1); PG8_STAGE(PG8_SA(1, 0), a3, voffA);
            PG8_BAR; PG8_WAIT_L(0); PG8_MMA(1, 0, At, B0); PG8_BAR; PG8_SCHED;
            PG8_STAGE(PG8_SB(1, 1), b3 + hsB, voffB);
            PG8_WAIT_V(6); PG8_BAR; PG8_MMA(1, 1, At, B1); PG8_BAR;
            }
        }
        if constexpr (ALIGN_EPI) { if (wr == 0) PG8_BAR; }
        int pulled = -1;
        if constexpr (Sched::DYNAMIC) { if (has_next && tid == 0) pulled = S.pull(); }
        E(acc, cur, wr, wc, fr, fq); S.done(cur);
        if constexpr (Sched::DYNAMIC) { if (has_next && tid == 0) S.slot[ui & 1] = pulled; }
        if (!has_next) break;
#pragma unroll
        for (int a = 0; a < 2; ++a)
#pragma unroll
            for (int b = 0; b < 2; ++b)
#pragma unroll
                for (int m = 0; m < 4; ++m)
#pragma unroll
                    for (int n = 0; n < 2; ++n) acc[a][b][m][n] = (f32x4){0.f, 0.f, 0.f, 0.f};
        cur = nxt; cA = nA; cB = nB; ++ui;
        if constexpr (ALIGN_EPI) { if (wr == 1) PG8_BAR; }
    }
    if constexpr (VAR & 128) __builtin_amdgcn_s_setprio(0);
    PG8_WAIT_V(0);
    asm volatile("" :: "v"(sink));
    if constexpr (!ALIGN_EPI) { if (wr == 0) PG8_BAR; }
    PG8_BAR;
#undef PG8_TOUCH
#undef PG8_NEXT_PTRS
#undef PG8_SA
#undef PG8_SB
#undef PG8_STAGE
#undef PG8_LDA
#undef PG8_LDB
#undef PG8_MMA
#undef PG8_WAIT_V
#undef PG8_WAIT_L
#undef PG8_BAR
#undef PG8_SCHED
}
}

#ifndef PG8_SP2
#define PG8_SP2 true
#endif
#ifndef PG8_ALIGN
#define PG8_ALIGN true
#endif
#ifndef PG8_VAR
#define PG8_VAR 0
#endif

constexpr int NWAVES = 8;
constexpr int D = 4096, BATCH = 4, SEQ = 4096, CTXL = 256, DFF = 11008, NMOD = 9;
constexpr int ML = BATCH * SEQ;
constexpr int MC = BATCH * CTXL;
constexpr int MA = ML + MC;
constexpr int SW = 1024, SG = 64, SK = 16, SP = 64;
constexpr int PW_ = 2048;
constexpr int DIN = SW + PW_ + 2 * D;
constexpr int CT = 32;
constexpr int NCH = SEQ / CT;
constexpr int A2R = BATCH * NCH;
constexpr int A2K = CT * SK + 4 * SP;
constexpr float RMS_EPS = 1e-6f;

constexpr size_t MiB = 1u << 20;
constexpr size_t WS_CTL = 0, CTL_ZERO_BYTES = 32768;
constexpr size_t WS_MOD = 1 * MiB;
constexpr size_t WS_BBAR = 2 * MiB;
constexpr size_t WS_LAMB = 3 * MiB;
constexpr size_t WS_USC = 4 * MiB;
constexpr size_t WS_S = 6 * MiB;
constexpr size_t WS_A2 = 38 * MiB;
constexpr size_t WS_BTY = 86 * MiB;
constexpr size_t WS_BTS = 134 * MiB;
constexpr size_t WS_W1A = 150 * MiB, WS_W1B = 322 * MiB, WS_W2A = 408 * MiB, WS_W2B = 580 * MiB;
constexpr size_t WS_WIN = 666 * MiB, WS_WGLU = 754 * MiB, WS_WA = 758 * MiB, WS_WPOOL = 766 * MiB, WS_WB = 768 * MiB, WS_WOUT = 784 * MiB;
constexpr size_t WS_U = 816 * MiB;
constexpr size_t WS_MIX = WS_U, WS_YB = WS_U + 64 * MiB;
constexpr size_t WS_H = 952 * MiB;
constexpr size_t WS_UP = WS_H, WS_GT = WS_H + 64 * MiB;
constexpr size_t WS_X = 1318 * MiB;
constexpr size_t WS_Z = 1590 * MiB, WS_GL = 1622 * MiB, WS_T = 1654 * MiB;
constexpr size_t WS_XB = 1782 * MiB;
constexpr size_t WS_END = 1918 * MiB;
static_assert(WS_H + (size_t)MA * DFF * 2 <= WS_X && WS_GT + (size_t)ML * 2 * D * 2 <= WS_X && WS_U + (size_t)MA * D * 2 <= WS_H && WS_X + (size_t)MA * D * 4 <= WS_Z, "ws map");
constexpr int CW_TMO = 0, CW_QUEUE = 64, CW_DONE = 512  , CW_DYN = 1536  , CW_BAR = 4096;

constexpr int RING_OFF = 0;
constexpr int MISC_OFF = 144000;
constexpr int LDS_BYTES = 147456;

#define GAS __attribute__((address_space(1)))
#define LAS __attribute__((address_space(3)))
typedef unsigned short bf16;
typedef unsigned v4u __attribute__((ext_vector_type(4)));
typedef unsigned v2u __attribute__((ext_vector_type(2)));
typedef float f32x4 __attribute__((ext_vector_type(4)));
typedef GAS unsigned gu32;
#define RLX_AGENT __ATOMIC_RELAXED, __HIP_MEMORY_SCOPE_AGENT
#define LDS_WAIT() asm volatile("s_waitcnt lgkmcnt(0)" ::: "memory")
#define VM_WAIT() asm volatile("s_waitcnt vmcnt(0)" ::: "memory")
using pg8::cvt_pk_bf16; using pg8::sigmoidf_fast; using pg8::bf_lo; using pg8::bf_hi;

#define XB_TMO      128
#define XB_XCNT(j)  (256  + 64 * (j))
#define XB_XSUB(j)  (1280 + 64 * (j))
#define XB_XGEN(j)  (2304 + 64 * (j))
#define XB_TOP      3328
#define XB_TOPGEN   3392
#define XCD_BAR_WORDS 3456
#define XB_SPIN_CAP (1u << 18)
__device__ __forceinline__ unsigned xb_ld(unsigned* p)              { return __hip_atomic_load(p, __ATOMIC_RELAXED, __HIP_MEMORY_SCOPE_AGENT); }
__device__ __forceinline__ unsigned xb_add(unsigned* p, unsigned v) { return __hip_atomic_fetch_add(p, v, __ATOMIC_RELAXED, __HIP_MEMORY_SCOPE_AGENT); }
__device__ __forceinline__ unsigned xb_xcc_id() { return (unsigned)__builtin_amdgcn_s_getreg((3 << 11) | 20) & 0xFu; }
#define XB_SPIN(cond, bar) do { unsigned _sp = 0; while (cond) { __builtin_amdgcn_s_sleep(1); \
    if ((++_sp & 255u) == 0u) { if (xb_ld(&(bar)[XB_TMO])) break; if (_sp > XB_SPIN_CAP) { atomicAdd(&(bar)[XB_TMO], 1u); break; } } } } while (0)
struct XcdBarrier { unsigned* bar; unsigned x; volatile LAS unsigned* st; };
__device__ __forceinline__ XcdBarrier xcd_barrier_post(unsigned* bar, volatile LAS unsigned* st) {
    XcdBarrier b; b.bar = bar; b.x = xb_xcc_id(); b.st = st;
    if (threadIdx.x == 0) (void)xb_add(&bar[XB_XCNT(b.x)], 1u);
    return b;
}
__device__ __forceinline__ void xcd_barrier_complete(unsigned* bar, unsigned x, unsigned& nloc, unsigned& nx) {
    const unsigned G = gridDim.x * gridDim.y * gridDim.z;
    unsigned sum, cnt, mine, sp = 0u;
    for (;;) {
        sum = 0u; cnt = 0u; mine = 0u;
#pragma unroll
        for (unsigned j = 0; j < 16; ++j) { const unsigned c = xb_ld(&bar[XB_XCNT(j)]); sum += c; cnt += (c > 0u) ? 1u : 0u; mine = (j == x) ? c : mine; }
        if (sum == G) break;
        __builtin_amdgcn_s_sleep(1);
        if ((++sp & 255u) == 0u) { if (xb_ld(&bar[XB_TMO])) break; if (sp > XB_SPIN_CAP) { atomicAdd(&bar[XB_TMO], 1u); break; } }
    }
    nloc = mine > 0u ? mine : 1u; nx = cnt > 0u ? cnt : 1u;
}
__device__ __forceinline__ void xcd_barrier(const XcdBarrier& b) {
    asm volatile("s_waitcnt vmcnt(0)" ::: "memory");
    __syncthreads();
    if (threadIdx.x == 0) {
        unsigned* bar = b.bar;
        __builtin_amdgcn_s_waitcnt(0);
        unsigned nloc = b.st[0], nx = b.st[1];
        if (nloc == 0u) { xcd_barrier_complete(bar, b.x, nloc, nx); b.st[0] = nloc; b.st[1] = nx; }
        const unsigned old = xb_add(&bar[XB_XSUB(b.x)], 1u);
        const unsigned gen = old / nloc;
        if (old + 1u == (gen + 1u) * nloc) {
            __builtin_amdgcn_fence(__ATOMIC_RELEASE, "agent");
            asm volatile("s_waitcnt vmcnt(0)" ::: "memory");
            const unsigned og = xb_add(&bar[XB_TOP], 1u);
            const unsigned tg = og / nx;
            if (og + 1u == (tg + 1u) * nx) xb_add(&bar[XB_TOPGEN], 1u);
            else XB_SPIN(xb_ld(&bar[XB_TOPGEN]) == tg, bar);
            __builtin_amdgcn_fence(__ATOMIC_ACQUIRE, "agent");
            xb_add(&bar[XB_XGEN(b.x)], 1u);
            asm volatile("s_waitcnt vmcnt(0)" ::: "memory");
        } else {
            XB_SPIN(xb_ld(&bar[XB_XGEN(b.x)]) == gen, bar);
            __builtin_amdgcn_fence(__ATOMIC_ACQUIRE, "agent");
            asm volatile("s_waitcnt vmcnt(0)" ::: "memory");
        }
    }
    __syncthreads();
}

struct Frame {
    LAS unsigned char* lds;
    int tid, lane, wave, vcu, G;
    const float* in[27];
    float* out; unsigned char* ws;
};
enum { I_X = 0, I_C, I_CTX, I_CCTX, I_WMOD, I_BMOD, I_NORMG, I_FINALG, I_F1IN, I_F1OUT, I_F2IN, I_F2OUT, I_WIN, I_LRE, I_LIM, I_LSTEP, I_BRE, I_BIM, I_CRE, I_CIM, I_SD, I_WGLU, I_WBA, I_POOLW, I_POOLS, I_WBB, I_WOUT };

__device__ __forceinline__ float wave_sum(float v) {
#pragma unroll
    for (int o = 1; o < 64; o <<= 1) v += __shfl_xor(v, o);
    return v;
}

using pg8::Unit; using pg8::BM; using pg8::HALF;
template <int MODE> struct EpiGated {
    static constexpr bool PERM = true;
    bf16* O; int ldo;
    __device__ __forceinline__ void operator()(const f32x4 (&acc)[2][2][4][2], const Unit& u, int wr, int wc, int fr, int fq) const {
        const int row0 = u.pm * BM + wr * 64 + fr, col0 = u.pn * HALF + wc * 32 + 8 * fq;
#pragma unroll
        for (int ai = 0; ai < 2; ++ai)
#pragma unroll
            for (int m = 0; m < 4; ++m) {
                float o[8];
#pragma unroll
                for (int n = 0; n < 2; ++n)
#pragma unroll
                    for (int j = 0; j < 4; ++j) { const float a = acc[ai][0][m][n][j], b = acc[ai][1][m][n][j];
                        o[n * 4 + j] = MODE == 0 ? a * sigmoidf_fast(a) * b : a * sigmoidf_fast(b); }
                v4u w; w.x = cvt_pk_bf16(o[0], o[1]); w.y = cvt_pk_bf16(o[2], o[3]); w.z = cvt_pk_bf16(o[4], o[5]); w.w = cvt_pk_bf16(o[6], o[7]);
                *(v4u*)(O + (size_t)(row0 + ai * HALF + m * 16) * ldo + col0) = w;
            }
    }
};
template <bool IN_BF16, bool OUT_BF16> struct EpiResid {
    static constexpr bool PERM = true;
    const void* in_lat; const float* in_ctx; void* X; const float* mod; int gidx; float coef; float* part;
    __device__ __forceinline__ void operator()(const f32x4 (&acc)[2][2][4][2], const Unit& u, int wr, int wc, int fr, int fq) const {
        const int row0 = u.pm * BM + wr * 64 + fr, col0 = u.pn * BM + wc * 32 + 8 * fq;
        if (u.g != 0) {
#pragma unroll
            for (int ai = 0; ai < 2; ++ai)
#pragma unroll
                for (int m = 0; m < 4; ++m) { float* rowp = part + ((size_t)(u.g - 1) * MC + (size_t)(row0 + ai * HALF + m * 16 - ML)) * D + col0;
#pragma unroll
                    for (int bj = 0; bj < 2; ++bj) { *(f32x4*)(rowp + bj * HALF) = acc[ai][bj][m][0]; *(f32x4*)(rowp + bj * HALF + 4) = acc[ai][bj][m][1]; } }
            return;
        }
        const bool isctx = u.pm >= ML / BM; const int mi = isctx ? 4 : (u.pm >> 4);
        const float* gp = mod + (size_t)mi * (NMOD * D) + (size_t)gidx * D + col0;
        f32x4 gv[2][2];
#pragma unroll
        for (int bj = 0; bj < 2; ++bj)
#pragma unroll
            for (int n = 0; n < 2; ++n) gv[bj][n] = *(const f32x4*)(gp + bj * HALF + 4 * n) * coef;
        const float* srcf = isctx ? in_ctx - (size_t)ML * D : (const float*)in_lat; const bf16* srcb = (const bf16*)in_lat;
#pragma unroll
        for (int ai = 0; ai < 2; ++ai) {
            f32x4 xi[4][2][2]; v4u xb[4][2];
#pragma unroll
            for (int m = 0; m < 4; ++m) { const size_t off = (size_t)(row0 + ai * HALF + m * 16) * D + col0;
#pragma unroll
                for (int bj = 0; bj < 2; ++bj) {
                    if constexpr (IN_BF16) xb[m][bj] = *(const v4u*)(srcb + off + bj * HALF);
                    else { xi[m][bj][0] = *(const f32x4*)(srcf + off + bj * HALF); xi[m][bj][1] = *(const f32x4*)(srcf + off + bj * HALF + 4); } } }
            asm volatile("" ::: "memory");
#pragma unroll
            for (int m = 0; m < 4; ++m) { const size_t off = (size_t)(row0 + ai * HALF + m * 16) * D + col0;
#pragma unroll
                for (int bj = 0; bj < 2; ++bj) {
                    f32x4 x0, x1;
                    if constexpr (IN_BF16) { const v4u w = xb[m][bj]; x0 = (f32x4){bf_lo(w.x), bf_hi(w.x), bf_lo(w.y), bf_hi(w.y)}; x1 = (f32x4){bf_lo(w.z), bf_hi(w.z), bf_lo(w.w), bf_hi(w.w)}; }
                    else { x0 = xi[m][bj][0]; x1 = xi[m][bj][1]; }
                    const f32x4 o0 = x0 + gv[bj][0] * acc[ai][bj][m][0], o1 = x1 + gv[bj][1] * acc[ai][bj][m][1];
                    if constexpr (OUT_BF16) { v4u w; w.x = cvt_pk_bf16(o0.x, o0.y); w.y = cvt_pk_bf16(o0.z, o0.w); w.z = cvt_pk_bf16(o1.x, o1.y); w.w = cvt_pk_bf16(o1.z, o1.w);
                        *(v4u*)((bf16*)X + off + bj * HALF) = w; }
                    else { *(f32x4*)((float*)X + off + bj * HALF) = o0; *(f32x4*)((float*)X + off + bj * HALF + 4) = o1; } } }
            asm volatile("" ::: "memory");
        }
    }
};
struct EpiWin {
    static constexpr bool PERM = true;
    bf16* A2; float* USCP; bf16* UP; bf16* GT;
    __device__ __forceinline__ void operator()(const f32x4 (&acc)[2][2][4][2], const Unit& u, int wr, int wc, int fr, int fq) const {
        const int row0 = u.pm * BM + wr * 64 + fr;
        if (u.g != 0) {
#pragma unroll
            for (int ai = 0; ai < 2; ++ai)
#pragma unroll
                for (int m = 0; m < 4; ++m) { float* rowp = USCP + ((size_t)(u.g - 1) * MC + (size_t)(row0 + ai * HALF + m * 16 - ML)) * SW + u.pn * BM + wc * 32 + 8 * fq;
#pragma unroll
                    for (int bj = 0; bj < 2; ++bj) { *(f32x4*)(rowp + bj * HALF) = acc[ai][bj][m][0]; *(f32x4*)(rowp + bj * HALF + 4) = acc[ai][bj][m][1]; } }
            return;
        }
#pragma unroll
        for (int ai = 0; ai < 2; ++ai)
#pragma unroll
            for (int m = 0; m < 4; ++m) { const int row = row0 + ai * HALF + m * 16;
#pragma unroll
                for (int bj = 0; bj < 2; ++bj) {
                    const int cl = bj * HALF + wc * 32 + 8 * fq;
                    f32x4 v0 = acc[ai][bj][m][0], v1 = acc[ai][bj][m][1];
                    bf16* dst;
                    if (u.pn < 4) {
                        const int c = u.pn * BM + cl;
                        { const int b = row >> 12, t = row & 4095, g = c >> 4, k0 = c & 15;
                               dst = A2 + ((size_t)(g * A2R + b * NCH + (t >> 5)) * A2K + (t & 31) * SK + k0); }
                    } else if (u.pn < 12) {
                        const int ch = (u.pn - 4) * BM + cl, b = row >> 12, t = row & 4095;
                        dst = UP + ((size_t)((b * 256 + (ch >> 3)) * SEQ + t) * 8);
                    } else {
#pragma unroll
                        for (int j = 0; j < 4; ++j) { v0[j] = sigmoidf_fast(v0[j]); v1[j] = sigmoidf_fast(v1[j]); }
                        dst = GT + (size_t)row * (2 * D) + (u.pn - 12) * BM + cl;
                    }
                    v4u w; w.x = cvt_pk_bf16(v0[0], v0[1]); w.y = cvt_pk_bf16(v0[2], v0[3]); w.z = cvt_pk_bf16(v1[0], v1[1]); w.w = cvt_pk_bf16(v1[2], v1[3]);
                    *(v4u*)dst = w; } }
    }
};
struct EpiF32G {
    static constexpr bool PERM = false;
    float* C; int ldc; size_t gs;
    __device__ __forceinline__ void operator()(const f32x4 (&acc)[2][2][4][2], const Unit& u, int wr, int wc, int fr, int fq) const {
        const int row0 = u.pm * BM + wr * 64 + fr, col0 = u.pn * BM + wc * 32 + 4 * fq;
#pragma unroll
        for (int ai = 0; ai < 2; ++ai)
#pragma unroll
            for (int m = 0; m < 4; ++m) { float* rowp = C + (size_t)u.g * gs + (size_t)(row0 + ai * HALF + m * 16) * ldc + col0;
#pragma unroll
                for (int bj = 0; bj < 2; ++bj)
#pragma unroll
                    for (int n = 0; n < 2; ++n) *(f32x4*)(rowp + bj * HALF + n * 16) = acc[ai][bj][m][n]; }
    }
};
__device__ __forceinline__ float gelu_tanh(float x) { const float u2 = 1.5957691216f * (x + 0.044715f * x * x * x); return x * sigmoidf_fast(u2); }
struct EpiY {
    static constexpr bool PERM = true;
    bf16* Z;
    __device__ __forceinline__ void operator()(const f32x4 (&acc)[2][2][4][2], const Unit& u, int wr, int wc, int fr, int fq) const {
        const int row0 = u.pm * BM + wr * 64 + fr;
#pragma unroll
        for (int ai = 0; ai < 2; ++ai)
#pragma unroll
            for (int m = 0; m < 4; ++m) { const int R = row0 + ai * HALF + m * 16, b = R >> 7, cc = R & 127;
#pragma unroll
                for (int bj = 0; bj < 2; ++bj) { const int n_ = u.pn * BM + bj * HALF + wc * 32 + 8 * fq, tl = n_ >> 4, k0 = n_ & 15;
                    float o[8];
#pragma unroll
                    for (int n = 0; n < 2; ++n)
#pragma unroll
                        for (int j = 0; j < 4; ++j) o[n * 4 + j] = gelu_tanh(acc[ai][bj][m][n][j]);
                    v4u w; w.x = cvt_pk_bf16(o[0], o[1]); w.y = cvt_pk_bf16(o[2], o[3]); w.z = cvt_pk_bf16(o[4], o[5]); w.w = cvt_pk_bf16(o[6], o[7]);
                    *(v4u*)(Z + (size_t)(b * SEQ + cc * CT + tl) * SW + u.g * SK + k0) = w; } }
    }
};
struct EpiPool {
    static constexpr bool PERM = true;
    bf16* YB; const float* scale;
    __device__ __forceinline__ void operator()(const f32x4 (&acc)[2][2][4][2], const Unit& u, int wr, int wc, int fr, int fq) const {
        const int row0 = u.pm * BM + wr * 64 + fr, col0 = u.g * 512 + u.pn * BM + wc * 32 + 8 * fq;
        f32x4 sv[2][2];
#pragma unroll
        for (int bj = 0; bj < 2; ++bj)
#pragma unroll
            for (int n = 0; n < 2; ++n) sv[bj][n] = *(const f32x4*)(scale + col0 + bj * HALF + 4 * n);
#pragma unroll
        for (int ai = 0; ai < 2; ++ai)
#pragma unroll
            for (int m = 0; m < 4; ++m) { bf16* rowp = YB + (size_t)(row0 + ai * HALF + m * 16) * PW_ + col0;
#pragma unroll
                for (int bj = 0; bj < 2; ++bj) { const f32x4 v0 = acc[ai][bj][m][0] * sv[bj][0], v1 = acc[ai][bj][m][1] * sv[bj][1];
                    v4u w; w.x = cvt_pk_bf16(v0[0], v0[1]); w.y = cvt_pk_bf16(v0[2], v0[3]); w.z = cvt_pk_bf16(v1[0], v1[1]); w.w = cvt_pk_bf16(v1[2], v1[3]);
                    *(v4u*)(rowp + bj * HALF) = w; } }
    }
};
template <bool ADD> struct EpiBranch {
    static constexpr bool PERM = true;
    bf16* T; const bf16* GT; int goff;
    __device__ __forceinline__ void operator()(const f32x4 (&acc)[2][2][4][2], const Unit& u, int wr, int wc, int fr, int fq) const {
        const int row0 = u.pm * BM + wr * 64 + fr, col0 = u.pn * BM + wc * 32 + 8 * fq;
#pragma unroll
        for (int ai = 0; ai < 2; ++ai) {
            v4u gws[4][2], tws[4][2];
#pragma unroll
            for (int m = 0; m < 4; ++m) { const size_t row = (size_t)(row0 + ai * HALF + m * 16);
#pragma unroll
                for (int bj = 0; bj < 2; ++bj) { gws[m][bj] = *(const v4u*)(GT + row * (2 * D) + goff + col0 + bj * HALF);
                    if (ADD) tws[m][bj] = *(const v4u*)(T + row * D + col0 + bj * HALF); else tws[m][bj] = (v4u){0u, 0u, 0u, 0u}; } }
            asm volatile("" ::: "memory");
#pragma unroll
            for (int m = 0; m < 4; ++m) { const size_t row = (size_t)(row0 + ai * HALF + m * 16);
#pragma unroll
                for (int bj = 0; bj < 2; ++bj) {
                    const v4u gw = gws[m][bj]; const v4u tw = tws[m][bj];
                    bf16* tp = T + row * D + col0 + bj * HALF;
                    float o[8]; const f32x4 v0 = acc[ai][bj][m][0], v1 = acc[ai][bj][m][1];
                    o[0] = bf_lo(gw.x) * v0[0]; o[1] = bf_hi(gw.x) * v0[1]; o[2] = bf_lo(gw.y) * v0[2]; o[3] = bf_hi(gw.y) * v0[3];
                    o[4] = bf_lo(gw.z) * v1[0]; o[5] = bf_hi(gw.z) * v1[1]; o[6] = bf_lo(gw.w) * v1[2]; o[7] = bf_hi(gw.w) * v1[3];
                    if (ADD) { o[0] += bf_lo(tw.x); o[1] += bf_hi(tw.x); o[2] += bf_lo(tw.y); o[3] += bf_hi(tw.y); o[4] += bf_lo(tw.z); o[5] += bf_hi(tw.z); o[6] += bf_lo(tw.w); o[7] += bf_hi(tw.w); }
                    v4u w; w.x = cvt_pk_bf16(o[0], o[1]); w.y = cvt_pk_bf16(o[2], o[3]); w.z = cvt_pk_bf16(o[4], o[5]); w.w = cvt_pk_bf16(o[6], o[7]);
                    *(v4u*)tp = w; } }
            asm volatile("" ::: "memory");
        }
    }
};

__device__ __forceinline__ void p0_mod(Frame& F) {
    LAS float* sc = (LAS float*)(F.lds);
    LAS float* red = (LAS float*)(F.lds + 81920);
    const float* c = F.in[I_C]; const float* cctx = F.in[I_CCTX]; const float* wmod = F.in[I_WMOD]; const float* bmod = F.in[I_BMOD];
    float* mod = (float*)(F.ws + WS_MOD);
    for (int i = F.tid; i < 5 * D; i += NWAVES * 64) { const int v = i >> 12, k = i & (D - 1); const float x = v < 4 ? c[v * D + k] : cctx[k]; sc[i] = x * sigmoidf_fast(x); }
    __syncthreads();
    const int col4 = F.tid % 36, ksub = F.tid / 36;
    for (int chunk = blockIdx.x; chunk < 256; chunk += F.G) {
        float acc[5][4];
#pragma unroll
        for (int v = 0; v < 5; ++v)
#pragma unroll
            for (int e = 0; e < 4; ++e) acc[v][e] = 0.f;
        if (ksub < 14) {
            const float* wp = wmod + (size_t)chunk * 144 + col4 * 4 + (size_t)ksub * (NMOD * D);
            constexpr size_t KSTR = (size_t)14 * NMOD * D;
            int k = ksub;
            for (; k + 15 * 14 < D; k += 16 * 14) {
                f32x4 w[16];
#pragma unroll
                for (int i = 0; i < 16; ++i) { w[i] = __builtin_nontemporal_load((const f32x4*)wp); wp += KSTR; }
#pragma unroll
                for (int i = 0; i < 16; ++i)
#pragma unroll
                    for (int v = 0; v < 5; ++v) { const float sv = sc[v * D + k + 14 * i];
#pragma unroll
                        for (int e = 0; e < 4; ++e) acc[v][e] += sv * w[i][e]; }
            }
            for (; k < D; k += 14) { const f32x4 w = __builtin_nontemporal_load((const f32x4*)wp); wp += KSTR;
#pragma unroll
                for (int v = 0; v < 5; ++v) { const float sv = sc[v * D + k];
#pragma unroll
                    for (int e = 0; e < 4; ++e) acc[v][e] += sv * w[e]; } }
#pragma unroll
            for (int v = 0; v < 5; ++v)
#pragma unroll
                for (int e = 0; e < 4; ++e) red[(ksub * 36 + col4) * 20 + v * 4 + e] = acc[v][e];
        }
        __syncthreads();
        for (int o = F.tid; o < 720; o += NWAVES * 64) { const int v = o / 144, cl = o % 144; float s = bmod[chunk * 144 + cl];
#pragma unroll
            for (int q = 0; q < 14; ++q) s += red[(q * 36 + (cl >> 2)) * 20 + v * 4 + (cl & 3)];
            mod[(size_t)v * (NMOD * D) + chunk * 144 + cl] = s; }
        __syncthreads();
    }
}

__device__ __forceinline__ void p0_transpose_item(const float* W, int N, bf16* WT, int ldt, int dst_row0, LAS float* scr, int k0, int n0, int lane) {
    f32x4 v[16];
    const float* src = W + (size_t)(k0 + (lane >> 4)) * N + n0 + (lane & 15) * 4;
#pragma unroll
    for (int i = 0; i < 16; ++i) v[i] = __builtin_nontemporal_load((const f32x4*)(src + (size_t)(4 * i) * N));
#pragma unroll
    for (int i = 0; i < 16; ++i) { LAS float* d = scr + (4 * i + (lane >> 4)) * 65 + (lane & 15) * 4; d[0] = v[i].x; d[1] = v[i].y; d[2] = v[i].z; d[3] = v[i].w; }
    LDS_WAIT(); asm volatile("" ::: "memory");
    const int c = lane >> 3, nn = lane & 7;
#pragma unroll
    for (int j = 0; j < 8; ++j) { const int n = nn + 8 * j; const LAS float* s = scr + (8 * c) * 65 + n;
        v4u o; o.x = cvt_pk_bf16(s[0 * 65], s[1 * 65]); o.y = cvt_pk_bf16(s[2 * 65], s[3 * 65]); o.z = cvt_pk_bf16(s[4 * 65], s[5 * 65]); o.w = cvt_pk_bf16(s[6 * 65], s[7 * 65]);
        __builtin_nontemporal_store(o, (GAS v4u*)(WT + (size_t)(dst_row0 + n) * ldt + k0 + 8 * c)); }
    LDS_WAIT(); asm volatile("" ::: "memory");
}
constexpr int IT_FA = (D / 64) * (2 * DFF / 64), IT_FB = (DFF / 64) * (D / 64), IT_WIN = (D / 64) * (DIN / 64), IT_GLU = (SW / 64) * (2 * SW / 64), IT_WA = (SW / 64) * (D / 64),
              IT_POOL = 4 * (512 / 64) * (512 / 64), IT_WB = (PW_ / 64) * (D / 64), IT_WOUT = (D / 64) * (D / 64);
constexpr int Q_W1A = IT_FA, Q_W1B = Q_W1A + IT_FB, Q_WIN = Q_W1B + IT_WIN, Q_POOL = Q_WIN + IT_POOL, Q_WB = Q_POOL + IT_WB, Q_GLU = Q_WB + IT_GLU, Q_WA = Q_GLU + IT_WA,
              Q_WOUT = Q_WA + IT_WOUT, Q_W2A = Q_WOUT + IT_FA, Q_W2B = Q_W2A + IT_FB;
constexpr int IT_TOTAL = Q_W2B;
__device__ __forceinline__ int gated_row(int n0, int half) { const int j = n0 < half ? n0 : n0 - half; return (j >> 7) * 256 + (j & 127) + (n0 < half ? 0 : 128); }
__device__ __forceinline__ void p0_one_item(Frame& F, int r, LAS float* scr) {
    unsigned char* ws = F.ws; const int lane = F.lane;
#define TR_PLAIN(W, Kd, Nd, WT) do { const int nblk = (Nd) / 64, kb = r / nblk, nb = r % nblk; p0_transpose_item(W, Nd, (bf16*)(WT), Kd, 64 * nb, scr, 64 * kb, 64 * nb, lane); } while (0)
#define TR_GATED(W, Kd, Nd, WT) do { const int nblk = (Nd) / 64, kb = r / nblk, nb = r % nblk; p0_transpose_item(W, Nd, (bf16*)(WT), Kd, gated_row(64 * nb, (Nd) / 2), scr, 64 * kb, 64 * nb, lane); } while (0)
    if (r < IT_FA) { TR_GATED(F.in[I_F1IN], D, 2 * DFF, ws + WS_W1A); return; } r -= IT_FA;
    if (r < IT_FB) { TR_PLAIN(F.in[I_F1OUT], DFF, D, ws + WS_W1B); return; } r -= IT_FB;
    if (r < IT_WIN) { TR_PLAIN(F.in[I_WIN], D, DIN, ws + WS_WIN); return; } r -= IT_WIN;
    if (r < IT_POOL) { const int gi = r / 64; r %= 64; TR_PLAIN(F.in[I_POOLW] + (size_t)gi * 512 * 512, 512, 512, ws + WS_WPOOL + (size_t)gi * 512 * 512 * 2); return; } r -= IT_POOL;
    if (r < IT_WB) { TR_PLAIN(F.in[I_WBB], PW_, D, ws + WS_WB); return; } r -= IT_WB;
    if (r < IT_GLU) { TR_GATED(F.in[I_WGLU], SW, 2 * SW, ws + WS_WGLU); return; } r -= IT_GLU;
    if (r < IT_WA) { TR_PLAIN(F.in[I_WBA], SW, D, ws + WS_WA); return; } r -= IT_WA;
    if (r < IT_WOUT) { TR_PLAIN(F.in[I_WOUT], D, D, ws + WS_WOUT); return; } r -= IT_WOUT;
    if (r < IT_FA) { TR_GATED(F.in[I_F2IN], D, 2 * DFF, ws + WS_W2A); return; } r -= IT_FA;
    TR_PLAIN(F.in[I_F2OUT], DFF, D, ws + WS_W2B);
#undef TR_PLAIN
#undef TR_GATED
}
__device__ __forceinline__ bool fill_transposes(Frame& F, int mandatory, unsigned* done_ctr) {
    LAS float* scr = (LAS float*)(F.lds + F.wave * 16640);
    volatile LAS int* sh = (volatile LAS int*)(F.lds + MISC_OFF + 64);
    unsigned* q = (unsigned*)(F.ws + WS_CTL) + CW_QUEUE;
    constexpr int PER_WAVE = 2, CHB = PER_WAVE * NWAVES;
    for (;;) {
        if (F.tid == 0) { int base = -1; const int head = (int)__hip_atomic_load(q, __ATOMIC_RELAXED, __HIP_MEMORY_SCOPE_AGENT);
            const bool go = head < mandatory || (head < IT_TOTAL && done_ctr != nullptr && __hip_atomic_load(done_ctr, __ATOMIC_RELAXED, __HIP_MEMORY_SCOPE_AGENT) < (unsigned)F.G);
            if (go) { base = (int)__hip_atomic_fetch_add(q, (unsigned)CHB, __ATOMIC_RELAXED, __HIP_MEMORY_SCOPE_AGENT); if (base >= IT_TOTAL) base = -2; }
            else if (head >= IT_TOTAL) base = -2;
            sh[0] = base; }
        __syncthreads();
        const int base = sh[0];
        __syncthreads();
        if (base < 0) return base == -2;
        const int b0 = base + F.wave * PER_WAVE, end = b0 + PER_WAVE < IT_TOTAL ? b0 + PER_WAVE : IT_TOTAL;
        for (int it = b0; it < end; ++it) p0_one_item(F, it, scr);
    }
}
__device__ __forceinline__ void phase_done(Frame& F, unsigned* done_ctr) {
    __syncthreads();
    if (F.tid == 0) __hip_atomic_fetch_add(done_ctr, 1u, __ATOMIC_RELAXED, __HIP_MEMORY_SCOPE_AGENT);
}

typedef float f32x2 __attribute__((ext_vector_type(2)));
constexpr int KFS = 272;
__device__ __forceinline__ void p0_ssm_part(Frame& F, int g, int part) {
    LAS f32x2* PWR = (LAS f32x2*)(F.lds);
    LAS f32x2* BB = (LAS f32x2*)(F.lds + 33792);
    LAS f32x2* CC = (LAS f32x2*)(F.lds + 33792 + 16384);
    LAS float* KF = (LAS float*)(F.lds + 33792 + 32768);
    const int tid = F.tid;
    if (tid < 128) {
        const int dir = tid >> 6, p = tid & 63, idx = (dir * SG + g) * SP + p;
        const double lr = fmin((double)F.in[I_LRE][idx], -1e-4), li = (double)F.in[I_LIM][idx], st = exp((double)F.in[I_LSTEP][dir * SG + g]);
        const double mag = exp(lr * st), ang = li * st, lbr = mag * cos(ang), lbi = mag * sin(ang);
        const double nr = lbr - 1.0, ni = lbi, den = lr * lr + li * li, fr_ = (nr * lr + ni * li) / den, fi_ = (ni * lr - nr * li) / den;
        double pr = 1.0, pi = 0.0;
        for (int tau = 0; tau <= CT; ++tau) { PWR[(dir * SP + p) * 33 + tau] = (f32x2){(float)pr, (float)pi}; const double t = pr * lbr - pi * lbi; pi = pr * lbi + pi * lbr; pr = t; }
        f32x2* bbar = (f32x2*)(F.ws + WS_BBAR);
        for (int k = 0; k < SK; ++k) { const double br = (double)F.in[I_BRE][idx * SK + k], bi = (double)F.in[I_BIM][idx * SK + k];
            const f32x2 bb = (f32x2){(float)(fr_ * br - fi_ * bi), (float)(fr_ * bi + fi_ * br)}; BB[(dir * SP + p) * SK + k] = bb; if (part == 0) bbar[(size_t)idx * SK + k] = bb; }
        if (part == 0) { f32x2* lamb = (f32x2*)(F.ws + WS_LAMB); f32x2* lamT = (f32x2*)(F.ws + WS_LAMB + 65536);
            lamb[idx] = (f32x2){(float)lbr, (float)lbi}; lamT[idx] = PWR[(dir * SP + p) * 33 + CT]; }
    }
    for (int o = tid; o < 2048; o += NWAVES * 64) { const int dir = o >> 10, k = (o >> 6) & 15, p = o & 63, cidx = ((dir * SG + g) * SK + k) * SP + p; CC[(dir * SP + p) * SK + k] = (f32x2){F.in[I_CRE][cidx], F.in[I_CIM][cidx]}; }
    __syncthreads();
    for (int combo = tid; combo < 1024; combo += NWAVES * 64) { const int dir = combo >> 9, tau = (combo >> 4) & 31, k = combo & 15;
        float a[16];
#pragma unroll
        for (int e = 0; e < 16; ++e) a[e] = 0.f;
        for (int p = 0; p < SP; ++p) { const f32x2 c = CC[(dir * SP + p) * SK + k], w = PWR[(dir * SP + p) * 33 + tau]; const float gr = c.x * w.x - c.y * w.y, gi = c.x * w.y + c.y * w.x;
#pragma unroll
            for (int e = 0; e < 16; ++e) { const f32x2 b = BB[(dir * SP + p) * SK + e]; a[e] += gr * b.x - gi * b.y; } }
#pragma unroll
        for (int e = 0; e < 16; ++e) KF[(dir * CT + tau) * KFS + k * SK + e] = a[e]; }
    __syncthreads();
    bf16* bty = (bf16*)(F.ws + WS_BTY) + (size_t)g * (CT * SK) * A2K;
    const float* dvec = F.in[I_SD] + g * SK;
    for (int ch = tid; ch < 128 * (A2K / 8); ch += NWAVES * 64) { const int n = part * 128 + ch / (A2K / 8), q = ch % (A2K / 8), t = n >> 4, k = n & 15;
        float v[8];
        if (q < 64) { const int s = q >> 1, k0 = (q & 1) * 8;
            f32x4 x0 = (f32x4){0.f, 0.f, 0.f, 0.f}, x1 = x0;
            if (t >= s) { const LAS f32x4* kp = (const LAS f32x4*)(KF + (t - s) * KFS + k * SK + k0); x0 += kp[0]; x1 += kp[1]; }
            if (s >= t) { const LAS f32x4* kp = (const LAS f32x4*)(KF + (CT + (s - t)) * KFS + k * SK + k0); x0 += kp[0]; x1 += kp[1]; }
            v[0] = x0.x; v[1] = x0.y; v[2] = x0.z; v[3] = x0.w; v[4] = x1.x; v[5] = x1.y; v[6] = x1.z; v[7] = x1.w;
            if (t == s && (k >> 3) == (q & 1)) { const float dk = dvec[k];
#pragma unroll
                for (int e = 0; e < 8; ++e) v[e] += ((k & 7) == e) ? dk : 0.f; }
        } else { const int pt = (q - 64) >> 3, p0 = ((q - 64) & 7) * 8, dir = pt >> 1, tau = dir == 0 ? t + 1 : CT - t;
#pragma unroll
            for (int e = 0; e < 8; ++e) { const int p = p0 + e; const f32x2 c = CC[(dir * SP + p) * SK + k], w = PWR[(dir * SP + p) * 33 + tau];
                const float re = c.x * w.x - c.y * w.y, im = c.x * w.y + c.y * w.x; v[e] = (pt & 1) ? -im : re; }
        }
        v4u o; o.x = cvt_pk_bf16(v[0], v[1]); o.y = cvt_pk_bf16(v[2], v[3]); o.z = cvt_pk_bf16(v[4], v[5]); o.w = cvt_pk_bf16(v[6], v[7]);
        *(v4u*)(bty + (size_t)n * A2K + q * 8) = o; }
    bf16* bts = (bf16*)(F.ws + WS_BTS) + (size_t)g * 256 * (CT * SK);
    for (int ch = tid; ch < 64 * 64; ch += NWAVES * 64) { const int p = ch >> 6, q = ch & 63, pt = part, n = pt * 64 + p, dir = pt >> 1, s = q >> 1, k0 = (q & 1) * 8, tau = dir == 0 ? CT - 1 - s : s;
        const f32x2 w = PWR[(dir * SP + p) * 33 + tau]; float v[8];
#pragma unroll
        for (int e = 0; e < 8; ++e) { const f32x2 b = BB[(dir * SP + p) * SK + k0 + e]; const float re = w.x * b.x - w.y * b.y, im = w.x * b.y + w.y * b.x; v[e] = (pt & 1) ? im : re; }
        v4u o; o.x = cvt_pk_bf16(v[0], v[1]); o.y = cvt_pk_bf16(v[2], v[3]); o.z = cvt_pk_bf16(v[4], v[5]); o.w = cvt_pk_bf16(v[6], v[7]);
        *(v4u*)(bts + (size_t)n * (CT * SK) + q * 8) = o; }
    __syncthreads();
}

template <bool FINAL, bool CTXSUM = false>
__device__ __forceinline__ void norm_rows(Frame& F, const float* in_lat, const float* in_ctx, int nrows, const float* gvec, int shift_idx, int scale_idx, bf16* outb, float* outf, const float* part = nullptr) {
    const int gw = F.vcu * NWAVES + F.wave, NGW = F.G * NWAVES;
    const float* mod = (const float*)(F.ws + WS_MOD);
    for (int m = gw; m < nrows; m += NGW) {
        const bool isctx = m >= ML; const int mi = isctx ? 4 : (m >> 12);
        const f32x4* xr = (const f32x4*)(isctx ? in_ctx + (size_t)(m - ML) * D : in_lat + (size_t)m * D) + F.lane;
        f32x4 v[16]; float ss = 0.f;
        if (CTXSUM && isctx) {
            const f32x4* p0 = (const f32x4*)(part + (size_t)(m - ML) * D) + F.lane;
#pragma unroll
            for (int j = 0; j < 16; ++j) v[j] = p0[64 * j];
#pragma unroll
            for (int sp = 1; sp < 4; ++sp) { const f32x4* ps = p0 + (size_t)sp * MC * (D / 4);
#pragma unroll
                for (int j = 0; j < 16; ++j) v[j] += ps[64 * j]; }
            const f32x4* gt = (const f32x4*)(mod + (size_t)4 * (NMOD * D) + (size_t)2 * D) + F.lane;
#pragma unroll
            for (int j = 0; j < 16; ++j) v[j] = xr[64 * j] + (gt[64 * j] * 0.5f) * v[j];
#pragma unroll
            for (int j = 0; j < 16; ++j) ss += (v[j].x * v[j].x + v[j].y * v[j].y) + (v[j].z * v[j].z + v[j].w * v[j].w);
        } else {
#pragma unroll
        for (int j = 0; j < 16; ++j) { v[j] = xr[64 * j]; ss += (v[j].x * v[j].x + v[j].y * v[j].y) + (v[j].z * v[j].z + v[j].w * v[j].w); }
        }
        const float rstd = 1.0f / sqrtf(wave_sum(ss) * (1.0f / D) + RMS_EPS);
        const f32x4* gp = (const f32x4*)gvec + F.lane;
        if constexpr (FINAL) {
            f32x4* op = (f32x4*)(outf + (size_t)m * D) + F.lane;
#pragma unroll
            for (int j = 0; j < 16; ++j) op[64 * j] = v[j] * rstd * gp[64 * j];
        } else {
            const f32x4* shp = (const f32x4*)(mod + (size_t)mi * (NMOD * D) + (size_t)shift_idx * D) + F.lane;
            const f32x4* scp = (const f32x4*)(mod + (size_t)mi * (NMOD * D) + (size_t)scale_idx * D) + F.lane;
            v2u* op = (v2u*)(outb + (size_t)m * D) + F.lane;
#pragma unroll
            for (int j = 0; j < 16; ++j) { const f32x4 o = (v[j] * rstd * gp[64 * j]) * (scp[64 * j] + 1.0f) + shp[64 * j];
                v2u w; w.x = cvt_pk_bf16(o.x, o.y); w.y = cvt_pk_bf16(o.z, o.w); op[64 * j] = w; }
        }
    }
}

template <bool FINAL>
__device__ __forceinline__ void norm_prep(Frame& F, LAS float* LA, LAS float* LB, const float* gvec, const float* mod, int mi, int shift_idx, int scale_idx) {
    for (int c = F.tid; c < D; c += NWAVES * 64) { const float g = gvec[c];
        if (FINAL) { LA[c] = g; LB[c] = 0.f; }
        else { LA[c] = g * (1.0f + mod[(size_t)mi * (NMOD * D) + (size_t)scale_idx * D + c]); LB[c] = mod[(size_t)mi * (NMOD * D) + (size_t)shift_idx * D + c]; } }
}
#define NIDX(j) (((j) >> 1) * 128 + ((j) & 1))
template <bool FINAL>
__device__ __forceinline__ void norm_row_out(Frame& F, const f32x4 (&v)[16], const LAS float* LA, const LAS float* LB, bf16* outb, float* outf, size_t m) {
    float ss = 0.f;
#pragma unroll
    for (int j = 0; j < 16; ++j) ss += (v[j].x * v[j].x + v[j].y * v[j].y) + (v[j].z * v[j].z + v[j].w * v[j].w);
    const float rstd = 1.0f / sqrtf(wave_sum(ss) * (1.0f / D) + RMS_EPS);
    const LAS f32x4* la = (const LAS f32x4*)LA + 2 * F.lane; const LAS f32x4* lb = (const LAS f32x4*)LB + 2 * F.lane;
    if constexpr (FINAL) { f32x4* op = (f32x4*)(outf + m * D) + 2 * F.lane;
#pragma unroll
        for (int j = 0; j < 16; ++j) op[NIDX(j)] = (v[j] * rstd) * la[NIDX(j)];
    } else { v4u* op = (v4u*)(outb + m * D) + F.lane;
#pragma unroll
        for (int jj = 0; jj < 8; ++jj) { const f32x4 o0 = (v[2 * jj] * rstd) * la[128 * jj] + lb[128 * jj], o1 = (v[2 * jj + 1] * rstd) * la[128 * jj + 1] + lb[128 * jj + 1];
            v4u w; w.x = cvt_pk_bf16(o0.x, o0.y); w.y = cvt_pk_bf16(o0.z, o0.w); w.z = cvt_pk_bf16(o1.x, o1.y); w.w = cvt_pk_bf16(o1.z, o1.w); op[64 * jj] = w; } }
}
template <bool FINAL, bool CTXSUM, bool IN_BF16 = false>
__device__ __forceinline__ void norm_phase(Frame& F, const void* in_lat_, const float* in_ctx, bool do_ctx, const float* gvec, int shift_idx, int scale_idx, bf16* outb, float* outf, const float* part) {
    LAS float* LA = (LAS float*)F.lds; LAS float* LB = LA + D;
    const float* mod = (const float*)(F.ws + WS_MOD);
    const int nb = F.G / 4, b = (int)blockIdx.x / nb, bi = (int)blockIdx.x % nb;
    norm_prep<FINAL>(F, LA, LB, gvec, mod, b, shift_idx, scale_idx);
    __syncthreads();
    {
        f32x4 va[16], vb[16];
        int k = F.wave;
#define NP_ROW(kk) ((size_t)b * SEQ + bi + (size_t)nb * (kk))
#define NP_VALID(kk) (bi + nb * (kk) < SEQ)
#define NP_LOAD(dst, kk) do { if constexpr (IN_BF16) { const v4u* xb_ = (const v4u*)((const bf16*)in_lat_ + NP_ROW(kk) * D) + F.lane; \
            _Pragma("unroll") for (int jj = 0; jj < 8; ++jj) { const v4u w_ = xb_[64 * jj]; dst[2 * jj] = (f32x4){bf_lo(w_.x), bf_hi(w_.x), bf_lo(w_.y), bf_hi(w_.y)}; dst[2 * jj + 1] = (f32x4){bf_lo(w_.z), bf_hi(w_.z), bf_lo(w_.w), bf_hi(w_.w)}; } } \
        else { const f32x4* xr_ = (const f32x4*)((const float*)in_lat_ + NP_ROW(kk) * D) + 2 * F.lane; _Pragma("unroll") for (int j = 0; j < 16; ++j) dst[j] = xr_[NIDX(j)]; } } while (0)
        if (NP_VALID(k)) {
            NP_LOAD(va, k);
            for (;;) {
                const int k2 = k + NWAVES; const bool has2 = NP_VALID(k2);
                if (has2) NP_LOAD(vb, k2);
                norm_row_out<FINAL>(F, va, LA, LB, outb, outf, NP_ROW(k));
                if (!has2) break;
                const int k3 = k2 + NWAVES; const bool has3 = NP_VALID(k3);
                if (has3) NP_LOAD(va, k3);
                norm_row_out<FINAL>(F, vb, LA, LB, outb, outf, NP_ROW(k2));
                if (!has3) break;
                k = k3;
            }
        }
#undef NP_ROW
#undef NP_VALID
#undef NP_LOAD
    }
    if (do_ctx) {
        __syncthreads();
        norm_prep<FINAL>(F, LA, LB, gvec, mod, 4, shift_idx, scale_idx);
        __syncthreads();
        for (int r = (int)blockIdx.x + F.G * F.wave; r < MC; r += F.G * NWAVES) {
            const f32x4* xr = (const f32x4*)(in_ctx + (size_t)r * D) + 2 * F.lane; f32x4 v[16];
            if constexpr (CTXSUM) {
                const f32x4* ps = (const f32x4*)(part + (size_t)r * D) + 2 * F.lane;
#pragma unroll
                for (int j = 0; j < 16; ++j) v[j] = (f32x4){0.f, 0.f, 0.f, 0.f};
#pragma unroll 1
                for (int sp = 0; sp < 4; ++sp) {
#pragma unroll
                    for (int j = 0; j < 16; ++j) v[j] += ps[NIDX(j)];
                    ps += (size_t)MC * (D / 4); }
                const f32x4* gt = (const f32x4*)(mod + (size_t)4 * (NMOD * D) + (size_t)2 * D) + 2 * F.lane;
#pragma unroll
                for (int j = 0; j < 16; ++j) v[j] = xr[NIDX(j)] + (gt[NIDX(j)] * 0.5f) * v[j];
            } else {
#pragma unroll
                for (int j = 0; j < 16; ++j) v[j] = xr[NIDX(j)];
            }
            norm_row_out<FINAL>(F, v, LA, LB, outb, outf, (size_t)ML + r);
        }
    }
    __syncthreads();
}

__device__ __forceinline__ void ctx_scan(Frame& F) {
    const f32x2* bbar = (const f32x2*)(F.ws + WS_BBAR); const f32x2* lamb = (const f32x2*)(F.ws + WS_LAMB); f32x2* hctx = (f32x2*)(F.ws + WS_LAMB + 131072);
    const float* uscp = (const float*)(F.ws + WS_Z);
    LAS float* LU = (LAS float*)F.lds;
    for (int bg = blockIdx.x; bg < BATCH * SG; bg += F.G) {
        const int b = bg >> 6, g = bg & 63;
        for (int i = F.tid; i < CTXL * 4; i += NWAVES * 64) { const int t = i >> 2, q = i & 3; const float* src = uscp + (size_t)(b * CTXL + t) * SW + g * SK + q * 4;
            f32x4 v = *(const f32x4*)src;
#pragma unroll
            for (int sp = 1; sp < 4; ++sp) v += *(const f32x4*)(src + (size_t)sp * MC * SW);
            *(LAS f32x4*)(LU + t * 16 + q * 4) = v; }
        __syncthreads();
        if (F.wave < 2) {
            const int dir = F.wave, p = F.lane, idx = (dir * SG + g) * SP + p;
            f32x2 bb[16];
#pragma unroll
            for (int k = 0; k < 16; ++k) bb[k] = bbar[(size_t)idx * SK + k];
            const f32x2 lam = lamb[idx]; float hr = 0.f, hi = 0.f;
#pragma unroll 4
            for (int s_ = 0; s_ < CTXL; ++s_) { const int t = dir == 0 ? s_ : CTXL - 1 - s_;
                const LAS f32x4* up = (const LAS f32x4*)(LU + t * 16); float br = 0.f, bi = 0.f;
#pragma unroll
                for (int q = 0; q < 4; ++q) { const f32x4 u4 = up[q];
#pragma unroll
                    for (int e = 0; e < 4; ++e) { br += bb[q * 4 + e].x * u4[e]; bi += bb[q * 4 + e].y * u4[e]; } }
                const float nr = lam.x * hr - lam.y * hi + br, ni = lam.x * hi + lam.y * hr + bi; hr = nr; hi = ni; }
            hctx[((dir * BATCH + b) * SG + g) * SP + p] = (f32x2){hr, hi};
        }
        __syncthreads();
    }
}
__device__ __forceinline__ void chunk_recurrence(Frame& F) {
    const f32x2* lamT = (const f32x2*)(F.ws + WS_LAMB + 65536); const f32x2* hctx = (const f32x2*)(F.ws + WS_LAMB + 131072);
    const float* S = (const float*)(F.ws + WS_S); bf16* A2 = (bf16*)(F.ws + WS_A2);
    LAS float* LS = (LAS float*)F.lds;
    for (int gb = blockIdx.x; gb < SG * BATCH; gb += F.G) {
        const int g = gb >> 2, b = gb & 3; const size_t row0 = (size_t)g * A2R + b * NCH;
        const f32x4* src = (const f32x4*)(S + row0 * 256);
#pragma unroll
        for (int i = 0; i < 16; ++i) { const int o = i * (NWAVES * 64) + F.tid; ((LAS f32x4*)LS)[o] = src[o]; }
        __syncthreads();
        if (F.wave < 2) {
            const int dir = F.wave, p = F.lane;
            const f32x2 lt = lamT[(dir * SG + g) * SP + p]; const f32x2 h0 = hctx[((dir * BATCH + b) * SG + g) * SP + p]; float hr = h0.x, hi = h0.y;
#pragma unroll 4
            for (int s_ = 0; s_ < NCH; ++s_) { const int c = dir == 0 ? s_ : NCH - 1 - s_;
                const float sr = LS[c * 256 + dir * 128 + p], si = LS[c * 256 + dir * 128 + 64 + p];
                bf16* ap = A2 + (row0 + c) * A2K + CT * SK + dir * 128 + p;
                ap[0] = (bf16)(cvt_pk_bf16(hr, 0.f) & 0xffffu); ap[64] = (bf16)(cvt_pk_bf16(hi, 0.f) & 0xffffu);
                const float nr = lt.x * hr - lt.y * hi + sr, ni = lt.x * hi + lt.y * hr + si; hr = nr; hi = ni; }
        }
        __syncthreads();
    }
}
__device__ __forceinline__ void pool_units(Frame& F) {
    LAS float* L = (LAS float*)(F.lds); constexpr int RS = 520;
    const bf16* UP = (const bf16*)(F.ws + WS_UP); bf16* MIX = (bf16*)(F.ws + WS_MIX);
    const int tid = F.tid;
    const bool bal = F.G == 256; const int bx = (int)blockIdx.x, nmine = bal ? (bx < 128 ? 3 : 5) : (BATCH * 256 - bx + F.G - 1) / F.G;
    const int vr = (bx & 7) * 16 + ((bx >> 3) - 16);
    for (int ui = 0; ui < nmine; ++ui) {
        const int unit = !bal ? bx + ui * F.G : (ui < 3 ? F.vcu + ui * 256 : (ui == 3 ? 768 + vr : 896 + vr));
        const int b = unit >> 8, slice = unit & 255, w = 2 << (slice >> 6), hw = w >> 1;
        const v4u* src = (const v4u*)(UP + (size_t)(b * 256 + slice) * SEQ * 8);
        v4u keep[8];
#pragma unroll
        for (int i = 0; i < 8; ++i) { const int tok = i * 512 + tid; keep[i] = src[tok]; }
#pragma unroll
        for (int i = 0; i < 8; ++i) { const int tok = i * 512 + tid, r = tok >> 6, c = tok & 63; LAS f32x4* d = (LAS f32x4*)(L + r * RS + c * 8);
            d[0] = (f32x4){bf_lo(keep[i].x), bf_hi(keep[i].x), bf_lo(keep[i].y), bf_hi(keep[i].y)}; d[1] = (f32x4){bf_lo(keep[i].z), bf_hi(keep[i].z), bf_lo(keep[i].w), bf_hi(keep[i].w)}; }
        __syncthreads();
        { const int r = tid >> 3, ch = tid & 7; LAS float* p = L + r * RS + ch; float run = 0.f;
#pragma unroll 8
          for (int c = 0; c < 64; ++c) { run += p[c * 8]; p[c * 8] = run; } }
        __syncthreads();
        { const int c = tid >> 3, ch = tid & 7; LAS float* p = L + c * 8 + ch; float run = 0.f;
#pragma unroll 8
          for (int r = 0; r < 64; ++r) { run += p[r * RS]; p[r * RS] = run; } }
        __syncthreads();
#pragma unroll
        for (int i = 0; i < 8; ++i) { const int tok = i * 512 + tid, r = tok >> 6, c = tok & 63;
            const int rlo = r - hw < 0 ? 0 : r - hw, rhi = r + hw > 64 ? 64 : r + hw, clo = c - hw < 0 ? 0 : c - hw, chi = c + hw > 64 ? 64 : c + hw;
            const float inv = 1.0f / (float)((rhi - rlo) * (chi - clo));
            f32x4 s0, s1;
            { const LAS f32x4* q = (const LAS f32x4*)(L + (rhi - 1) * RS + (chi - 1) * 8); s0 = q[0]; s1 = q[1]; }
            if (rlo > 0) { const LAS f32x4* q = (const LAS f32x4*)(L + (rlo - 1) * RS + (chi - 1) * 8); s0 -= q[0]; s1 -= q[1]; }
            if (clo > 0) { const LAS f32x4* q = (const LAS f32x4*)(L + (rhi - 1) * RS + (clo - 1) * 8); s0 -= q[0]; s1 -= q[1]; }
            if (rlo > 0 && clo > 0) { const LAS f32x4* q = (const LAS f32x4*)(L + (rlo - 1) * RS + (clo - 1) * 8); s0 += q[0]; s1 += q[1]; }
            const f32x4 v0 = (f32x4){bf_lo(keep[i].x), bf_hi(keep[i].x), bf_lo(keep[i].y), bf_hi(keep[i].y)}, v1 = (f32x4){bf_lo(keep[i].z), bf_hi(keep[i].z), bf_lo(keep[i].w), bf_hi(keep[i].w)};
            const f32x4 o0 = s0 * inv - v0, o1 = s1 * inv - v1;
            v4u wv; wv.x = cvt_pk_bf16(o0.x, o0.y); wv.y = cvt_pk_bf16(o0.z, o0.w); wv.z = cvt_pk_bf16(o1.x, o1.y); wv.w = cvt_pk_bf16(o1.z, o1.w);
            *(v4u*)(MIX + (size_t)(b * SEQ + tok) * PW_ + slice * 8) = wv; }
        __syncthreads();
    }
}

constexpr int NPHASES = 16;
#ifndef WGM_FFN
#define WGM_FFN 8
#endif
#ifndef DUP_MASK
#define DUP_MASK 0
#endif
#ifndef DUP_SUB
#define DUP_SUB 0
#endif
#define REPS(k) _Pragma("unroll") for (int rep_ = 0; rep_ < ((((DUP_MASK) >> (k)) & 1) ? 2 : 1); ++rep_)
#ifndef MK_N_LAUNCHES
#define MK_N_LAUNCHES 1
#endif
struct Args { const float* in[27]; float* out; unsigned char* ws; int ph_lo, ph_hi; };
static_assert(sizeof(Args) == 27 * 8 + 8 + 8 + 8, "Args has no padding");

__global__ void __launch_bounds__(NWAVES * 64, 2) fwd_kernel(Args args) {
    extern __shared__ __attribute__((aligned(16))) unsigned char lds[];
    Frame F;
    F.lds = (LAS unsigned char*)lds;
    F.tid = threadIdx.x; F.lane = F.tid & 63; F.wave = __builtin_amdgcn_readfirstlane(F.tid >> 6);
    F.G = gridDim.x; { const int bx = blockIdx.x; F.vcu = (F.G % 8 == 0) ? (bx % 8) * (F.G / 8) + bx / 8 : bx; }
#pragma unroll
    for (int i = 0; i < 27; ++i) F.in[i] = args.in[i];
    F.out = args.out; F.ws = args.ws;
    volatile LAS unsigned* MISC = (volatile LAS unsigned*)(F.lds + MISC_OFF);
    if (F.tid < 32) MISC[F.tid] = 0u;
    __syncthreads();
    unsigned* ctl = (unsigned*)(F.ws + WS_CTL);
    XcdBarrier bar; bar.bar = ctl + CW_BAR; bar.x = 0; bar.st = nullptr;
    if (MK_N_LAUNCHES == 1) bar = xcd_barrier_post(ctl + CW_BAR, MISC + 8);
#define GRID_BAR() do { if (MK_N_LAUNCHES == 1) xcd_barrier(bar); } while (0)
    const int lo = args.ph_lo, hi = args.ph_hi;
#define IN(k) (lo <= (k) && (k) < hi)
#if defined(EXP_T_LO)
    unsigned long long tA_ = 0ull, tB_ = 0ull;
#define TSTAMP(k) do { if ((k) == EXP_T_LO) tA_ = __builtin_amdgcn_s_memrealtime(); if ((k) == EXP_T_HI) tB_ = __builtin_amdgcn_s_memrealtime(); } while (0)
#else
#define TSTAMP(k) do { } while (0)
#endif
    bool qdone = false;
#define FILL_TAIL(p, mand) do { if (!qdone) { phase_done(F, ctl + CW_DONE + 64 * (p)); qdone = fill_transposes(F, (mand), ctl + CW_DONE + 64 * (p)); } } while (0)
#define FILL_MAND(mand) do { if (!qdone) qdone = fill_transposes(F, (mand), nullptr); } while (0)
#define BOTH(k) (IN(k) && IN((k) + 1))
    unsigned char* ws = F.ws;
    LAS unsigned char* ring = F.lds + RING_OFF;
    volatile LAS int* DSLOT = (volatile LAS int*)(F.lds + MISC_OFF + 96);
    const float* mod = (const float*)(ws + WS_MOD);

    TSTAMP(0);
    if (IN(0)) REPS(0) {
        for (int st = 0; st < 3; ++st) { const int which = ((blockIdx.x & 1) && st < 2) ? 1 - st : st;
            if (which == 0) { for (int w = blockIdx.x; w < SG * 4; w += F.G) p0_ssm_part(F, w >> 2, w & 3); }
            else if (which == 1) p0_mod(F);
            else (void)fill_transposes(F, Q_W1B, nullptr); }
        if (BOTH(0)) GRID_BAR();
    }
    TSTAMP(1);
    if (IN(1)) REPS(1) {
        if (F.G % 4 == 0) norm_phase<false, false>(F, F.in[I_X], F.in[I_CTX], true, F.in[I_NORMG], 0, 1, (bf16*)(ws + WS_U), nullptr, nullptr);
        else norm_rows<false>(F, F.in[I_X], F.in[I_CTX], MA, F.in[I_NORMG], 0, 1, (bf16*)(ws + WS_U), nullptr);
        if (BOTH(1)) GRID_BAR();
#if defined(EXP_BARS)
        for (int eb = 0; eb < EXP_BARS; ++eb) GRID_BAR();
#endif
        }
    TSTAMP(2);
    if (IN(2)) REPS(2) {
        pg8::Gemm g{(const char*)(ws + WS_U), (const char*)(ws + WS_W1A), D, D, D, 0, 0};
        pg8::DynOrder<pg8::StaticOrder> S; S.B.init(MA, 2 * DFF, F.G, (int)blockIdx.x, WGM_FFN); S.ctr = ctl + CW_DYN + 128 * 2; S.slot = DSLOT; S.G = F.G; S.c = (int)blockIdx.x;
        EpiGated<0> E{(bf16*)(ws + WS_H), DFF};
#if defined(EXP_VAR)
        pg8::gemm_phase<EpiGated<0>, pg8::DynOrder<pg8::StaticOrder>, PG8_ALIGN, PG8_SP2, EXP_VAR>(ring, g, S, E); GRID_BAR();
#endif
        pg8::gemm_phase<EpiGated<0>, pg8::DynOrder<pg8::StaticOrder>, PG8_ALIGN, PG8_SP2, PG8_VAR>(ring, g, S, E);
        FILL_TAIL(2, Q_W1B); if (BOTH(2)) GRID_BAR();
    }
    TSTAMP(3);
    if (IN(3)) REPS(3) {
        pg8::Gemm g{(const char*)(ws + WS_H), (const char*)(ws + WS_W1B), DFF, DFF, DFF, 0, 0};
        pg8::DynOrder<pg8::SplitKOrder> S; S.ctr = ctl + CW_DYN + 128 * 3; S.slot = DSLOT; S.G = F.G; S.c = (int)blockIdx.x;
        S.B.S.init(ML, D, F.G, (int)blockIdx.x, 2); S.B.pm0 = ML / BM; S.B.npn = D / BM; S.B.ntiles = (MC / BM) * (D / BM); S.B.kt_a = 44; S.B.kt_b = 42;
        EpiResid<false, true> E{F.in[I_X], F.in[I_CTX], (void*)(ws + WS_XB), mod, 2, 0.5f, (float*)(ws + WS_T)};
#if defined(EXP3_VAR)
        pg8::gemm_phase<EpiResid<false, true>, pg8::DynOrder<pg8::SplitKOrder>, PG8_ALIGN, PG8_SP2, EXP3_VAR>(ring, g, S, E); GRID_BAR();
#endif
        pg8::gemm_phase<EpiResid<false, true>, pg8::DynOrder<pg8::SplitKOrder>, PG8_ALIGN, PG8_SP2, PG8_VAR>(ring, g, S, E);
        FILL_TAIL(3, Q_WIN); if (BOTH(3)) GRID_BAR();
    }
    TSTAMP(4);
    if (IN(4)) REPS(4) { const float* X = (const float*)(ws + WS_X);
        norm_phase<false, true, true>(F, (const void*)(ws + WS_XB), F.in[I_CTX], true, F.in[I_NORMG] + D, 3, 4, (bf16*)(ws + WS_U), nullptr, (const float*)(ws + WS_T));
        if (BOTH(4)) GRID_BAR(); }
    TSTAMP(5);
    if (IN(5)) REPS(5) {
        pg8::Gemm g{(const char*)(ws + WS_U), (const char*)(ws + WS_WIN), D, D, D, 0, 0};
        pg8::DynOrder<pg8::SplitKOrder> S; S.ctr = ctl + CW_DYN + 128 * 5; S.slot = DSLOT; S.G = F.G; S.c = (int)blockIdx.x;
        S.B.S.init(ML, DIN, F.G, (int)blockIdx.x, WGM_FFN); S.B.pm0 = ML / BM; S.B.npn = SW / BM; S.B.ntiles = (MC / BM) * (SW / BM); S.B.kt_a = 16; S.B.kt_b = 16;
        EpiWin E{(bf16*)(ws + WS_A2), (float*)(ws + WS_Z), (bf16*)(ws + WS_UP), (bf16*)(ws + WS_GT)};
        pg8::gemm_phase<EpiWin, pg8::DynOrder<pg8::SplitKOrder>, PG8_ALIGN, PG8_SP2, PG8_VAR>(ring, g, S, E);
        FILL_TAIL(5, Q_WIN); if (BOTH(5)) GRID_BAR();
    }
    TSTAMP(6);
    if (IN(6)) REPS(6) {
        { pg8::Gemm g{(const char*)(ws + WS_A2), (const char*)(ws + WS_BTS), A2K, CT * SK, CT * SK, (long)A2R * A2K * 2, (long)256 * CT * SK * 2};
          pg8::GroupOrder S{A2R / BM, 1, SG, F.G, (int)blockIdx.x};
          EpiF32G E{(float*)(ws + WS_S), 256, (size_t)A2R * 256};
          pg8::gemm_phase<EpiF32G, pg8::GroupOrder, PG8_ALIGN, PG8_SP2, PG8_VAR>(ring, g, S, E); }
        ctx_scan(F);
        __syncthreads();
        pool_units(F);
        FILL_MAND(Q_POOL); if (BOTH(6)) GRID_BAR();
    }
    TSTAMP(7);
    if (IN(7)) REPS(7) {
        chunk_recurrence(F);
        { pg8::Gemm g{(const char*)(ws + WS_MIX), (const char*)(ws + WS_WPOOL), PW_, 512, 512, (long)512 * 2, (long)512 * 512 * 2};
          pg8::GroupOrder S{ML / BM, 512 / BM, 4, F.G, (int)blockIdx.x};
          EpiPool E{(bf16*)(ws + WS_YB), F.in[I_POOLS]};
          pg8::gemm_phase<EpiPool, pg8::GroupOrder, PG8_ALIGN, PG8_SP2, PG8_VAR>(ring, g, S, E); }
        FILL_MAND(Q_WB); if (BOTH(7)) GRID_BAR();
    }
    TSTAMP(8);
    if (IN(8)) REPS(8) {
        { pg8::Gemm g{(const char*)(ws + WS_A2), (const char*)(ws + WS_BTY), A2K, A2K, A2K, (long)A2R * A2K * 2, (long)(CT * SK) * A2K * 2};
          pg8::GroupOrder S{A2R / BM, (CT * SK) / BM, SG, F.G, F.vcu};
          EpiY E{(bf16*)(ws + WS_Z)};
          pg8::gemm_phase<EpiY, pg8::GroupOrder, PG8_ALIGN, PG8_SP2, PG8_VAR>(ring, g, S, E); }
        { pg8::Gemm g{(const char*)(ws + WS_YB), (const char*)(ws + WS_WB), PW_, PW_, PW_, 0, 0}; pg8::StaticOrder S; S.init(ML, D, F.G, (int)blockIdx.x, 4);
          EpiBranch<false> E{(bf16*)(ws + WS_T), (const bf16*)(ws + WS_GT), D};
          pg8::gemm_phase<EpiBranch<false>, pg8::StaticOrder, PG8_ALIGN, PG8_SP2, PG8_VAR>(ring, g, S, E); }
        FILL_MAND(Q_GLU); if (BOTH(8)) GRID_BAR();
    }
    TSTAMP(9);
    if (IN(9)) REPS(9) {
        pg8::Gemm g{(const char*)(ws + WS_Z), (const char*)(ws + WS_WGLU), SW, SW, SW, 0, 0}; pg8::StaticOrder S; S.init(ML, 2 * SW, F.G, (int)blockIdx.x);
        EpiGated<1> E{(bf16*)(ws + WS_GL), SW};
        pg8::gemm_phase<EpiGated<1>, pg8::StaticOrder, PG8_ALIGN, PG8_SP2, PG8_VAR>(ring, g, S, E);
        FILL_MAND(Q_WA); if (BOTH(9)) GRID_BAR();
    }
    TSTAMP(10);
    if (IN(10)) {
        pg8::Gemm g{(const char*)(ws + WS_GL), (const char*)(ws + WS_WA), SW, SW, SW, 0, 0}; pg8::StaticOrder S; S.init(ML, D, F.G, (int)blockIdx.x);
        EpiBranch<true> E{(bf16*)(ws + WS_T), (const bf16*)(ws + WS_GT), 0};
        pg8::gemm_phase<EpiBranch<true>, pg8::StaticOrder, PG8_ALIGN, PG8_SP2, PG8_VAR>(ring, g, S, E);
        FILL_MAND(Q_WOUT); if (BOTH(10)) GRID_BAR();
    }
    TSTAMP(11);
    if (IN(11)) {
        pg8::Gemm g{(const char*)(ws + WS_T), (const char*)(ws + WS_WOUT), D, D, D, 0, 0}; pg8::StaticOrder S; S.init(ML, D, F.G, (int)blockIdx.x, 4);
        EpiResid<true, true> E{(const void*)(ws + WS_XB), nullptr, (void*)(ws + WS_XB), mod, 5, 1.0f, nullptr};
        pg8::gemm_phase<EpiResid<true, true>, pg8::StaticOrder, PG8_ALIGN, PG8_SP2, PG8_VAR>(ring, g, S, E);
        FILL_MAND(Q_W2A); if (BOTH(11)) GRID_BAR();
    }
    TSTAMP(12);
    if (IN(12)) REPS(12) { const float* X = (const float*)(ws + WS_X);
        norm_phase<false, false, true>(F, (const void*)(ws + WS_XB), nullptr, false, F.in[I_NORMG] + 2 * D, 6, 7, (bf16*)(ws + WS_U), nullptr, nullptr);
        if (BOTH(12)) GRID_BAR(); }
    TSTAMP(13);
    if (IN(13)) REPS(13) {
        pg8::Gemm g{(const char*)(ws + WS_U), (const char*)(ws + WS_W2A), D, D, D, 0, 0};
        pg8::DynOrder<pg8::StaticOrder> S; S.B.init(ML, 2 * DFF, F.G, (int)blockIdx.x, WGM_FFN); S.ctr = ctl + CW_DYN + 128 * 13; S.slot = DSLOT; S.G = F.G; S.c = (int)blockIdx.x;
        EpiGated<0> E{(bf16*)(ws + WS_H), DFF};
        pg8::gemm_phase<EpiGated<0>, pg8::DynOrder<pg8::StaticOrder>, PG8_ALIGN, PG8_SP2, PG8_VAR>(ring, g, S, E);
        FILL_TAIL(13, Q_W2B); if (BOTH(13)) GRID_BAR();
    }
    TSTAMP(14);
    if (IN(14)) {
        pg8::Gemm g{(const char*)(ws + WS_H), (const char*)(ws + WS_W2B), DFF, DFF, DFF, 0, 0}; pg8::StaticOrder S; S.init(ML, D, F.G, (int)blockIdx.x, 2);
        EpiResid<true, false> E{(const void*)(ws + WS_XB), nullptr, (void*)F.out, mod, 8, 0.5f, nullptr};
        pg8::gemm_phase<EpiResid<true, false>, pg8::StaticOrder, PG8_ALIGN, PG8_SP2, PG8_VAR>(ring, g, S, E);
        if (BOTH(14)) GRID_BAR();
    }
    TSTAMP(15);
    if (IN(15)) REPS(15) { const float* X = F.out;
        if (F.G % 4 == 0) norm_phase<true, false>(F, X, nullptr, false, F.in[I_FINALG], 0, 0, nullptr, F.out, nullptr);
        else norm_rows<true>(F, X, X, ML, F.in[I_FINALG], 0, 0, nullptr, F.out); }
    TSTAMP(16);
#if defined(EXP_T_LO)
    if (blockIdx.x == 0) { const unsigned long long t0_ = __builtin_amdgcn_s_memrealtime(), w_ = (tB_ - tA_) * EXP_T_MUL; while (__builtin_amdgcn_s_memrealtime() - t0_ < w_) __builtin_amdgcn_s_sleep(8); }
#endif
#undef IN
#undef BOTH
#undef GRID_BAR
}

extern "C" void kernel_launch(void* const* d_in, const int* in_sizes, int n_in, void* d_out, int out_size, void* d_ws, size_t ws_size, hipStream_t stream) {
    static int grid = 0;
    if (grid == 0) {
        if (n_in != 27 || in_sizes[0] != ML * D || out_size != ML * D || ws_size < WS_END) { fprintf(stderr, "kernel_launch: unexpected shapes (n_in %d, in0 %d, out %d, ws %zu < %zu); nothing launched\n", n_in, n_in > 0 ? in_sizes[0] : -1, out_size, ws_size, (size_t)WS_END); grid = -1; return; }
        int dev = 0, cus = 0, per_cu = 0;
        if (hipGetDevice(&dev) != hipSuccess || hipDeviceGetAttribute(&cus, hipDeviceAttributeMultiprocessorCount, dev) != hipSuccess) { fprintf(stderr, "kernel_launch: device query failed\n"); grid = -1; return; }
        if (hipFuncSetAttribute((const void*)fwd_kernel, hipFuncAttributeMaxDynamicSharedMemorySize, LDS_BYTES) != hipSuccess) { fprintf(stderr, "kernel_launch: hipFuncSetAttribute failed\n"); grid = -1; return; }
        if (hipOccupancyMaxActiveBlocksPerMultiprocessor(&per_cu, (const void*)fwd_kernel, NWAVES * 64, LDS_BYTES) != hipSuccess || per_cu < 1) fprintf(stderr, "kernel_launch: note: occupancy query reports %d workgroups per CU\n", per_cu);
        (void)hipGetLastError();
        grid = cus - cus % 4;
    }
    if (grid < 0) return;
    if (hipMemsetAsync((char*)d_ws + WS_CTL, 0, CTL_ZERO_BYTES, stream) != hipSuccess) { fprintf(stderr, "kernel_launch: memset failed\n"); return; }
    Args a{};
    for (int i = 0; i < 27; ++i) a.in[i] = (const float*)d_in[i];
    a.out = (float*)d_out; a.ws = (unsigned char*)d_ws;
    for (int li = 0; li < MK_N_LAUNCHES; ++li) {
        a.ph_lo = (MK_N_LAUNCHES == 1) ? 0 : li; a.ph_hi = (MK_N_LAUNCHES == 1) ? NPHASES : li + 1;
        hipLaunchKernelGGL(fwd_kernel, dim3(grid), dim3(NWAVES * 64), LDS_BYTES, stream, a);
        const hipError_t le = hipPeekAtLastError();
        if (le != hipSuccess) { fprintf(stderr, "kernel_launch: launch %d failed: %s\n", li, hipGetErrorName(le)); break; }
    }
}
```
